# Optimizing an MI355X kernel written in HIP

```python
import math
import jax, jax.numpy as jnp
from jax import lax
import numpy as np

D_MODEL = 2048
BATCH = 8
SEQ = 2048
DEPTH = 1
DEC_BATCH = 128
DEC_SEQ = 4
PAST_LEN = 2048
PAGE_SIZE = 128

D_RNN = D_MODEL // 2
RNN_BLOCKS = 8
RNN_BLK = D_RNN // RNN_BLOCKS
RNN_CONV = 4
LRU_C = 8.0
HEAD_DIM = 128
D_ATT = D_MODEL // 2
N_HEADS = D_ATT // HEAD_DIM
N_KV = 2
HPG = N_HEADS // N_KV
KV_W = 2 * N_KV * HEAD_DIM
CMP_BLOCK = 32
CMP_STRIDE = 16
SLC_BLOCK = 64
TOPK = 8
WINDOW = 512
WIN_Q_BLOCK = 128
D_FF = 3 * D_MODEL
FFN_CONV = 3
D_IN = 2 * D_RNN + D_ATT + 3 * KV_W + 3 * N_HEADS + 2 * D_MODEL
RMS_EPS = 1e-6
NEG = -1e30
FORCE = 1e9

kernel_name = 'hawk_nsa_convffn_step'


def rmsnorm(x, g):
    x32 = x.astype(jnp.float32)
    y = x32 * lax.rsqrt(jnp.mean(x32 * x32, axis=-1, keepdims=True) + RMS_EPS)
    return (y * g.astype(jnp.float32)).astype(x.dtype)


def alibi_slopes():
    h = jnp.arange(1, N_HEADS + 1, dtype=jnp.float32)
    return jnp.exp2(-8.0 * h / N_HEADS).reshape(N_KV, HPG)


def masked_softmax(s, mask):
    s = jnp.where(mask, s.astype(jnp.float32), NEG)
    e = jnp.where(mask, jnp.exp(s - jnp.max(s, axis=-1, keepdims=True)), 0.0)
    return e / jnp.maximum(jnp.sum(e, axis=-1, keepdims=True), 1e-30)


def causal_dwconv(x, prev, w, b):
    k = w.shape[0]
    t = x.shape[1]
    xcat = jnp.concatenate([prev.astype(x.dtype), x], axis=1)
    y = b + sum(w[j] * xcat[:, j:j + t] for j in range(k))
    return y, xcat[:, xcat.shape[1] - (k - 1):]


def split_in(z):
    widths = (D_RNN, D_RNN, D_ATT, KV_W, KV_W, KV_W, 3 * N_HEADS, 2 * D_MODEL)
    cuts = [int(c) for c in np.cumsum(widths)[:-1]]
    return jnp.split(z, cuts, axis=-1)


def mixer_inputs(x, norm_g, w_in):
    B, T, _ = x.shape
    h = rmsnorm(x, norm_g)
    xr, gr, q, kvc, kvs, kvw, g_nsa, g_m = split_in(h @ w_in)
    kv_shape = (B, T, 2, N_KV, HEAD_DIM)
    return (xr, gr, q.reshape(B, T, N_KV, HPG, HEAD_DIM), kvc.reshape(kv_shape),
            kvs.reshape(kv_shape), kvw.reshape(kv_shape), g_nsa, g_m)


def rglru(xr, gr, conv_prev, h0, conv_w, conv_b, wa, ba, wx, bx, lam):
    B, T, _ = xr.shape
    xc, new_conv = causal_dwconv(xr, conv_prev, conv_w, conv_b)
    xb = xc.reshape(B, T, RNN_BLOCKS, RNN_BLK)
    r = jax.nn.sigmoid(jnp.einsum('btnc,ncd->btnd', xb, wa).reshape(B, T, D_RNN) + ba)
    i = jax.nn.sigmoid(jnp.einsum('btnc,ncd->btnd', xb, wx).reshape(B, T, D_RNN) + bx)
    log_a = -LRU_C * r.astype(jnp.float32) * jax.nn.softplus(-lam.astype(jnp.float32))
    a = jnp.exp(log_a)
    u = jnp.sqrt(-jnp.expm1(2.0 * log_a)) * (i * xc).astype(jnp.float32)

    def step(h, au):
        h = au[0] * h + au[1]
        return h, h

    h_last, hs = lax.scan(step, h0.astype(jnp.float32), (jnp.swapaxes(a, 0, 1), jnp.swapaxes(u, 0, 1)))
    y = jnp.swapaxes(hs, 0, 1).astype(xr.dtype) * jax.nn.gelu(gr)
    return y, h_last.astype(xr.dtype), new_conv


def chunk_proj(rows, cmp_w):
    B, L = rows.shape[:2]
    ch = rows.reshape(B, L // CMP_STRIDE, CMP_STRIDE, 2, N_KV, HEAD_DIM)
    first = jnp.einsum('bnlcgd,clde->bncge', ch, cmp_w[:, :CMP_STRIDE])
    second = jnp.einsum('bnlcgd,clde->bncge', ch, cmp_w[:, CMP_STRIDE:])
    return first, second


def compress_blocks(first, second, cmp_w, cmp_pos):
    pos_bias = jnp.einsum('cld,clde->ce', cmp_pos, cmp_w)
    return first[:, :-1] + second[:, 1:] + pos_bias[:, None, :]


def compressed_attention(q, qpos, kc, slopes):
    n = kc.shape[1]
    bend = CMP_STRIDE * jnp.arange(n) + (CMP_BLOCK - 1)
    dist = (qpos[:, None] - bend[None, :]).astype(jnp.float32)
    s = jnp.einsum('btgpd,bngd->bgptn', q, kc[:, :, 0]).astype(jnp.float32) / math.sqrt(HEAD_DIM)
    p = masked_softmax(s - slopes[:, :, None, None] * dist, dist >= 0)
    o = jnp.einsum('bgptn,bngd->btgpd', p.astype(q.dtype), kc[:, :, 1])
    return o, p


def cmp_to_slc(n_cmp, n_blk):
    start = CMP_STRIDE * jnp.arange(n_cmp)[:, None]
    b0 = SLC_BLOCK * jnp.arange(n_blk)[None, :]
    return ((start < b0 + SLC_BLOCK) & (start + CMP_BLOCK > b0)).astype(jnp.float32)


def select_blocks(p_cmp, qpos, n_blk):
    imp = jnp.einsum('bgptn,nk->bgtk', p_cmp, cmp_to_slc(p_cmp.shape[-1], n_blk))
    blk = jnp.arange(n_blk)
    cur = (qpos // SLC_BLOCK)[:, None]
    cand = blk[None, :] < cur
    score = jnp.where(cand, jnp.where(blk == 0, FORCE, imp), NEG)
    _, idx = lax.top_k(score, min(TOPK - 1, n_blk))
    return idx, idx < cur


def selected_attention(q, qpos, kv_sel, idx, valid, kv_loc, kpos_loc, slopes):
    B, T = q.shape[:2]
    k1 = idx.shape[-1]
    kpos = idx[..., None] * SLC_BLOCK + jnp.arange(SLC_BLOCK)
    d_sel = (qpos[None, None, :, None, None] - kpos)[:, :, None].astype(jnp.float32)
    s_sel = jnp.einsum('btgpd,bgtksd->bgptks', q, kv_sel[..., 0, :]).astype(jnp.float32) / math.sqrt(HEAD_DIM)
    s_sel = s_sel - slopes[:, :, None, None, None] * d_sel
    m_sel = jnp.broadcast_to(valid[:, :, None, :, :, None], s_sel.shape)
    d_loc = (qpos[:, None] - kpos_loc[None, :]).astype(jnp.float32)
    s_loc = jnp.einsum('btgpd,bsgd->bgpts', q, kv_loc[:, :, 0]).astype(jnp.float32) / math.sqrt(HEAD_DIM)
    s_loc = s_loc - slopes[:, :, None, None] * d_loc
    m_loc = jnp.broadcast_to(d_loc >= 0, s_loc.shape)
    flat = (B, N_KV, HPG, T, k1 * SLC_BLOCK)
    p = masked_softmax(jnp.concatenate([s_sel.reshape(flat), s_loc], -1),
                       jnp.concatenate([m_sel.reshape(flat), m_loc], -1)).astype(q.dtype)
    p_sel = p[..., :k1 * SLC_BLOCK].reshape(s_sel.shape)
    return (jnp.einsum('bgptks,bgtksd->btgpd', p_sel, kv_sel[..., 1, :])
            + jnp.einsum('bgpts,bsgd->btgpd', p[..., k1 * SLC_BLOCK:], kv_loc[:, :, 1]))


def window_attention(q, qpos, kv, kpos, slopes):
    d = qpos[:, None] - kpos[None, :]
    mask = (d >= 0) & (d <= WINDOW) & (kpos[None, :] >= 0)
    s = jnp.einsum('btgpd,bsgd->bgpts', q, kv[:, :, 0]).astype(jnp.float32) / math.sqrt(HEAD_DIM)
    p = masked_softmax(s - slopes[:, :, None, None] * d.astype(jnp.float32), mask)
    return jnp.einsum('bgpts,bsgd->btgpd', p.astype(q.dtype), kv[:, :, 1])


def nsa_prompt(q, kv_cmp, kv_slc, kv_win, cmp_w, cmp_pos, slopes):
    B, T = q.shape[:2]
    qpos = jnp.arange(T)
    first, second = chunk_proj(kv_cmp, cmp_w)
    kc = compress_blocks(first, second, cmp_w, cmp_pos)
    o_cmp, p_cmp = compressed_attention(q, qpos, kc, slopes)
    nb = T // SLC_BLOCK
    idx, valid = select_blocks(p_cmp, qpos, nb)
    k1 = idx.shape[-1]
    kv_blocks = kv_slc.reshape(B, nb, SLC_BLOCK, 2, N_KV, HEAD_DIM)
    kvb = kv_blocks.transpose(0, 4, 1, 2, 3, 5)
    bi = jnp.arange(B)[:, None, None, None]
    gi = jnp.arange(N_KV)[None, :, None, None]

    def one_block(args):
        i, q_i, idx_i, val_i, loc_i = args
        qpos_i = i * SLC_BLOCK + jnp.arange(SLC_BLOCK)
        kv_sel = kvb[bi, gi, idx_i]
        return selected_attention(q_i, qpos_i, kv_sel, idx_i, val_i, loc_i, qpos_i, slopes)

    q_b = jnp.swapaxes(q.reshape(B, nb, SLC_BLOCK, N_KV, HPG, HEAD_DIM), 0, 1)
    idx_b = idx.reshape(B, N_KV, nb, SLC_BLOCK, k1).transpose(2, 0, 1, 3, 4)
    val_b = valid.reshape(B, N_KV, nb, SLC_BLOCK, k1).transpose(2, 0, 1, 3, 4)
    o_slc = lax.map(one_block, (jnp.arange(nb), q_b, idx_b, val_b, jnp.swapaxes(kv_blocks, 0, 1)))
    o_slc = jnp.swapaxes(o_slc, 0, 1).reshape(B, T, N_KV, HPG, HEAD_DIM)
    nq = T // WIN_Q_BLOCK
    kv_pad = jnp.pad(kv_win, ((0, 0), (WINDOW, 0), (0, 0), (0, 0), (0, 0)))
    band = jnp.arange(nq)[:, None] * WIN_Q_BLOCK + jnp.arange(WIN_Q_BLOCK + WINDOW)[None, :]
    o_win = jax.vmap(window_attention, in_axes=(1, 0, 1, 0, None), out_axes=1)(
        q.reshape(B, nq, WIN_Q_BLOCK, N_KV, HPG, HEAD_DIM), qpos.reshape(nq, WIN_Q_BLOCK),
        kv_pad[:, band], band - WINDOW, slopes)
    return o_cmp, o_slc, o_win.reshape(B, T, N_KV, HPG, HEAD_DIM)


def nsa_sample(q, kv_cmp_new, kv_slc_new, kv_win_new, cache_cmp, cache_slc, cache_win, page_table, cmp_w, cmp_pos, slopes):
    DB, Tq = q.shape[:2]
    page = cache_cmp.shape[1]
    past = page_table.shape[1] * page
    qpos = past + jnp.arange(Tq)
    past_cmp = cache_cmp[page_table].reshape(DB, past, 2, N_KV, HEAD_DIM)
    first, second = chunk_proj(past_cmp, cmp_w)
    n_new = Tq // CMP_STRIDE
    if n_new > 0:
        f2, s2 = chunk_proj(kv_cmp_new[:, :n_new * CMP_STRIDE], cmp_w)
        first = jnp.concatenate([first, f2], axis=1)
        second = jnp.concatenate([second, s2], axis=1)
    kc = compress_blocks(first, second, cmp_w, cmp_pos)
    o_cmp, p_cmp = compressed_attention(q, qpos, kc, slopes)
    idx, valid = select_blocks(p_cmp, qpos, past // SLC_BLOCK)
    bpp = page // SLC_BLOCK
    phys = page_table[jnp.arange(DB)[:, None, None, None], idx // bpp]
    rows = (idx % bpp)[..., None] * SLC_BLOCK + jnp.arange(SLC_BLOCK)
    gi = jnp.arange(N_KV)[None, :, None, None, None]
    kv_sel = cache_slc[phys[..., None], rows, :, gi, :]
    o_slc = selected_attention(q, qpos, kv_sel, idx, valid, kv_slc_new, qpos, slopes)
    wb = cache_win.shape[1]
    kv_cat = jnp.concatenate([cache_win, kv_win_new.astype(cache_win.dtype)], axis=1)
    o_win = window_attention(q, qpos, kv_cat, past - wb + jnp.arange(wb + Tq), slopes)
    return o_cmp, o_slc, o_win, kv_cat[:, Tq:]


def merge_out(y_rnn, o_cmp, o_slc, o_win, g_nsa, g_m, w_proj_rnn, w_proj_att, w_out):
    B, T = y_rnn.shape[:2]
    g = jax.nn.sigmoid(g_nsa).reshape(B, T, 3, N_KV, HPG, 1)
    o = (g[:, :, 0] * o_cmp + g[:, :, 1] * o_slc + g[:, :, 2] * o_win).reshape(B, T, D_ATT)
    m = (jax.nn.sigmoid(g_m[..., :D_MODEL]) * (y_rnn @ w_proj_rnn)
         + jax.nn.sigmoid(g_m[..., D_MODEL:]) * (o @ w_proj_att))
    return m @ w_out


def conv_ffn(h, prev, w_gate, w_up, conv_w, conv_b, w_down):
    u, new_conv = causal_dwconv(h @ w_gate, prev, conv_w, conv_b)
    return (jax.nn.gelu(u) * (h @ w_up)) @ w_down, new_conv


def setup_inputs(seed: int = 0) -> dict:
    key = jax.random.key(seed)
    ks = jax.random.split(key, 32)

    def nrm(k, shape, scale):
        return jax.random.normal(k, shape, jnp.float32) * scale

    n_pages = PAST_LEN // PAGE_SIZE
    n_used = DEC_BATCH * n_pages
    n_pool = (5 * n_used) // 4
    page_table = jax.random.permutation(ks[0], n_pool)[:n_used].reshape(DEC_BATCH, n_pages).astype(jnp.int32)
    wbuf = min(WINDOW, PAST_LEN)
    u = jax.random.uniform(ks[1], (DEPTH, D_RNN), jnp.float32, 0.9, 0.999)
    s = u ** (1.0 / LRU_C)
    return {
        'x_prompt': nrm(ks[2], (BATCH, SEQ, D_MODEL), 1.0),
        'x_sample': nrm(ks[3], (DEC_BATCH, DEC_SEQ, D_MODEL), 1.0),
        'cache_kv_cmp': nrm(ks[4], (DEPTH, n_pool, PAGE_SIZE, 2, N_KV, HEAD_DIM), 1.0),
        'cache_kv_slc': nrm(ks[5], (DEPTH, n_pool, PAGE_SIZE, 2, N_KV, HEAD_DIM), 1.0),
        'cache_kv_win': nrm(ks[6], (DEPTH, DEC_BATCH, wbuf, 2, N_KV, HEAD_DIM), 1.0),
        'state_rnn_h': nrm(ks[7], (DEPTH, DEC_BATCH, D_RNN), 0.5),
        'state_rnn_conv': nrm(ks[8], (DEPTH, DEC_BATCH, RNN_CONV - 1, D_RNN), 1.0),
        'state_ffn_conv': nrm(ks[9], (DEPTH, DEC_BATCH, FFN_CONV - 1, D_FF), 1.0),
        'page_table': page_table,
        'norm_mix': 1.0 + nrm(ks[10], (DEPTH, D_MODEL), 0.02),
        'w_in': nrm(ks[11], (DEPTH, D_MODEL, D_IN), D_MODEL ** -0.5),
        'rnn_conv_w': nrm(ks[12], (DEPTH, RNN_CONV, D_RNN), RNN_CONV ** -0.5),
        'rnn_conv_b': nrm(ks[13], (DEPTH, D_RNN), 0.01),
        'rnn_wa': nrm(ks[14], (DEPTH, RNN_BLOCKS, RNN_BLK, RNN_BLK), RNN_BLK ** -0.5),
        'rnn_ba': nrm(ks[15], (DEPTH, D_RNN), 0.01),
        'rnn_wx': nrm(ks[16], (DEPTH, RNN_BLOCKS, RNN_BLK, RNN_BLK), RNN_BLK ** -0.5),
        'rnn_bx': nrm(ks[17], (DEPTH, D_RNN), 0.01),
        'rnn_lambda': jnp.log(s) - jnp.log1p(-s),
        'cmp_w': nrm(ks[18], (DEPTH, 2, CMP_BLOCK, HEAD_DIM, HEAD_DIM), (CMP_BLOCK * HEAD_DIM) ** -0.5),
        'cmp_pos': nrm(ks[19], (DEPTH, 2, CMP_BLOCK, HEAD_DIM), 0.02),
        'w_proj_rnn': nrm(ks[20], (DEPTH, D_RNN, D_MODEL), D_RNN ** -0.5),
        'w_proj_att': nrm(ks[21], (DEPTH, D_ATT, D_MODEL), D_ATT ** -0.5),
        'w_out': nrm(ks[22], (DEPTH, D_MODEL, D_MODEL), D_MODEL ** -0.5),
        'norm_ffn': 1.0 + nrm(ks[23], (DEPTH, D_MODEL), 0.02),
        'ffn_w_gate': nrm(ks[24], (DEPTH, D_MODEL, D_FF), D_MODEL ** -0.5),
        'ffn_w_up': nrm(ks[25], (DEPTH, D_MODEL, D_FF), D_MODEL ** -0.5),
        'ffn_conv_w': nrm(ks[26], (DEPTH, FFN_CONV, D_FF), FFN_CONV ** -0.5),
        'ffn_conv_b': nrm(ks[27], (DEPTH, D_FF), 0.01),
        'ffn_w_down': nrm(ks[28], (DEPTH, D_FF, D_MODEL), D_FF ** -0.5),
        'norm_final': 1.0 + nrm(ks[29], (D_MODEL,), 0.02),
    }


def reference(x_prompt, x_sample, cache_kv_cmp, cache_kv_slc, cache_kv_win, state_rnn_h, state_rnn_conv,
              state_ffn_conv, page_table, norm_mix, w_in, rnn_conv_w, rnn_conv_b, rnn_wa, rnn_ba, rnn_wx, rnn_bx,
              rnn_lambda, cmp_w, cmp_pos, w_proj_rnn, w_proj_att, w_out, norm_ffn, ffn_w_gate, ffn_w_up,
              ffn_conv_w, ffn_conv_b, ffn_w_down, norm_final):
    slopes = alibi_slopes()
    xp, xs = x_prompt, x_sample
    B, T, _ = xp.shape
    DB = xs.shape[0]
    pst = [[] for _ in range(6)]
    sst = [[] for _ in range(6)]
    for l in range(DEPTH):
        rnn_args = (rnn_conv_w[l], rnn_conv_b[l], rnn_wa[l], rnn_ba[l], rnn_wx[l], rnn_bx[l], rnn_lambda[l])
        ffn_args = (ffn_w_gate[l], ffn_w_up[l], ffn_conv_w[l], ffn_conv_b[l], ffn_w_down[l])
        out_args = (w_proj_rnn[l], w_proj_att[l], w_out[l])
        xr, gr, q, kvc, kvs, kvw, g_nsa, g_m = mixer_inputs(xp, norm_mix[l], w_in[l])
        y_rnn, h_last, rconv = rglru(xr, gr, jnp.zeros((B, RNN_CONV - 1, D_RNN), xp.dtype),
                                     jnp.zeros((B, D_RNN), xp.dtype), *rnn_args)
        o_c, o_s, o_w = nsa_prompt(q, kvc, kvs, kvw, cmp_w[l], cmp_pos[l], slopes)
        xp = xp + merge_out(y_rnn, o_c, o_s, o_w, g_nsa, g_m, *out_args)
        f, fconv = conv_ffn(rmsnorm(xp, norm_ffn[l]), jnp.zeros((B, FFN_CONV - 1, D_FF), xp.dtype), *ffn_args)
        xp = xp + f
        for lst, v in zip(pst, (kvc, kvs, kvw[:, T - min(WINDOW, T):], h_last, rconv, fconv)):
            lst.append(v)
        xr, gr, q, kvc, kvs, kvw, g_nsa, g_m = mixer_inputs(xs, norm_mix[l], w_in[l])
        y_rnn, h_last, rconv = rglru(xr, gr, state_rnn_conv[l], state_rnn_h[l], *rnn_args)
        o_c, o_s, o_w, win_buf = nsa_sample(q, kvc, kvs, kvw, cache_kv_cmp[l], cache_kv_slc[l], cache_kv_win[l],
                                            page_table, cmp_w[l], cmp_pos[l], slopes)
        xs = xs + merge_out(y_rnn, o_c, o_s, o_w, g_nsa, g_m, *out_args)
        f, fconv = conv_ffn(rmsnorm(xs, norm_ffn[l]), state_ffn_conv[l], *ffn_args)
        xs = xs + f
        for lst, v in zip(sst, (kvc, kvs, win_buf, h_last, rconv, fconv)):
            lst.append(v)
    y_prompt = rmsnorm(xp, norm_final)
    y_sample = rmsnorm(xs, norm_final)
    p_kv_cmp, p_kv_slc, p_kv_win, p_rnn_h, p_rnn_conv, p_ffn_conv = [jnp.stack(v) for v in pst]
    s_kv_cmp, s_kv_slc, s_kv_win, s_rnn_h, s_rnn_conv, s_ffn_conv = [jnp.stack(v) for v in sst]
    return (y_prompt, y_sample, p_kv_cmp, p_kv_slc, p_kv_win, p_rnn_h, p_rnn_conv, p_ffn_conv,
            s_kv_cmp, s_kv_slc, s_kv_win, s_rnn_h, s_rnn_conv, s_ffn_conv)
```

```cpp
#include <hip/hip_runtime.h>
#include <cstdio>
#include <cstdint>
#define MK_ONE_LAUNCH 1
#define PROJ_MERGED 1
namespace pg8 {
#define PG8_LAS __attribute__((address_space(3)))
typedef unsigned short bf16_t;
typedef short bf16x8 __attribute__((ext_vector_type(8)));
typedef float f32x4 __attribute__((ext_vector_type(4)));
typedef unsigned u32x4 __attribute__((ext_vector_type(4)));
constexpr int BM = 256, BK = 64, HALF = 128, HTB = HALF * BK * 2  , STAGE_BYTES = 8 * HTB, NXCD = 8, WGM = 8;

__host__ __device__ __forceinline__ int lds_byte(int r, int c) { const int st = (r >> 4) * 2 + (c >> 5), rr = r & 15, cc = c & 31, ob = rr * 64 + cc * 2; return st * 1024 + (ob ^ (((ob >> 9) & 1) << 5)); }
__host__ __device__ __forceinline__ void stage_rc(int b, int& R, int& C) { const int st = b / 1024, sb = b % 1024, swz = sb ^ (((sb >> 9) & 1) << 5); R = (st >> 1) * 16 + swz / 64; C = (st & 1) * 32 + (swz % 64) / 2; }
__host__ __device__ __forceinline__ int perm32(int rho) { const int n = rho >> 4, i = rho & 15; return 8 * (i >> 2) + 4 * n + (i & 3); }

struct Unit { int pm, pn, ko; };
struct Gemm { const bf16_t* A; const bf16_t* Bt; int M, N, K, lda, ldb; const bf16_t* A2 = nullptr; const bf16_t* Bt2 = nullptr; };

struct StaticOrder {
    int nM, nN, nwg, G, c, wgm;
    __host__ __device__ void init(int M, int N, int G_, int c_, int wgm_ = WGM) { nM = M / BM; nN = N / BM; nwg = nM * nN; G = G_; c = c_; wgm = wgm_; }
    __host__ __device__ bool next(int i, Unit& u) const {
        const long L = (long)i * G + c; if (L >= nwg) return false;
        int wgid = (int)L; { const int q = nwg / NXCD, r = nwg % NXCD, xcd = wgid % NXCD, off = wgid / NXCD; wgid = (xcd < r ? xcd * (q + 1) : r * (q + 1) + (xcd - r) * q) + off; }
        const int nig = wgm * nN, gid = wgid / nig, fm = gid * wgm, gsz = (nM - fm) < wgm ? (nM - fm) : wgm;
        u.pm = fm + ((wgid % nig) % gsz); u.pn = (wgid % nig) / gsz; u.ko = 0; return true;
    }
    __device__ __forceinline__ void a_ready(const Unit&) const {}
    __device__ __forceinline__ void done(const Unit&) const {}
};
typedef __bf16 bf16x2n_t __attribute__((ext_vector_type(2)));
typedef float f32x2n_t __attribute__((ext_vector_type(2)));
__device__ __forceinline__ unsigned cvt_pk_bf16(float lo, float hi) { const f32x2n_t f = {lo, hi}; return __builtin_bit_cast(unsigned, __builtin_convertvector(f, bf16x2n_t)); }
template <class Epi, class Sched, bool ALIGN_EPI = false, bool SP2 = false>
__device__ __forceinline__ void gemm_phase(PG8_LAS unsigned char* lds, const Gemm g, const Sched& S, const Epi& E) {
    const int tid = threadIdx.x, wid = __builtin_amdgcn_readfirstlane(tid >> 6), lane = tid & 63, wr = wid >> 2, wc = wid & 3, fr = lane & 15, fq = lane >> 4;
    const int K = g.K, nt = K / BK;
    unsigned voffA[2], voffB[2];
#pragma unroll
    for (int i = 0; i < 2; ++i) { int R, C; stage_rc(tid * 16 + i * 8192, R, C); const int Rb = Epi::PERM ? ((R & ~31) + perm32(R & 31)) : R;
        voffA[i] = (unsigned)(R * g.lda + C) * 2u; voffB[i] = (unsigned)(Rb * g.ldb + C) * 2u; }
    const size_t kstep = (size_t)(BK * 2);
    const size_t hstepA = (size_t)HALF * g.lda * 2, hstepB = (size_t)HALF * g.ldb * 2;
    const size_t tstepA = 2 * hstepA, tstepB = 2 * hstepB;
    const unsigned ldsw = (unsigned)wid * 1024u;
    const int aoff = lds_byte(wr * 64 + fr, fq * 8), boff = lds_byte(wc * 32 + fr, fq * 8);
#define PG8_SA(b, h) (((b) * 2 + (h)) * HTB)
#define PG8_SB(b, h) ((4 + (b) * 2 + (h)) * HTB)
#define PG8_STAGE(bufoff, gbase, voff) do { _Pragma("unroll") for (int _i = 0; _i < 2; ++_i) \
        __builtin_amdgcn_global_load_lds((const unsigned*)((const char*)(gbase) + (voff)[_i]), (PG8_LAS unsigned*)(lds + (bufoff) + ldsw + _i * 8192), 16, 0, 0); } while (0)
#define PG8_LDA(dst, b, h) do { _Pragma("unroll") for (int m = 0; m < 4; ++m) _Pragma("unroll") for (int k = 0; k < 2; ++k) dst[m][k] = *(const PG8_LAS bf16x8*)(lds + PG8_SA(b, h) + aoff + m * 2048 + k * 1024); } while (0)
#define PG8_LDB(dst, b, h) do { _Pragma("unroll") for (int n = 0; n < 2; ++n) _Pragma("unroll") for (int k = 0; k < 2; ++k) dst[n][k] = *(const PG8_LAS bf16x8*)(lds + PG8_SB(b, h) + boff + n * 2048 + k * 1024); } while (0)
#define PG8_MMA(ai, bj, At, Bt) do { __builtin_amdgcn_s_setprio(1); _Pragma("unroll") for (int m = 0; m < 4; ++m) _Pragma("unroll") for (int n = 0; n < 2; ++n) _Pragma("unroll") for (int k = 0; k < 2; ++k) \
        acc[ai][bj][m][n] = __builtin_amdgcn_mfma_f32_16x16x32_bf16(Bt[n][k], At[m][k], acc[ai][bj][m][n], 0, 0, 0); __builtin_amdgcn_s_setprio(0); } while (0)
#define PG8_WAIT_V(n) asm volatile("s_waitcnt vmcnt(" #n ")" ::: "memory")
#define PG8_WAIT_L(n) asm volatile("s_waitcnt lgkmcnt(" #n ")" ::: "memory")
#define PG8_BAR __builtin_amdgcn_s_barrier()
#define PG8_SCHED __builtin_amdgcn_sched_barrier(0)
    Unit cur, nxt; int ui = 0;
    if (!S.next(0, cur)) return;
    f32x4 acc[2][2][4][2];
#pragma unroll
    for (int a = 0; a < 2; ++a)
#pragma unroll
        for (int b = 0; b < 2; ++b)
#pragma unroll
            for (int m = 0; m < 4; ++m)
#pragma unroll
                for (int n = 0; n < 2; ++n) acc[a][b][m][n] = (f32x4){0.f, 0.f, 0.f, 0.f};
    bf16x8 At[4][2], B0[2][2], B1[2][2];
    const char* cA = (const char*)g.A + (size_t)cur.pm * tstepA + (size_t)cur.ko * 2; const char* cB = (const char*)g.Bt + (size_t)cur.pn * tstepB + (size_t)cur.ko * 2;
    const int ks = nt / 2;
    const char* cA2 = nullptr; const char* cB2 = nullptr;
    if constexpr (Epi::MIDK) { cA2 = (const char*)g.A2 + (size_t)cur.pm * tstepA - (size_t)ks * kstep; cB2 = (const char*)g.Bt2 + (size_t)cur.pn * tstepB - (size_t)ks * kstep; }
    S.a_ready(cur);
    if constexpr (SP2) {
        PG8_STAGE(PG8_SB(0, 0), cB, voffB); PG8_STAGE(PG8_SB(0, 1), cB + hstepB, voffB); PG8_STAGE(PG8_SA(0, 0), cA, voffA); PG8_STAGE(PG8_SA(0, 1), cA + hstepA, voffA);
        if (wr == 1) PG8_BAR;
        PG8_WAIT_V(2); PG8_BAR;
        PG8_STAGE(PG8_SB(1, 0), cB + kstep, voffB); PG8_STAGE(PG8_SA(1, 0), cA + kstep, voffA); PG8_STAGE(PG8_SB(1, 1), cB + hstepB + kstep, voffB);
        PG8_WAIT_V(6); PG8_BAR;
    } else {
        PG8_STAGE(PG8_SB(0, 0), cB, voffB); PG8_STAGE(PG8_SA(0, 0), cA, voffA); PG8_STAGE(PG8_SB(0, 1), cB + hstepB, voffB); PG8_STAGE(PG8_SA(0, 1), cA + hstepA, voffA);
        if (wr == 1) PG8_BAR;
        PG8_WAIT_V(4); PG8_BAR;
        PG8_STAGE(PG8_SB(1, 0), cB + kstep, voffB); PG8_STAGE(PG8_SA(1, 0), cA + kstep, voffA); PG8_STAGE(PG8_SB(1, 1), cB + hstepB + kstep, voffB);
        PG8_WAIT_V(6); PG8_BAR;
    }
    for (;;) {
        const bool has_next = S.next(ui + 1, nxt);
        const char* nA = has_next ? (const char*)g.A + (size_t)nxt.pm * tstepA + (size_t)nxt.ko * 2 : cA; const char* nB = has_next ? (const char*)g.Bt + (size_t)nxt.pn * tstepB + (size_t)nxt.ko * 2 : cB;
#pragma unroll
        for (int seg = 0; seg < (Epi::MIDK ? 2 : 1); ++seg) {
        if constexpr (Epi::MIDK) { if (seg == 1) E.mid(acc, cur, wr, wc, fr, fq); }
        for (int t = (seg == 0 ? 0 : ks); t < ((Epi::MIDK && seg == 0) ? ks : nt); t += 2) {
            const bool last = (t == nt - 2);
            const char* pA1 = cA; const char* pA2 = cA; const char* pB2 = cB;
            if constexpr (Epi::MIDK) { if (t >= ks) pA1 = cA2; if (t + 2 >= ks) { pA2 = cA2; pB2 = cB2; } }
            const char* a1 = pA1 + (size_t)(t + 1) * kstep;
            const char* a2 = last ? nA : pA2 + (size_t)(t + 2) * kstep; const char* b2 = last ? nB : pB2 + (size_t)(t + 2) * kstep;
            const char* a3 = a2 + kstep; const char* b3 = b2 + kstep;
            if (last && has_next) S.a_ready(nxt);
            if constexpr (SP2) {
            PG8_LDB(B0, 0, 0); PG8_LDB(B1, 0, 1); PG8_SCHED; PG8_LDA(At, 0, 0); PG8_STAGE(PG8_SA(1, 1), a1 + hstepA, voffA);
            PG8_WAIT_V(8); PG8_WAIT_L(0); PG8_BAR; PG8_MMA(0, 0, At, B0); PG8_MMA(0, 1, At, B1); PG8_BAR; PG8_SCHED;
            PG8_LDA(At, 0, 1); PG8_STAGE(PG8_SB(0, 0), b2, voffB); PG8_STAGE(PG8_SB(0, 1), b2 + hstepB, voffB); PG8_STAGE(PG8_SA(0, 0), a2, voffA);
            PG8_WAIT_V(8); PG8_WAIT_L(0); PG8_BAR; PG8_MMA(1, 0, At, B0); PG8_MMA(1, 1, At, B1); PG8_BAR; PG8_SCHED;
            PG8_LDB(B0, 1, 0); PG8_LDB(B1, 1, 1); PG8_SCHED; PG8_LDA(At, 1, 0); PG8_STAGE(PG8_SA(0, 1), a2 + hstepA, voffA);
            PG8_WAIT_V(8); PG8_WAIT_L(0); PG8_BAR; PG8_MMA(0, 0, At, B0); PG8_MMA(0, 1, At, B1); PG8_BAR; PG8_SCHED;
            PG8_LDA(At, 1, 1); PG8_STAGE(PG8_SB(1, 0), b3, voffB); PG8_STAGE(PG8_SB(1, 1), b3 + hstepB, voffB); PG8_STAGE(PG8_SA(1, 0), a3, voffA);
            PG8_WAIT_V(8); PG8_WAIT_L(0); PG8_BAR; PG8_MMA(1, 0, At, B0); PG8_MMA(1, 1, At, B1); PG8_BAR; PG8_SCHED;
            } else {
            PG8_LDB(B0, 0, 0); PG8_SCHED; PG8_LDA(At, 0, 0); PG8_STAGE(PG8_SA(1, 1), a1 + hstepA, voffA);
            PG8_WAIT_L(8); PG8_BAR; PG8_WAIT_L(0); PG8_MMA(0, 0, At, B0); PG8_BAR; PG8_SCHED;
            PG8_LDB(B1, 0, 1); PG8_STAGE(PG8_SB(0, 0), b2, voffB);
            PG8_BAR; PG8_WAIT_L(0); PG8_MMA(0, 1, At, B1); PG8_BAR;
            PG8_LDA(At, 0, 1); PG8_STAGE(PG8_SA(0, 0), a2, voffA);
            PG8_BAR; PG8_WAIT_L(0); PG8_MMA(1, 0, At, B0); PG8_BAR; PG8_SCHED;
            PG8_STAGE(PG8_SB(0, 1), b2 + hstepB, voffB);
            PG8_WAIT_V(6); PG8_BAR; PG8_MMA(1, 1, At, B1); PG8_BAR;
            PG8_LDB(B0, 1, 0); PG8_SCHED; PG8_LDA(At, 1, 0); PG8_STAGE(PG8_SA(0, 1), a2 + hstepA, voffA);
            PG8_WAIT_L(8); PG8_BAR; PG8_WAIT_L(0); PG8_MMA(0, 0, At, B0); PG8_BAR; PG8_SCHED;
            PG8_LDB(B1, 1, 1); PG8_STAGE(PG8_SB(1, 0), b3, voffB);
            PG8_BAR; PG8_WAIT_L(0); PG8_MMA(0, 1, At, B1); PG8_BAR;
            PG8_LDA(At, 1, 1); PG8_STAGE(PG8_SA(1, 0), a3, voffA);
            PG8_BAR; PG8_WAIT_L(0); PG8_MMA(1, 0, At, B0); PG8_BAR; PG8_SCHED;
            PG8_STAGE(PG8_SB(1, 1), b3 + hstepB, voffB);
            PG8_WAIT_V(6); PG8_BAR; PG8_MMA(1, 1, At, B1); PG8_BAR;
            }
        }
        }
        if constexpr (ALIGN_EPI) { if (wr == 0) PG8_BAR; }
        if constexpr (!Epi::AFTER_DRAIN) { E(acc, cur, wr, wc, fr, fq); S.done(cur); }
        if (!has_next) break;
#pragma unroll
        for (int a = 0; a < 2; ++a)
#pragma unroll
            for (int b = 0; b < 2; ++b)
#pragma unroll
                for (int m = 0; m < 4; ++m)
#pragma unroll
                    for (int n = 0; n < 2; ++n) acc[a][b][m][n] = (f32x4){0.f, 0.f, 0.f, 0.f};
        cur = nxt; cA = nA; cB = nB; ++ui;
        if constexpr (Epi::MIDK) { cA2 = (const char*)g.A2 + (size_t)cur.pm * tstepA - (size_t)ks * kstep; cB2 = (const char*)g.Bt2 + (size_t)cur.pn * tstepB - (size_t)ks * kstep; }
        if constexpr (ALIGN_EPI) { if (wr == 1) PG8_BAR; }
    }
    PG8_WAIT_V(0);
    if constexpr (!ALIGN_EPI) { if (wr == 0) PG8_BAR; }
    PG8_BAR;
    if constexpr (Epi::AFTER_DRAIN) { E.fused(acc, cur, wr, wc, fr, fq, lds, wid, lane); S.done(cur); }
#undef PG8_SA
#undef PG8_SB
#undef PG8_STAGE
#undef PG8_LDA
#undef PG8_LDB
#undef PG8_MMA
#undef PG8_WAIT_V
#undef PG8_WAIT_L
#undef PG8_BAR
#undef PG8_SCHED
}
}

#define LAS __attribute__((address_space(3)))
using pg8::bf16_t; using pg8::bf16x8; using pg8::f32x4; using pg8::u32x4; using pg8::Unit;
typedef float f32x16 __attribute__((ext_vector_type(16)));
typedef short s16x4 __attribute__((ext_vector_type(4)));
typedef unsigned u32x2 __attribute__((ext_vector_type(2)));

#ifndef MK_ONE_LAUNCH
#define MK_ONE_LAUNCH 0
#endif
constexpr int NPHASE = 12;
#ifndef SC_YP
#define SC_YP 1.0f
#endif
#ifndef SC_YS
#define SC_YS 1.0f
#endif
#ifndef SC_PFC
#define SC_PFC 1.0f
#endif
#ifndef SC_SFC
#define SC_SFC 1.0f
#endif
#ifndef SC_PRH
#define SC_PRH 1.0f
#endif
#ifndef SC_SRH
#define SC_SRH 1.0f
#endif
constexpr int DM = 2048, NBATCH = 8, SEQ = 2048, DBATCH = 128, DSEQ = 4;
constexpr int MP = NBATCH * SEQ, MS = DBATCH * DSEQ, M = MP + MS;
constexpr int DFF = 6144, N1 = 8704;
constexpr float EPS = 1e-6f;
constexpr int NCU_UNITS = 272;

constexpr size_t O_YP = 0, O_YS = O_YP + (size_t)MP * DM, O_PKC = O_YS + (size_t)MS * DM, O_PKS = O_PKC + (size_t)MP * 512, O_PKW = O_PKS + (size_t)MP * 512,
    O_PRH = O_PKW + (size_t)NBATCH * 512 * 512, O_PRC = O_PRH + NBATCH * 1024, O_PFC = O_PRC + NBATCH * 3 * 1024, O_SKC = O_PFC + (size_t)NBATCH * 2 * DFF,
    O_SKS = O_SKC + (size_t)MS * 512, O_SKW = O_SKS + (size_t)MS * 512, O_SRH = O_SKW + (size_t)DBATCH * 512 * 512, O_SRC = O_SRH + DBATCH * 1024,
    O_SFC = O_SRC + DBATCH * 3 * 1024, O_END = O_SFC + (size_t)DBATCH * 2 * DFF;

constexpr size_t MiB = 1u << 20;
constexpr size_t WS_CTL = 0, CTL_ZERO_BYTES = 1 * MiB;
constexpr size_t WS_SS2 = 1265 * MiB, WS_SS3 = 1268 * MiB;
constexpr size_t WS_RSTD1 = 1 * MiB, WS_POSB = 1 * MiB + 128 * 1024, WS_POSP = 1 * MiB + 256 * 1024;
constexpr size_t WS_W1T = 2 * MiB, WS_WPR = 37 * MiB, WS_WPA = 41 * MiB, WS_WO = 45 * MiB, WS_WG = 53 * MiB, WS_WU = 77 * MiB, WS_WD = 101 * MiB, WS_WC = 125 * MiB;
constexpr size_t WS_XB = 128 * MiB, WS_XR = 194 * MiB, WS_GG = 227 * MiB, WS_Q = 260 * MiB, WS_KVS = 293 * MiB, WS_KVW = 310 * MiB, WS_CC = 327 * MiB, WS_FS = 600 * MiB,
    WS_SGM = 668 * MiB, WS_GNSA = 800 * MiB, WS_Y = 803 * MiB, WS_OB = 836 * MiB, WS_OMIX = 869 * MiB, WS_T1 = 935 * MiB, WS_MB = 1001 * MiB, WS_XP1 = 1067 * MiB, WS_XB2 = 1199 * MiB,
    WS_END = 1271 * MiB;
constexpr size_t WS_GE = WS_MB, WS_G0 = WS_MB + 4 * MiB, WS_U0 = WS_MB + 8 * MiB;
constexpr size_t WS_SLAB = WS_T1, WS_SLAB2 = WS_OMIX;
constexpr size_t WS_GB = 128 * MiB, WS_UB = 326 * MiB, WS_ACT = 524 * MiB;
static_assert(WS_W1T + (size_t)N1 * 2048 * 2 <= WS_WPR && WS_WD + (size_t)2048 * 6144 * 2 <= WS_WC && WS_WC + (size_t)512 * 2048 * 2 <= WS_XB, "ws map weights");
static_assert(WS_XB + (size_t)M * 2048 * 2 <= WS_XR && WS_XR + (size_t)M * 1024 * 2 <= WS_GG && WS_Q + (size_t)M * 1024 * 2 <= WS_KVS && WS_KVS + (size_t)M * 512 * 2 <= WS_KVW && WS_KVW + (size_t)M * 512 * 2 <= WS_CC, "ws map act");
static_assert(WS_CC + (size_t)(NCU_UNITS * 256 + 8) * 2048 * 2 <= WS_FS && WS_FS + (size_t)NCU_UNITS * 65536 * 4 <= WS_SGM && WS_SGM + (size_t)M * 4096 * 2 <= WS_GNSA && WS_GNSA + (size_t)M * 32 * 4 <= WS_Y, "ws map 2");
static_assert(WS_Y + (size_t)M * 1024 * 2 <= WS_OB && WS_OB + (size_t)M * 1024 * 2 <= WS_OMIX && WS_OMIX + (size_t)M * 1024 * 4 <= WS_T1 && WS_T1 + (size_t)M * 2048 * 2 <= WS_MB && WS_MB + (size_t)M * 2048 * 2 <= WS_XP1, "ws map 3");
static_assert(WS_XP1 + (size_t)M * 2048 * 4 <= WS_XB2 && WS_XB2 + (size_t)M * 2048 * 2 <= WS_SS2 && WS_SS2 + (size_t)M * 128 <= WS_SS3 && WS_SS3 + (size_t)M * 128 <= WS_END && WS_ACT + (size_t)M * DFF * 2 <= WS_GNSA && WS_GB + (size_t)M * DFF * 2 <= WS_UB && WS_UB + (size_t)M * DFF * 2 <= WS_ACT, "ws map 4");
constexpr int CW_BAR = 4096, CW_QUEUE = 64;

constexpr int RING_BYTES = 131072, MISC_OFF = RING_BYTES + 320, XL_OFF = RING_BYTES + 1024, LDS_BYTES = 147456;

__device__ __forceinline__ unsigned pk2(float lo, float hi) { return pg8::cvt_pk_bf16(lo, hi); }
__device__ __forceinline__ float bf2f(unsigned short b) { return __uint_as_float(((unsigned)b) << 16); }
__device__ __forceinline__ float bflo(unsigned w) { return __uint_as_float(w << 16); }
__device__ __forceinline__ float bfhi(unsigned w) { return __uint_as_float(w & 0xffff0000u); }
__device__ __forceinline__ float sigmoidf_(float v) { return __builtin_amdgcn_rcpf(1.0f + __builtin_amdgcn_exp2f(-1.4426950409f * v)); }
__device__ __forceinline__ float gelu_tanh(float x) { const float u = x * (1.0f + 0.044715f * x * x); return x * __builtin_amdgcn_rcpf(1.0f + __builtin_amdgcn_exp2f(-2.302208198f * u)); }
__device__ __forceinline__ float wave_sum(float v) {
    v += __int_as_float(__builtin_amdgcn_update_dpp(0, __float_as_int(v), 0xB1, 0xf, 0xf, true));
    v += __int_as_float(__builtin_amdgcn_update_dpp(0, __float_as_int(v), 0x4E, 0xf, 0xf, true));
    v += __int_as_float(__builtin_amdgcn_update_dpp(0, __float_as_int(v), 0x141, 0xf, 0xf, true));
    v += __int_as_float(__builtin_amdgcn_update_dpp(0, __float_as_int(v), 0x140, 0xf, 0xf, true));
    v += __shfl_xor(v, 16); v += __shfl_xor(v, 32);
    return v;
}
__device__ __forceinline__ u32x4 pack8u(f32x4 a, f32x4 b) { u32x4 w = {pk2(a[0], a[1]), pk2(a[2], a[3]), pk2(b[0], b[1]), pk2(b[2], b[3])}; return w; }

#define XB_TMO      128
#define XB_XCNT(j)  (256  + 64 * (j))
#define XB_XSUB(j)  (1280 + 64 * (j))
#define XB_XGEN(j)  (2304 + 64 * (j))
#define XB_TOP      3328
#define XB_TOPGEN   3392
#define XCD_BAR_WORDS 3456
#define XB_SPIN_CAP (1u << 18)
__device__ __forceinline__ unsigned xb_ld(unsigned* p)              { return __hip_atomic_load(p, __ATOMIC_RELAXED, __HIP_MEMORY_SCOPE_AGENT); }
__device__ __forceinline__ unsigned xb_add(unsigned* p, unsigned v) { return __hip_atomic_fetch_add(p, v, __ATOMIC_RELAXED, __HIP_MEMORY_SCOPE_AGENT); }
__device__ __forceinline__ unsigned xb_xcc_id() { return (unsigned)__builtin_amdgcn_s_getreg((3 << 11) | 20) & 0xFu; }
#define XB_SPIN(cond, bar) do { unsigned _sp = 0; while (cond) { __builtin_amdgcn_s_sleep(1); \
    if ((++_sp & 255u) == 0u) { if (xb_ld(&(bar)[XB_TMO])) break; if (_sp > XB_SPIN_CAP) { atomicAdd(&(bar)[XB_TMO], 1u); break; } } } } while (0)
struct XcdBarrier { unsigned* bar; unsigned x; volatile LAS unsigned* st; };
__device__ __forceinline__ XcdBarrier xcd_barrier_post(unsigned* bar, volatile LAS unsigned* st) {
    XcdBarrier b; b.bar = bar; b.x = xb_xcc_id(); b.st = st;
    if (threadIdx.x == 0) (void)xb_add(&bar[XB_XCNT(b.x)], 1u);
    return b;
}
__device__ __forceinline__ void xcd_barrier_complete(unsigned* bar, unsigned x, unsigned& nloc, unsigned& nx) {
    const unsigned G = gridDim.x * gridDim.y * gridDim.z;
    unsigned sum, cnt, mine, sp = 0u;
    for (;;) {
        sum = 0u; cnt = 0u; mine = 0u;
#pragma unroll
        for (unsigned j = 0; j < 16; ++j) { const unsigned c = xb_ld(&bar[XB_XCNT(j)]); sum += c; cnt += (c > 0u) ? 1u : 0u; mine = (j == x) ? c : mine; }
        if (sum == G) break;
        __builtin_amdgcn_s_sleep(1);
        if ((++sp & 255u) == 0u) { if (xb_ld(&bar[XB_TMO])) break; if (sp > XB_SPIN_CAP) { atomicAdd(&bar[XB_TMO], 1u); break; } }
    }
    nloc = mine > 0u ? mine : 1u; nx = cnt > 0u ? cnt : 1u;
}
__device__ __forceinline__ void xcd_barrier(const XcdBarrier& b) {
    asm volatile("s_waitcnt vmcnt(0)" ::: "memory");
    __syncthreads();
    if (threadIdx.x == 0) {
        unsigned* bar = b.bar;
        __builtin_amdgcn_s_waitcnt(0);
        unsigned nloc = b.st[0], nx = b.st[1];
        if (nloc == 0u) { xcd_barrier_complete(bar, b.x, nloc, nx); b.st[0] = nloc; b.st[1] = nx; }
        const unsigned old = xb_add(&bar[XB_XSUB(b.x)], 1u);
        const unsigned gen = old / nloc;
        if (old + 1u == (gen + 1u) * nloc) {
            __builtin_amdgcn_fence(__ATOMIC_RELEASE, "agent");
            asm volatile("s_waitcnt vmcnt(0)" ::: "memory");
            const unsigned og = xb_add(&bar[XB_TOP], 1u);
            const unsigned tg = og / nx;
            if (og + 1u == (tg + 1u) * nx) xb_add(&bar[XB_TOPGEN], 1u);
            else XB_SPIN(xb_ld(&bar[XB_TOPGEN]) == tg, bar);
            __builtin_amdgcn_fence(__ATOMIC_ACQUIRE, "agent");
            xb_add(&bar[XB_XGEN(b.x)], 1u);
            asm volatile("s_waitcnt vmcnt(0)" ::: "memory");
        } else {
            XB_SPIN(xb_ld(&bar[XB_XGEN(b.x)]) == gen, bar);
            __builtin_amdgcn_fence(__ATOMIC_ACQUIRE, "agent");
            asm volatile("s_waitcnt vmcnt(0)" ::: "memory");
        }
    }
    __syncthreads();
}

struct Args { const void* in[30]; float* out; unsigned char* ws; int ph_lo, ph_hi, qlo, qhi; };
struct Frame {
    int tid, lane, wave, G, bid;
    const float *x_p, *x_s, *c_cmp, *c_slc, *c_win, *st_h, *st_conv, *st_ffn; const int* pt;
    const float *norm_mix, *w_in, *rconv_w, *rconv_b, *rwa, *rba, *rwx, *rbx, *rlam, *cmp_w, *cmp_pos, *w_pr, *w_pa, *w_out, *norm_ffn, *w_gate, *w_up, *fconv_w, *fconv_b, *w_down, *norm_final;
    float* out; unsigned char* ws;
};
#define WSP(T, off) ((T*)(F.ws + (off)))

struct TrDesc { const float* src; const float* ks; bf16_t* dst; int ldw, ldk; };
__device__ __forceinline__ TrDesc tr_mk(const float* W, int ldw, int k0, int c0, const float* kscale, bf16_t* WT, int ldk, int dst_row0, int dst_k0) {
    TrDesc d; d.src = W + (size_t)k0 * ldw + c0; d.ks = kscale ? kscale + k0 : nullptr; d.dst = WT + (size_t)dst_row0 * ldk + dst_k0; d.ldw = ldw; d.ldk = ldk; return d; }
constexpr int TR_IN = 32 * (N1 / 32), TR_PR = 16 * 64, TR_O = 32 * 64, TR_G = 32 * 192, TR_D = 96 * 64, TR_C = 2 * 64 * 4;
constexpr int TR_A1 = TR_IN, TR_A2 = TR_A1 + 2 * TR_PR + TR_O, TR_A3 = TR_A2 + 2 * TR_G, TR_A4 = TR_A3 + TR_D, TR_A5 = TR_A4 + TR_C;
constexpr int TR_GDEF = 2048;
__device__ __forceinline__ TrDesc tr_desc(const Frame& F, int r) {
    if (r < TR_IN) { const int nblk = N1 / 32, kb = r / nblk, nb = r % nblk, n0 = nb * 32; const int src = n0 < 4608 ? n0 : n0 + 24;
        return tr_mk(F.w_in, 8728, kb * 64, src, F.norm_mix, WSP(bf16_t, WS_W1T), 2048, n0, kb * 64); } r -= TR_IN;
    if (r < TR_PR) { const int kb = r / 64, nb = r % 64; return tr_mk(F.w_pr, 2048, kb * 64, nb * 32, nullptr, WSP(bf16_t, WS_WPR), 1024, nb * 32, kb * 64); } r -= TR_PR;
    if (r < TR_PR) { const int kb = r / 64, nb = r % 64; return tr_mk(F.w_pa, 2048, kb * 64, nb * 32, nullptr, WSP(bf16_t, WS_WPA), 1024, nb * 32, kb * 64); } r -= TR_PR;
    if (r < TR_O) { const int kb = r / 64, nb = r % 64; return tr_mk(F.w_out, 2048, kb * 64, nb * 32, nullptr, WSP(bf16_t, WS_WO), 2048, nb * 32, kb * 64); } r -= TR_O;
    if (r < TR_G) { const int kb = r / 192, nb = r % 192; return tr_mk(F.w_gate, DFF, kb * 64, nb * 32, F.norm_ffn, WSP(bf16_t, WS_WG), 2048, (nb >> 2) * 256 + (nb & 3) * 32, kb * 64); } r -= TR_G;
    if (r < TR_G) { const int kb = r / 192, nb = r % 192; return tr_mk(F.w_up, DFF, kb * 64, nb * 32, F.norm_ffn, WSP(bf16_t, WS_WG), 2048, (nb >> 2) * 256 + 128 + (nb & 3) * 32, kb * 64); } r -= TR_G;
    if (r < TR_D) { const int kb = r / 64, nb = r % 64; return tr_mk(F.w_down, 2048, kb * 64, nb * 32, nullptr, WSP(bf16_t, WS_WD), DFF, nb * 32, kb * 64); } r -= TR_D;
    { const int c = r / 256, rr = r % 256, kb = rr / 4, nb = rr % 4, k0 = kb * 64, lw = k0 >> 7;
      return tr_mk(F.cmp_w + (size_t)c * 4096 * 128, 128, k0, nb * 32, nullptr, WSP(bf16_t, WS_WC), 2048, c * 256 + (lw >> 4) * 128 + nb * 32, (lw & 15) * 128 + (k0 & 127)); }
}
__device__ __forceinline__ void tr_load(const TrDesc& d, float (&tv)[32], f32x4 (&ks)[2], int lane) {
    const float* p = d.src + (size_t)(lane >> 5) * d.ldw + (lane & 31);
#pragma unroll
    for (int i = 0; i < 32; ++i) tv[i] = p[(size_t)(2 * i) * d.ldw];
    if (d.ks) { ks[0] = *(const f32x4*)(d.ks + 8 * (lane & 7)); ks[1] = *(const f32x4*)(d.ks + 8 * (lane & 7) + 4); } else { ks[0] = (f32x4){1.f, 1.f, 1.f, 1.f}; ks[1] = ks[0]; }
}
__device__ __forceinline__ void tr_store(const TrDesc& d, const float (&tv)[32], const f32x4 (&ks)[2], LAS float* scr, int lane) {
#pragma unroll
    for (int i = 0; i < 32; ++i) scr[(2 * i + (lane >> 5)) * 33 + (lane & 31)] = tv[i];
    asm volatile("s_waitcnt lgkmcnt(0)" ::: "memory");
    const int c = lane & 7;
#pragma unroll
    for (int j4 = 0; j4 < 4; ++j4) { const int n = (lane >> 3) + 8 * j4; const LAS float* s = scr + (8 * c) * 33 + n;
        u32x4 o; o.x = pk2(s[0 * 33] * ks[0].x, s[1 * 33] * ks[0].y); o.y = pk2(s[2 * 33] * ks[0].z, s[3 * 33] * ks[0].w); o.z = pk2(s[4 * 33] * ks[1].x, s[5 * 33] * ks[1].y); o.w = pk2(s[6 * 33] * ks[1].z, s[7 * 33] * ks[1].w);
        *(u32x4*)(d.dst + (size_t)n * d.ldk + 8 * c) = o; }
    asm volatile("s_waitcnt lgkmcnt(0)" ::: "memory");
}
__device__ __forceinline__ int tr_map(int v, int mode) { return mode == 0 ? v : v < TR_IN ? v : v < TR_IN + (2 * TR_G - TR_GDEF) ? v - TR_IN + TR_A2 + TR_GDEF : v - (TR_IN + 2 * TR_G - TR_GDEF) + TR_A4; }
__device__ __forceinline__ void tr_run(const Frame& F, LAS float* scr, int lane, int first, int step, int end, int mode) {
    int v = first; if (v >= end) return;
    TrDesc d = tr_desc(F, tr_map(v, mode)); float tv[32]; f32x4 ks[2]; tr_load(d, tv, ks, lane);
#pragma unroll 1
    for (;;) { const int vn = v + step; const bool more = vn < end;
        const TrDesc dn = tr_desc(F, tr_map(more ? vn : v, mode)); float tn[32]; f32x4 kn[2]; tr_load(dn, tn, kn, lane);
        tr_store(d, tv, ks, scr, lane);
        if (!more) break;
        d = dn; v = vn; ks[0] = kn[0]; ks[1] = kn[1];
#pragma unroll
        for (int i = 0; i < 32; ++i) tv[i] = tn[i]; }
}
__device__ __forceinline__ void tr_deferred(const Frame& F, unsigned char* ldsg, int lo, int hi, int wg_lo, int wg_hi) {
    if (wg_lo >= wg_hi) { wg_lo = 0; wg_hi = F.G; }
    if (F.bid < wg_lo || F.bid >= wg_hi) return;
    LAS float* scr = (LAS float*)((LAS unsigned char*)ldsg + F.wave * 16384);
    tr_run(F, scr, F.lane, lo + (F.bid - wg_lo) * 8 + F.wave, (wg_hi - wg_lo) * 8, hi, 0);
}
constexpr int CC_EARLY = 24;
__device__ __forceinline__ void cc_item(const Frame& F, int it, int lane) { bf16_t* CC = WSP(bf16_t, WS_CC);
    const int db = it >> 7, n = it & 127; const int phys = F.pt[db * 16 + (n >> 3)];
    const float* src = F.c_cmp + ((size_t)phys * 128 + (n & 7) * 16) * 512 + lane * 4; const int g = lane >> 5, d = (lane & 31) * 4;
#pragma unroll 1
    for (int l0 = 0; l0 < 16; l0 += 8) { f32x4 t[16];
#pragma unroll
        for (int u = 0; u < 16; ++u) t[u] = *(const f32x4*)(src + (l0 + (u >> 1)) * 512 + (u & 1) * 256);
#pragma unroll
        for (int u = 0; u < 16; ++u) { u32x2 w; w.x = pk2(t[u].x, t[u].y); w.y = pk2(t[u].z, t[u].w);
            *(u32x2*)(CC + ((size_t)((db * 2 + (u & 1)) * 256 + g * 128 + n)) * 2048 + (l0 + (u >> 1)) * 128 + d) = w; } }
}
__device__ __forceinline__ void p0_prologue(const Frame& F, unsigned char* ldsg, const int skipmask) {
    LAS float* scr = (LAS float*)((LAS unsigned char*)ldsg + F.wave * 16384);
    const int gw = F.bid * 8 + F.wave, NGW = F.G * 8, lane = F.lane;
    if (!(skipmask & 1)) { LAS bf16_t* WL = (LAS bf16_t*)ldsg; constexpr int WLS = 2056;
      { f32x4 wv[4][6];
#pragma unroll
        for (int r = 0; r < 4; ++r)
#pragma unroll
            for (int q = 0; q < 6; ++q) wv[r][q] = *(const f32x4*)(F.w_in + (size_t)(F.tid + 512 * r) * 8728 + 4608 + 4 * q);
#pragma unroll
        for (int r = 0; r < 4; ++r) { const int k = F.tid + 512 * r; const float nm = F.norm_mix[k];
#pragma unroll
            for (int q = 0; q < 6; ++q)
#pragma unroll
                for (int e = 0; e < 4; ++e) WL[(4 * q + e) * WLS + k] = (bf16_t)(pk2(wv[r][q][e] * nm, 0.f) & 0xffffu);
#pragma unroll
            for (int c = 24; c < 32; ++c) WL[c * WLS + k] = (bf16_t)0; } }
      __syncthreads();
      bf16_t* XB = WSP(bf16_t, WS_XB); float* RS = WSP(float, WS_RSTD1); float* GN = WSP(float, WS_GNSA);
      const int fr = lane & 15, fq = lane >> 4;
      if (F.wave >= 5 && !(skipmask & 4)) { const int ipw = (DBATCH * 128 + F.G - 1) / F.G, lo = F.bid * ipw, hi0 = (lo + ipw) < DBATCH * 128 ? (lo + ipw) : DBATCH * 128, hi = (lo + CC_EARLY) < hi0 ? (lo + CC_EARLY) : hi0;
          for (int it = lo + (F.wave - 5); it < hi; it += 3) cc_item(F, it, lane); }
      for (int grp = F.wave * F.G + F.bid; grp < M / 16; grp += NGW) { const int m0 = grp * 16, m = m0 + fr;
          const float* xrow = ((m < MP) ? F.x_p + (size_t)m * DM : F.x_s + (size_t)(m - MP) * DM) + 8 * fq;
          bf16_t* xb = XB + (size_t)m * DM + 8 * fq; const LAS bf16_t* w0 = WL + fr * WLS + 8 * fq; const LAS bf16_t* w1 = w0 + 16 * WLS;
          f32x4 a0 = {0.f, 0.f, 0.f, 0.f}, a1 = {0.f, 0.f, 0.f, 0.f}; float ss = 0.f;
          f32x4 cur[16], nxt[16];
#pragma unroll
          for (int j = 0; j < 8; ++j) { cur[2 * j] = *(const f32x4*)(xrow + 32 * j); cur[2 * j + 1] = *(const f32x4*)(xrow + 32 * j + 4); }
#pragma unroll 1
          for (int b = 0; b < 8; ++b) { const int bn = b < 7 ? b + 1 : 7;
#pragma unroll
              for (int j = 0; j < 8; ++j) { nxt[2 * j] = *(const f32x4*)(xrow + 256 * bn + 32 * j); nxt[2 * j + 1] = *(const f32x4*)(xrow + 256 * bn + 32 * j + 4); }
#pragma unroll
              for (int j = 0; j < 8; ++j) { const f32x4 p = cur[2 * j], q = cur[2 * j + 1];
                  ss += (p.x * p.x + p.y * p.y) + (p.z * p.z + p.w * p.w) + (q.x * q.x + q.y * q.y) + (q.z * q.z + q.w * q.w);
                  const u32x4 pk = pack8u(p, q); *(u32x4*)(xb + 256 * b + 32 * j) = pk; const bf16x8 af = __builtin_bit_cast(bf16x8, pk);
                  const bf16x8 b0 = *(const LAS bf16x8*)(w0 + 256 * b + 32 * j), b1 = *(const LAS bf16x8*)(w1 + 256 * b + 32 * j);
                  a0 = __builtin_amdgcn_mfma_f32_16x16x32_bf16(af, b0, a0, 0, 0, 0); a1 = __builtin_amdgcn_mfma_f32_16x16x32_bf16(af, b1, a1, 0, 0, 0); }
#pragma unroll
              for (int j = 0; j < 16; ++j) cur[j] = nxt[j]; }
          ss += __shfl_xor(ss, 16); ss += __shfl_xor(ss, 32);
          const float rstd = 1.0f / sqrtf(ss * (1.0f / DM) + EPS);
          if (fq == 0) RS[m] = rstd;
#pragma unroll
          for (int i = 0; i < 4; ++i) { const float rsr = __shfl(rstd, 4 * fq + i);
              GN[(size_t)(m0 + 4 * fq + i) * 32 + fr] = sigmoidf_(a0[i] * rsr); GN[(size_t)(m0 + 4 * fq + i) * 32 + 16 + fr] = sigmoidf_(fr < 8 ? a1[i] * rsr : 0.f); } }
      __syncthreads(); }
    if (!(skipmask & 2)) { constexpr int NV = TR_IN + (2 * TR_G - TR_GDEF) + TR_C; tr_run(F, scr, lane, gw, NGW, NV, 1); }
    if (!(skipmask & 4)) { const int ipw = (DBATCH * 128 + F.G - 1) / F.G, lo = F.bid * ipw, hi = (lo + ipw) < DBATCH * 128 ? (lo + ipw) : DBATCH * 128;
      for (int it = lo + CC_EARLY + F.wave; it < hi; it += 8) cc_item(F, it, lane); }
    if (F.tid < 256) { const int c = F.tid >> 7, e2 = F.tid & 127, kb = F.bid * (4096 / F.G), ke = kb + 4096 / F.G; float s = 0.f;
        const float* pw = F.cmp_w + (size_t)c * 4096 * 128 + e2; const float* pp = F.cmp_pos + c * 4096;
#pragma unroll 8
        for (int k = kb; k < ke; ++k) s += pp[k] * pw[(size_t)k * 128];
        WSP(float, WS_POSP)[F.bid * 256 + F.tid] = s; }
}

#define EPI_ROWS(r_) _Pragma("unroll") for (int ai = 0; ai < 2; ++ai) _Pragma("unroll") for (int m = 0; m < 4; ++m) { const int r_ = row0 + ai * 128 + m * 16;
#define EPI_COLS(c_) _Pragma("unroll") for (int bj = 0; bj < 2; ++bj) { const int c_ = col0 + bj * 128; f32x4 v0 = acc[ai][bj][m][0], v1 = acc[ai][bj][m][1];
#define EPI_END } }
#define EPI_PIN(x) asm volatile("" : "+v"(x))
__device__ __forceinline__ void st_bf8(bf16_t* p, f32x4 a, f32x4 b) { *(u32x4*)p = pack8u(a, b); }
__device__ __forceinline__ void st_f8(float* p, f32x4 a, f32x4 b) { *(f32x4*)p = a; *(f32x4*)(p + 4) = b; }

struct EpiIn {
    static constexpr bool PERM = true, AFTER_DRAIN = false, MIDK = false;
    const float* rstd; bf16_t *XR, *GG, *Q, *KVS, *KVW, *CC, *SGM; float* GNSA; float* out; int skip;
    __device__ __forceinline__ void operator()(const f32x4 (&acc)[2][2][4][2], const Unit& u, int wr, int wc, int fr, int fq) const {
        if (skip) { if (acc[0][0][0][0].x == 123456.789f) out[0] = 1.f; return; }
        const int row0 = u.pm * 256 + wr * 64 + fr, col0 = u.pn * 256 + wc * 32 + 8 * fq, pn = u.pn; const bool samp = u.pm >= 64;
        float rsv[2][4];
#pragma unroll
        for (int ai = 0; ai < 2; ++ai)
#pragma unroll
            for (int m = 0; m < 4; ++m) rsv[ai][m] = rstd[row0 + ai * 128 + m * 16];
#pragma unroll
        for (int ai = 0; ai < 2; ++ai)
#pragma unroll
            for (int m = 0; m < 4; ++m) EPI_PIN(rsv[ai][m]);
        EPI_ROWS(r) const float rs = rsv[ai][m];
            EPI_COLS(c) v0 *= rs; v1 *= rs;
                if (pn < 4) { st_bf8(XR + (size_t)r * 1024 + c, v0, v1);
                    if (!samp) { const int t = r & 2047; if (t >= 2045) st_f8(out + O_PRC + (size_t)((r >> 11) * 3 + (t - 2045)) * 1024 + c, v0, v1); }
                    else { const int tq = r & 3; if (tq >= 1) st_f8(out + O_SRC + (size_t)(((r - MP) >> 2) * 3 + tq - 1) * 1024 + c, v0, v1); } }
                else if (pn < 8) { f32x4 a, b;
#pragma unroll
                    for (int j = 0; j < 4; ++j) { a[j] = gelu_tanh(v0[j]); b[j] = gelu_tanh(v1[j]); }
                    st_bf8(GG + (size_t)r * 1024 + (c - 1024), a, b); }
                else if (pn < 12) { st_bf8(Q + (size_t)r * 1024 + (c - 2048), v0, v1); }
                else if (pn < 14) { const int cc = c - 3072;
                    if (!samp) { st_f8(out + O_PKC + (size_t)r * 512 + cc, v0, v1); const int t = r & 2047, b = r >> 11;
                        st_bf8(CC + ((size_t)((256 + b * 2 + (cc >> 8)) * 256 + ((cc >> 7) & 1) * 128 + (t >> 4))) * 2048 + (t & 15) * 128 + (cc & 127), v0, v1); }
                    else st_f8(out + O_SKC + (size_t)(r - MP) * 512 + cc, v0, v1); }
                else if (pn < 16) { const int cc = c - 3584; st_bf8(KVS + (size_t)r * 512 + cc, v0, v1);
                    if (!samp) st_f8(out + O_PKS + (size_t)r * 512 + cc, v0, v1); else st_f8(out + O_SKS + (size_t)(r - MP) * 512 + cc, v0, v1); }
                else if (pn < 18) { const int cc = c - 4096; st_bf8(KVW + (size_t)r * 512 + cc, v0, v1);
                    if (!samp) { const int t = r & 2047; if (t >= 1536) st_f8(out + O_PKW + (size_t)((r >> 11) * 512 + t - 1536) * 512 + cc, v0, v1); }
                    else { const int q = r - MP; st_f8(out + O_SKW + (size_t)((q >> 2) * 512 + 508 + (q & 3)) * 512 + cc, v0, v1); } }
                else { f32x4 a, b;
#pragma unroll
                    for (int j = 0; j < 4; ++j) { a[j] = sigmoidf_(v0[j]); b[j] = sigmoidf_(v1[j]); }
                    st_bf8(SGM + (size_t)r * 4096 + (c - 4608), a, b); }
            EPI_END
    }
};
struct EpiFS {
    static constexpr bool PERM = false, AFTER_DRAIN = false, MIDK = false;
    float* FS;
    __device__ __forceinline__ void operator()(const f32x4 (&acc)[2][2][4][2], const Unit& u, int wr, int wc, int fr, int fq) const {
        float* base = FS + (size_t)u.pm * 65536 + (size_t)(wr * 64 + fr) * 256 + wc * 32 + 4 * fq;
#pragma unroll
        for (int ai = 0; ai < 2; ++ai)
#pragma unroll
            for (int m = 0; m < 4; ++m)
#pragma unroll
                for (int bj = 0; bj < 2; ++bj)
#pragma unroll
                    for (int n = 0; n < 2; ++n) *(f32x4*)(base + (size_t)(ai * 128 + m * 16) * 256 + bj * 128 + n * 16) = acc[ai][bj][m][n];
    }
};
template <int PASS> struct EpiProj {
    static constexpr bool PERM = true, AFTER_DRAIN = false, MIDK = false;
    const bf16_t* SGM; bf16_t* T1; bf16_t* MB;
    __device__ __forceinline__ void operator()(const f32x4 (&acc)[2][2][4][2], const Unit& u, int wr, int wc, int fr, int fq) const {
        const int row0 = u.pm * 256 + wr * 64 + fr, col0 = u.pn * 256 + wc * 32 + 8 * fq;
#pragma unroll
        for (int ai = 0; ai < 2; ++ai) { u32x4 gw[4][2], tw[4][2];
#pragma unroll
            for (int m = 0; m < 4; ++m)
#pragma unroll
                for (int bj = 0; bj < 2; ++bj) { const size_t r = (size_t)(row0 + ai * 128 + m * 16); const int c = col0 + bj * 128; gw[m][bj] = *(const u32x4*)(SGM + r * 4096 + PASS * 2048 + c);
                    if (PASS == 1) tw[m][bj] = *(const u32x4*)(T1 + r * 2048 + c); }
#pragma unroll
            for (int m = 0; m < 4; ++m)
#pragma unroll
                for (int bj = 0; bj < 2; ++bj) { EPI_PIN(gw[m][bj]); if (PASS == 1) EPI_PIN(tw[m][bj]); }
#pragma unroll
            for (int m = 0; m < 4; ++m)
#pragma unroll
                for (int bj = 0; bj < 2; ++bj) { const size_t r = (size_t)(row0 + ai * 128 + m * 16); const int c = col0 + bj * 128; const u32x4 g_ = gw[m][bj];
                    const f32x4 g0 = {bflo(g_.x), bfhi(g_.x), bflo(g_.y), bfhi(g_.y)}, g1 = {bflo(g_.z), bfhi(g_.z), bflo(g_.w), bfhi(g_.w)};
                    f32x4 v0 = acc[ai][bj][m][0] * g0, v1 = acc[ai][bj][m][1] * g1;
                    if (PASS == 0) st_bf8(T1 + r * 2048 + c, v0, v1);
                    else { const u32x4 t_ = tw[m][bj]; v0 += (f32x4){bflo(t_.x), bfhi(t_.x), bflo(t_.y), bfhi(t_.y)}; v1 += (f32x4){bflo(t_.z), bfhi(t_.z), bflo(t_.w), bfhi(t_.w)};
                        st_bf8(MB + r * 2048 + c, v0, v1); } } }
    }
};
struct EpiProjM {
    static constexpr bool PERM = true, AFTER_DRAIN = false, MIDK = true;
    const bf16_t* SGM; bf16_t* MB;
    __device__ __forceinline__ void mid(f32x4 (&acc)[2][2][4][2], const Unit& u, int wr, int wc, int fr, int fq) const {
        asm volatile("" : "+v"(fr), "+v"(fq));
        const int row0 = u.pm * 256 + wr * 64 + fr, col0 = u.pn * 256 + wc * 32 + 8 * fq;
#pragma unroll
        for (int ai = 0; ai < 2; ++ai) { u32x4 gr[4][2], ga[4][2];
#pragma unroll
            for (int m = 0; m < 4; ++m)
#pragma unroll
                for (int bj = 0; bj < 2; ++bj) { const bf16_t* p = SGM + (size_t)(row0 + ai * 128 + m * 16) * 4096 + col0 + bj * 128; gr[m][bj] = *(const u32x4*)p; ga[m][bj] = *(const u32x4*)(p + 2048); }
#pragma unroll
            for (int m = 0; m < 4; ++m)
#pragma unroll
                for (int bj = 0; bj < 2; ++bj) { EPI_PIN(gr[m][bj]); EPI_PIN(ga[m][bj]); }
#pragma unroll
            for (int m = 0; m < 4; ++m)
#pragma unroll
                for (int bj = 0; bj < 2; ++bj) { const u32x4 r_ = gr[m][bj], a_ = ga[m][bj];
                    const f32x4 r0 = {bflo(r_.x), bfhi(r_.x), bflo(r_.y), bfhi(r_.y)}, r1 = {bflo(r_.z), bfhi(r_.z), bflo(r_.w), bfhi(r_.w)};
                    f32x4 a0 = {bflo(a_.x), bfhi(a_.x), bflo(a_.y), bfhi(a_.y)}, a1 = {bflo(a_.z), bfhi(a_.z), bflo(a_.w), bfhi(a_.w)};
#pragma unroll
                    for (int j = 0; j < 4; ++j) { a0[j] = __builtin_amdgcn_rcpf(fmaxf(a0[j], 1e-20f)); a1[j] = __builtin_amdgcn_rcpf(fmaxf(a1[j], 1e-20f)); }
                    acc[ai][bj][m][0] *= r0 * a0; acc[ai][bj][m][1] *= r1 * a1; } }
    }
    __device__ __forceinline__ void operator()(const f32x4 (&acc)[2][2][4][2], const Unit& u, int wr, int wc, int fr, int fq) const {
        const int row0 = u.pm * 256 + wr * 64 + fr, col0 = u.pn * 256 + wc * 32 + 8 * fq;
#pragma unroll
        for (int ai = 0; ai < 2; ++ai) { u32x4 ga[4][2];
#pragma unroll
            for (int m = 0; m < 4; ++m)
#pragma unroll
                for (int bj = 0; bj < 2; ++bj) ga[m][bj] = *(const u32x4*)(SGM + (size_t)(row0 + ai * 128 + m * 16) * 4096 + 2048 + col0 + bj * 128);
#pragma unroll
            for (int m = 0; m < 4; ++m)
#pragma unroll
                for (int bj = 0; bj < 2; ++bj) EPI_PIN(ga[m][bj]);
#pragma unroll
            for (int m = 0; m < 4; ++m)
#pragma unroll
                for (int bj = 0; bj < 2; ++bj) { const u32x4 a_ = ga[m][bj]; f32x4 a0 = {bflo(a_.x), bfhi(a_.x), bflo(a_.y), bfhi(a_.y)}, a1 = {bflo(a_.z), bfhi(a_.z), bflo(a_.w), bfhi(a_.w)};
#pragma unroll
                    for (int j = 0; j < 4; ++j) { a0[j] = fmaxf(a0[j], 1e-20f); a1[j] = fmaxf(a1[j], 1e-20f); }
                    st_bf8(MB + (size_t)(row0 + ai * 128 + m * 16) * 2048 + col0 + bj * 128, acc[ai][bj][m][0] * a0, acc[ai][bj][m][1] * a1); } }
    }
};
struct EpiOut {
    static constexpr bool PERM = true, AFTER_DRAIN = false, MIDK = false;
    const bf16_t* XB; bf16_t* XB2; float* SS;
    __device__ __forceinline__ void operator()(const f32x4 (&acc)[2][2][4][2], const Unit& u, int wr, int wc, int fr, int fq) const {
        const int row0 = u.pm * 256 + wr * 64 + fr, col0 = u.pn * 256 + wc * 32 + 8 * fq;
#pragma unroll
        for (int ai = 0; ai < 2; ++ai) { u32x4 xw[4][2];
#pragma unroll
            for (int m = 0; m < 4; ++m)
#pragma unroll
                for (int bj = 0; bj < 2; ++bj) xw[m][bj] = *(const u32x4*)(XB + (size_t)(row0 + ai * 128 + m * 16) * DM + col0 + bj * 128);
#pragma unroll
            for (int m = 0; m < 4; ++m)
#pragma unroll
                for (int bj = 0; bj < 2; ++bj) EPI_PIN(xw[m][bj]);
#pragma unroll
            for (int m = 0; m < 4; ++m) { const int r = row0 + ai * 128 + m * 16; float ss = 0.f;
#pragma unroll
                for (int bj = 0; bj < 2; ++bj) { const int c = col0 + bj * 128; const u32x4 w = xw[m][bj];
                    const f32x4 v0 = acc[ai][bj][m][0] + (f32x4){bflo(w.x), bfhi(w.x), bflo(w.y), bfhi(w.y)}, v1 = acc[ai][bj][m][1] + (f32x4){bflo(w.z), bfhi(w.z), bflo(w.w), bfhi(w.w)};
                    st_bf8(XB2 + (size_t)r * DM + c, v0, v1);
                    ss += (v0.x * v0.x + v0.y * v0.y) + (v0.z * v0.z + v0.w * v0.w) + (v1.x * v1.x + v1.y * v1.y) + (v1.z * v1.z + v1.w * v1.w); }
                ss += __shfl_xor(ss, 16); ss += __shfl_xor(ss, 32);
                if (fq == 0) SS[(size_t)r * 32 + u.pn * 4 + wc] = ss; } }
    }
};
__device__ __forceinline__ float dppf(float x, int ctrl_sel) {
    const int v = __float_as_int(x);
    const int r = ctrl_sel == 0 ? __builtin_amdgcn_update_dpp(0, v, 0x111, 0xf, 0xf, true) : ctrl_sel == 1 ? __builtin_amdgcn_update_dpp(0, v, 0x112, 0xf, 0xf, true)
                : ctrl_sel == 2 ? __builtin_amdgcn_update_dpp(0, v, 0x121, 0xf, 0xf, true) : __builtin_amdgcn_update_dpp(0, v, 0x122, 0xf, 0xf, true);
    return __int_as_float(r);
}
struct EpiFFN {
    static constexpr bool PERM = true, AFTER_DRAIN = false, MIDK = false;
    const float* SS; const float* cw; const float* cbias; const float* st_ffn; bf16_t* ACT; float* out; float* GE; float* G0; float* U0; LAS float* XL; int skip;
    __device__ __forceinline__ void operator()(const f32x4 (&acc)[2][2][4][2], const Unit& u, int wr, int wc, int fr, int fq) const {
        if (skip) { if (acc[0][0][0][0].x == 123456.789f) out[0] = 1.f; return; }
        const int row0 = u.pm * 256 + wr * 64 + fr, f0 = u.pn * 128 + wc * 32 + 8 * fq; const bool samp = u.pm >= 64;
        float w0[8], w1[8], w2[8], bb[8];
#pragma unroll
        for (int e = 0; e < 8; e += 4) { const f32x4 a = *(const f32x4*)(cw + f0 + e), b4 = *(const f32x4*)(cw + DFF + f0 + e), c4 = *(const f32x4*)(cw + 2 * DFF + f0 + e), d4 = *(const f32x4*)(cbias + f0 + e);
#pragma unroll
            for (int j = 0; j < 4; ++j) { w0[e + j] = a[j]; w1[e + j] = b4[j]; w2[e + j] = c4[j]; bb[e + j] = d4[j]; } }
        LAS float* RSL = XL + 1024;
        { const int tl = (((wr << 2) | wc) << 6) | (fq << 4) | fr, rr = tl >> 1, hh = tl & 1; const float* sp = SS + (size_t)(u.pm * 256 + rr) * 32 + hh * 16;
          const f32x4 a = *(const f32x4*)sp, b4 = *(const f32x4*)(sp + 4), c4 = *(const f32x4*)(sp + 8), d4 = *(const f32x4*)(sp + 12);
          float t = (((a.x + a.y) + (a.z + a.w)) + ((b4.x + b4.y) + (b4.z + b4.w))) + (((c4.x + c4.y) + (c4.z + c4.w)) + ((d4.x + d4.y) + (d4.z + d4.w)));
          t += __int_as_float(__builtin_amdgcn_update_dpp(0, __float_as_int(t), 0xB1, 0xf, 0xf, true));
          if (hh == 0) RSL[rr] = 1.0f / sqrtf(t * (1.0f / DM) + EPS); }
        LAS float* xw = XL + ((wr * 4 + wc) * 2) * 32 + 8 * fq;
#pragma unroll
        for (int ai = 0; ai < 2; ++ai) if (fr >= 14) { LAS float* p = xw + ai * (2 * 4 * 2 * 32) + (fr - 14) * 32; *(LAS f32x4*)p = acc[ai][0][3][0]; *(LAS f32x4*)(p + 4) = acc[ai][0][3][1]; }
        asm volatile("s_waitcnt lgkmcnt(0)\n\ts_barrier" ::: "memory");
        float rs[2][4];
#pragma unroll
        for (int ai = 0; ai < 2; ++ai)
#pragma unroll
            for (int m = 0; m < 4; ++m) rs[ai][m] = RSL[ai * 128 + wr * 64 + m * 16 + fr];
#pragma unroll
        for (int ai = 0; ai < 2; ++ai) {
            float x0[8], x1[8]; const int pb = ai * 2 + wr;
            if (pb > 0) { const LAS float* p = XL + (((pb - 1) * 4 + wc) * 2) * 32 + 8 * fq; const f32x4 a = *(const LAS f32x4*)p, b4 = *(const LAS f32x4*)(p + 4), c4 = *(const LAS f32x4*)(p + 32), d4 = *(const LAS f32x4*)(p + 36);
                const float sa = RSL[(pb - 1) * 64 + 62], sb = RSL[(pb - 1) * 64 + 63];
#pragma unroll
                for (int j = 0; j < 4; ++j) { x0[j] = a[j] * sa; x0[4 + j] = b4[j] * sa; x1[j] = c4[j] * sb; x1[4 + j] = d4[j] * sb; } }
            else {
#pragma unroll
                for (int j = 0; j < 8; ++j) { x0[j] = 0.f; x1[j] = 0.f; } }
            float gp[8];
#pragma unroll
            for (int j = 0; j < 8; ++j) gp[j] = 0.f;
#pragma unroll
            for (int m = 0; m < 4; ++m) { const int r = row0 + ai * 128 + m * 16; const float s = rs[ai][m];
                float g[8], uu[8], q1[8], q2[8];
#pragma unroll
                for (int j = 0; j < 4; ++j) { g[j] = acc[ai][0][m][0][j] * s; g[4 + j] = acc[ai][0][m][1][j] * s; uu[j] = acc[ai][1][m][0][j] * s; uu[4 + j] = acc[ai][1][m][1][j] * s; }
#pragma unroll
                for (int j = 0; j < 8; ++j) {
                    if (m == 0) { const float s1 = dppf(g[j], 0), s2 = dppf(g[j], 1); q1[j] = (fr == 0) ? x1[j] : s1; q2[j] = (fr == 0) ? x0[j] : (fr == 1) ? x1[j] : s2; }
                    else { const float r1 = dppf(gp[j], 2), r2 = dppf(gp[j], 3);
                        q1[j] = __int_as_float(__builtin_amdgcn_update_dpp(__float_as_int(r1), __float_as_int(g[j]), 0x111, 0xf, 0xf, false));
                        q2[j] = __int_as_float(__builtin_amdgcn_update_dpp(__float_as_int(r2), __float_as_int(g[j]), 0x112, 0xf, 0xf, false)); } }
                if (samp) { const int qq = r - MP, tq = qq & 3;
                    if (tq < 2) { const float* sp = st_ffn + (size_t)(qq >> 2) * 2 * DFF + f0; const f32x4 a = *(const f32x4*)(sp + DFF), b4 = *(const f32x4*)(sp + DFF + 4);
                        if (tq == 0) { const f32x4 c4 = *(const f32x4*)sp, d4 = *(const f32x4*)(sp + 4);
#pragma unroll
                            for (int j = 0; j < 4; ++j) { q1[j] = a[j]; q1[4 + j] = b4[j]; q2[j] = c4[j]; q2[4 + j] = d4[j]; } }
                        else {
#pragma unroll
                            for (int j = 0; j < 4; ++j) { q2[j] = a[j]; q2[4 + j] = b4[j]; } } }
                    if (tq >= 2) { float* op = out + O_SFC + (size_t)((qq >> 2) * 2 + tq - 2) * DFF + f0; *(f32x4*)op = (f32x4){g[0] * SC_SFC, g[1] * SC_SFC, g[2] * SC_SFC, g[3] * SC_SFC}; *(f32x4*)(op + 4) = (f32x4){g[4] * SC_SFC, g[5] * SC_SFC, g[6] * SC_SFC, g[7] * SC_SFC}; } }
                else { const int t = r & 2047; if (t >= 2046) { float* op = out + O_PFC + (size_t)((r >> 11) * 2 + t - 2046) * DFF + f0; *(f32x4*)op = (f32x4){g[0] * SC_PFC, g[1] * SC_PFC, g[2] * SC_PFC, g[3] * SC_PFC}; *(f32x4*)(op + 4) = (f32x4){g[4] * SC_PFC, g[5] * SC_PFC, g[6] * SC_PFC, g[7] * SC_PFC}; } }
                float ov[8];
#pragma unroll
                for (int j = 0; j < 8; j += 2) {
                    typedef float f32x2 __attribute__((ext_vector_type(2)));
                    const f32x2 W0 = {w0[j], w0[j + 1]}, W1 = {w1[j], w1[j + 1]}, W2 = {w2[j], w2[j + 1]}, BB = {bb[j], bb[j + 1]}, Q2 = {q2[j], q2[j + 1]}, Q1 = {q1[j], q1[j + 1]}, GG2 = {g[j], g[j + 1]}, UU = {uu[j], uu[j + 1]};
                    const f32x2 x = W2 * GG2 + (W1 * Q1 + (W0 * Q2 + BB));
                    const f32x2 t = (x * x) * 0.044715f + 1.0f, a2 = (x * t) * (-2.302208198f);
                    f32x2 ex; ex.x = __builtin_amdgcn_exp2f(a2.x); ex.y = __builtin_amdgcn_exp2f(a2.y);
                    const f32x2 dn = ex + 1.0f; f32x2 rc; rc.x = __builtin_amdgcn_rcpf(dn.x); rc.y = __builtin_amdgcn_rcpf(dn.y);
                    const f32x2 r2 = (x * rc) * UU; ov[j] = r2.x; ov[j + 1] = r2.y; }
                u32x4 o; o.x = pk2(ov[0], ov[1]); o.y = pk2(ov[2], ov[3]); o.z = pk2(ov[4], ov[5]); o.w = pk2(ov[6], ov[7]);
                *(u32x4*)(ACT + (size_t)r * DFF + f0) = o;
                if (ai == 1 && m == 3 && wr == 1 && fr >= 14) { float* p = GE + ((size_t)u.pm * 2 + (fr - 14)) * DFF + f0; *(f32x4*)p = (f32x4){g[0], g[1], g[2], g[3]}; *(f32x4*)(p + 4) = (f32x4){g[4], g[5], g[6], g[7]}; }
                if (ai == 0 && m == 0 && wr == 0 && fr < 2) { float* p = G0 + ((size_t)u.pm * 2 + fr) * DFF + f0; *(f32x4*)p = (f32x4){g[0], g[1], g[2], g[3]}; *(f32x4*)(p + 4) = (f32x4){g[4], g[5], g[6], g[7]};
                    float* p2 = U0 + ((size_t)u.pm * 2 + fr) * DFF + f0; *(f32x4*)p2 = (f32x4){uu[0], uu[1], uu[2], uu[3]}; *(f32x4*)(p2 + 4) = (f32x4){uu[4], uu[5], uu[6], uu[7]}; }
#pragma unroll
                for (int j = 0; j < 8; ++j) gp[j] = g[j];
            }
        }
    }
};
struct EpiDown {
    static constexpr bool PERM = false, AFTER_DRAIN = false, MIDK = false;
    const bf16_t* XB2; float* out; float* SS; int skip;
    __device__ __forceinline__ void operator()(const f32x4 (&acc)[2][2][4][2], const Unit& u, int wr, int wc, int fr, int fq) const {
        if (skip) { if (acc[0][0][0][0].x == 123456.789f) out[0] = 1.f; return; }
        const int row0 = u.pm * 256 + wr * 64 + fr, col0 = u.pn * 256 + wc * 32 + 4 * fq;
#pragma unroll
        for (int ai = 0; ai < 2; ++ai) { u32x2 xw[4][2][2];
#pragma unroll
            for (int m = 0; m < 4; ++m)
#pragma unroll
                for (int bj = 0; bj < 2; ++bj)
#pragma unroll
                    for (int n = 0; n < 2; ++n) xw[m][bj][n] = *(const u32x2*)(XB2 + (size_t)(row0 + ai * 128 + m * 16) * DM + col0 + bj * 128 + n * 16);
#pragma unroll
            for (int m = 0; m < 4; ++m)
#pragma unroll
                for (int bj = 0; bj < 2; ++bj)
#pragma unroll
                    for (int n = 0; n < 2; ++n) EPI_PIN(xw[m][bj][n]);
#pragma unroll
            for (int m = 0; m < 4; ++m) { const int r = row0 + ai * 128 + m * 16; float ss = 0.f;
#pragma unroll
                for (int bj = 0; bj < 2; ++bj)
#pragma unroll
                    for (int n = 0; n < 2; ++n) { const size_t o = (size_t)r * DM + col0 + bj * 128 + n * 16; const u32x2 w = xw[m][bj][n]; const f32x4 v = acc[ai][bj][m][n] + (f32x4){bflo(w.x), bfhi(w.x), bflo(w.y), bfhi(w.y)};
                        *(f32x4*)(out + o) = v; ss += (v.x * v.x + v.y * v.y) + (v.z * v.z + v.w * v.w); }
                ss += __shfl_xor(ss, 16); ss += __shfl_xor(ss, 32);
                if (fq == 0) SS[(size_t)r * 32 + u.pn * 4 + wc] = ss; } }
    }
};
template <int MODE  > struct EpiSlab {
    static constexpr bool PERM = false, AFTER_DRAIN = false, MIDK = false;
    float* SLAB; int kslice; const bf16_t* SGM;
    __device__ __forceinline__ void operator()(const f32x4 (&acc)[2][2][4][2], const Unit& u, int wr, int wc, int fr, int fq) const {
        int pm = u.pm, pn = u.pn, s = u.ko / kslice, pass = 0;
        if (MODE == 1 && pm >= 130) { pass = 1; pm -= 66; pn -= 8; s += 4; }
        float* base = SLAB + ((size_t)s * MS + (size_t)(pm - 64) * 256 + wr * 64 + fr) * DM + pn * 256 + wc * 32 + 4 * fq;
        const bf16_t* gb = SGM + (size_t)(pm * 256 + wr * 64 + fr) * 4096 + pass * 2048 + pn * 256 + wc * 32 + 4 * fq;
#pragma unroll
        for (int ai = 0; ai < 2; ++ai)
#pragma unroll
            for (int m = 0; m < 4; ++m)
#pragma unroll
                for (int bj = 0; bj < 2; ++bj)
#pragma unroll
                    for (int n = 0; n < 2; ++n) { f32x4 v = acc[ai][bj][m][n];
                        if (MODE == 1) { const u32x2 gw = *(const u32x2*)(gb + (size_t)(ai * 128 + m * 16) * 4096 + bj * 128 + n * 16); v *= (f32x4){bflo(gw.x), bfhi(gw.x), bflo(gw.y), bfhi(gw.y)}; }
                        *(f32x4*)(base + (size_t)(ai * 128 + m * 16) * DM + bj * 128 + n * 16) = v; }
    }
};
struct SplitOrder {
    int G, c, NS, kslice, mode;
    __device__ __forceinline__ bool next(int i, Unit& u) const { const int L = i * G + c; if (L >= 16 * NS) return false; const int un = L / NS; int s = L - un * NS; u.pm = 64 + (un >> 3); u.pn = un & 7;
        if (mode == 1 && s >= NS / 2) { s -= NS / 2; u.pm += 66; u.pn += 8; } u.ko = s * kslice; return true; }
    __device__ __forceinline__ void a_ready(const Unit&) const {}
    __device__ __forceinline__ void done(const Unit&) const {}
};
struct CmpOrder {
    int G, c, base, count;
    __device__ __forceinline__ bool next(int i, Unit& u) const { const int L = i * G + c; if (L >= count) return false; u.pm = base + L; u.pn = (base + L) & 1; u.ko = 0; return true; }
    __device__ __forceinline__ void a_ready(const Unit&) const {}
    __device__ __forceinline__ void done(const Unit&) const {}
};

constexpr int RG_XC = 0, RG_WA = 34816, RG_WX = 43520, RG_A = 52224, RG_B = 68608, RG_U = 84992, RG_SA = 101376, RG_SH = 103424, RG_HC = 105472;
__device__ __forceinline__ void rglru_unit(const Frame& F, int unit, unsigned char* ldsg) {
    LAS unsigned char* lds = (LAS unsigned char*)ldsg;
    int tid = F.tid; asm volatile("" : "+v"(tid));
    const int lane = tid & 63, wid = F.wave, r32 = lane & 31, hi = lane >> 5;
    const bool samp = unit >= 256; int b = 0, n, q, grp = 0;
    if (!samp) { b = unit >> 5; n = (unit >> 2) & 7; q = unit & 3; } else { const int u2 = unit - 256; n = u2 >> 4; q = (u2 >> 2) & 3; grp = u2 & 3; }
    const int rowbase = samp ? MP + grp * 128 : b * SEQ, nchunks = samp ? 1 : 16;
    const bf16_t* XR = WSP(bf16_t, WS_XR); const bf16_t* GG = WSP(bf16_t, WS_GG); bf16_t* Y = WSP(bf16_t, WS_Y);
    LAS bf16_t* XC = (LAS bf16_t*)(lds + RG_XC); LAS bf16_t* WAT = (LAS bf16_t*)(lds + RG_WA); LAS bf16_t* WXT = (LAS bf16_t*)(lds + RG_WX);
    LAS float* As = (LAS float*)(lds + RG_A); LAS float* Bs = (LAS float*)(lds + RG_B); LAS float* Us = (LAS float*)(lds + RG_U);
    LAS float* SA = (LAS float*)(lds + RG_SA); LAS float* SH = (LAS float*)(lds + RG_SH); LAS float* HC = (LAS float*)(lds + RG_HC);
    __syncthreads();
    for (int idx = tid; idx < 4096; idx += 512) { const int c = idx >> 5, d = idx & 31; const size_t o = ((size_t)n * 128 + c) * 128 + q * 32 + d;
        WAT[d * 136 + c] = (bf16_t)(pk2(F.rwa[o], 0.f) & 0xffffu); WXT[d * 136 + c] = (bf16_t)(pk2(F.rwx[o], 0.f) & 0xffffu); }
    if (tid < 32) HC[tid] = 0.f;
    const int cg = tid & 15; float cw[4][8], cb[8];
#pragma unroll
    for (int e = 0; e < 8; ++e) { const int ch = n * 128 + cg * 8 + e; cb[e] = F.rconv_b[ch];
#pragma unroll
        for (int j = 0; j < 4; ++j) cw[j][e] = F.rconv_w[j * 1024 + ch]; }
    const int which = wid >> 2, rt = wid & 3, chd = n * 128 + q * 32 + r32;
    const float gbias = which ? F.rbx[chd] : F.rba[chd];
    const float sp8 = -8.0f * log1pf(expf(-F.rlam[chd]));
    const int sd = tid & 31, seg = tid >> 5, sch = n * 128 + q * 32 + sd;
    for (int ck = 0; ck < nchunks; ++ck) {
        const int r0 = rowbase + ck * 128;
        __syncthreads();
#pragma unroll
        for (int k = 0; k < 4; ++k) { const int item = tid + 512 * k, row = item >> 4; const int gr = r0 + row; float acc8[8];
#pragma unroll
            for (int e = 0; e < 8; ++e) acc8[e] = cb[e];
#pragma unroll
            for (int j = 0; j < 4; ++j) { float xv[8]; bool have = true;
                if (!samp) { const int t = ck * 128 + row - 3 + j; have = t >= 0;
                    if (have) { const u32x4 w = *(const u32x4*)(XR + (size_t)(gr - 3 + j) * 1024 + n * 128 + cg * 8);
                        xv[0] = bflo(w.x); xv[1] = bfhi(w.x); xv[2] = bflo(w.y); xv[3] = bfhi(w.y); xv[4] = bflo(w.z); xv[5] = bfhi(w.z); xv[6] = bflo(w.w); xv[7] = bfhi(w.w); } }
                else { const int qq = gr - MP, db = qq >> 2, tq = qq & 3, tt = tq - 3 + j;
                    if (tt >= 0) { const u32x4 w = *(const u32x4*)(XR + (size_t)(gr - 3 + j) * 1024 + n * 128 + cg * 8);
                        xv[0] = bflo(w.x); xv[1] = bfhi(w.x); xv[2] = bflo(w.y); xv[3] = bfhi(w.y); xv[4] = bflo(w.z); xv[5] = bfhi(w.z); xv[6] = bflo(w.w); xv[7] = bfhi(w.w); }
                    else { const float* sp = F.st_conv + ((size_t)db * 3 + (tq + j)) * 1024 + n * 128 + cg * 8; const f32x4 a = *(const f32x4*)sp, c4 = *(const f32x4*)(sp + 4);
                        xv[0] = a.x; xv[1] = a.y; xv[2] = a.z; xv[3] = a.w; xv[4] = c4.x; xv[5] = c4.y; xv[6] = c4.z; xv[7] = c4.w; } }
                if (have) {
#pragma unroll
                    for (int e = 0; e < 8; ++e) acc8[e] += cw[j][e] * xv[e]; } }
            u32x4 o; o.x = pk2(acc8[0], acc8[1]); o.y = pk2(acc8[2], acc8[3]); o.z = pk2(acc8[4], acc8[5]); o.w = pk2(acc8[6], acc8[7]);
            *(LAS u32x4*)(XC + row * 136 + cg * 8) = o; }
        __syncthreads();
        { f32x16 acc;
#pragma unroll
          for (int r = 0; r < 16; ++r) acc[r] = gbias;
          const LAS bf16_t* wt = which ? WXT : WAT;
#pragma unroll
          for (int ks = 0; ks < 8; ++ks) { const bf16x8 af = *(const LAS bf16x8*)(XC + (rt * 32 + r32) * 136 + ks * 16 + hi * 8); const bf16x8 bfr = *(const LAS bf16x8*)(wt + r32 * 136 + ks * 16 + hi * 8);
              acc = __builtin_amdgcn_mfma_f32_32x32x16_bf16(af, bfr, acc, 0, 0, 0); }
#pragma unroll
          for (int r = 0; r < 16; ++r) { const int row = rt * 32 + (r & 3) + 8 * (r >> 2) + 4 * hi; const float sg = sigmoidf_(acc[r]);
              if (which == 0) { const float la = sp8 * sg; As[row * 32 + r32] = expf(la); Bs[row * 32 + r32] = sqrtf(-expm1f(2.0f * la)); }
              else { Us[row * 32 + r32] = sg * bf2f(XC[row * 136 + q * 32 + r32]); } } }
        __syncthreads();
        if (!samp) { float hl[8], cl[8]; float h = 0.f, ca = 1.f;
#pragma unroll
            for (int i = 0; i < 8; ++i) { const int row = seg * 8 + i; const float a = As[row * 32 + sd], uu = Bs[row * 32 + sd] * Us[row * 32 + sd]; h = a * h + uu; ca *= a; hl[i] = h; cl[i] = ca; }
            SA[seg * 32 + sd] = ca; SH[seg * 32 + sd] = h;
            __syncthreads();
            float hin = HC[sd];
            for (int s = 0; s < seg; ++s) hin = SA[s * 32 + sd] * hin + SH[s * 32 + sd];
            float hh = 0.f;
#pragma unroll
            for (int i = 0; i < 8; ++i) { const int gr = r0 + seg * 8 + i; hh = hl[i] + cl[i] * hin; const float gg = bf2f(GG[(size_t)gr * 1024 + sch]);
                Y[(size_t)gr * 1024 + sch] = (bf16_t)(pk2(hh * gg, 0.f) & 0xffffu); }
            __syncthreads();
            if (seg == 15) { HC[sd] = hh; if (ck == nchunks - 1) F.out[O_PRH + (size_t)b * 1024 + sch] = hh * SC_PRH; }
        } else { float h = 0.f;
#pragma unroll
            for (int i = 0; i < 8; ++i) { const int row = seg * 8 + i, gr = r0 + row, qq = gr - MP, db = qq >> 2, tq = qq & 3;
                if (tq == 0) h = F.st_h[(size_t)db * 1024 + sch];
                const float a = As[row * 32 + sd], uu = Bs[row * 32 + sd] * Us[row * 32 + sd]; h = a * h + uu;
                const float gg = bf2f(GG[(size_t)gr * 1024 + sch]); Y[(size_t)gr * 1024 + sch] = (bf16_t)(pk2(h * gg, 0.f) & 0xffffu);
                if (tq == 3) F.out[O_SRH + (size_t)db * 1024 + sch] = h * SC_SRH; } }
    }
}

constexpr int RP_XRAW = 0, RP_XC = 33792, RP_WA = 68608, RP_WX = 77312, RP_A = 86016, RP_U = 102400, RP_SA = 118784, RP_SH = 120832, RP_HC = 122880;
__device__ __forceinline__ void rglru_prompt_unit(const Frame& F, int unit, unsigned char* ldsg) {
    LAS unsigned char* lds = (LAS unsigned char*)ldsg;
    int tid = F.tid; asm volatile("" : "+v"(tid));
    const int lane = tid & 63, wid = F.wave;
    const int b = unit >> 5, n = (unit >> 2) & 7, q = unit & 3, rowbase = b * SEQ;
    const bf16_t* XR = WSP(bf16_t, WS_XR); const bf16_t* GG = WSP(bf16_t, WS_GG); bf16_t* Y = WSP(bf16_t, WS_Y);
    LAS bf16_t* XRAW = (LAS bf16_t*)(lds + RP_XRAW); LAS bf16_t* XC = (LAS bf16_t*)(lds + RP_XC); LAS bf16_t* WAT = (LAS bf16_t*)(lds + RP_WA); LAS bf16_t* WXT = (LAS bf16_t*)(lds + RP_WX);
    LAS float* As = (LAS float*)(lds + RP_A); LAS float* Us = (LAS float*)(lds + RP_U);
    LAS float* SA = (LAS float*)(lds + RP_SA); LAS float* SH = (LAS float*)(lds + RP_SH); LAS float* HC = (LAS float*)(lds + RP_HC);
    __syncthreads();
    for (int idx = tid; idx < 4096; idx += 512) { const int c = idx >> 5, d = idx & 31; const size_t o = ((size_t)n * 128 + c) * 128 + q * 32 + d;
        WAT[d * 136 + c] = (bf16_t)(pk2(F.rwa[o], 0.f) & 0xffffu); WXT[d * 136 + c] = (bf16_t)(pk2(F.rwx[o], 0.f) & 0xffffu); }
    if (tid < 32) HC[tid] = 0.f;
    const int cg = tid & 15; float cw[4][8], cb[8];
#pragma unroll
    for (int e = 0; e < 8; ++e) { const int ch = n * 128 + cg * 8 + e; cb[e] = F.rconv_b[ch];
#pragma unroll
        for (int j = 0; j < 4; ++j) cw[j][e] = F.rconv_w[j * 1024 + ch]; }
    const int fr = lane & 15, fq = lane >> 4; float gba[2], gbx[2], sp8[2];
#pragma unroll
    for (int ct = 0; ct < 2; ++ct) { const int chd = n * 128 + q * 32 + ct * 16 + fr; gba[ct] = F.rba[chd]; gbx[ct] = F.rbx[chd]; sp8[ct] = -8.0f * 1.4426950409f * log1pf(expf(-F.rlam[chd])); }
    const int sd = tid & 31, seg = tid >> 5;
    const int orow = tid >> 2, ocg = tid & 3;
    u32x4 raw[5], ggp;
#pragma unroll
    for (int k = 0; k < 5; ++k) { const int p = tid + 512 * k, rr = (p >> 4) - 4; raw[k] = (u32x4){0u, 0u, 0u, 0u};
        if (p < 2112 && rr >= 0) raw[k] = *(const u32x4*)(XR + (size_t)(rowbase + rr) * 1024 + n * 128 + (p & 15) * 8); }
    ggp = *(const u32x4*)(GG + (size_t)(rowbase + orow) * 1024 + n * 128 + q * 32 + ocg * 8);
    for (int ck = 0; ck < 16; ++ck) {
        const int r0 = rowbase + ck * 128;
        __syncthreads();
#pragma unroll
        for (int k = 0; k < 5; ++k) { const int p = tid + 512 * k; if (p < 2112) *(LAS u32x4*)(XRAW + (p >> 4) * 128 + (p & 15) * 8) = raw[k]; }
        const u32x4 ggc = ggp;
        if (ck < 15) {
#pragma unroll
            for (int k = 0; k < 5; ++k) { const int p = tid + 512 * k; if (p < 2112) raw[k] = *(const u32x4*)(XR + (size_t)(r0 + 124 + (p >> 4)) * 1024 + n * 128 + (p & 15) * 8); }
            ggp = *(const u32x4*)(GG + (size_t)(r0 + 128 + orow) * 1024 + n * 128 + q * 32 + ocg * 8); }
        __syncthreads();
#pragma unroll
        for (int k = 0; k < 4; ++k) { const int row = (tid >> 4) + 32 * k; float acc8[8];
#pragma unroll
            for (int e = 0; e < 8; ++e) acc8[e] = cb[e];
#pragma unroll
            for (int j = 0; j < 4; ++j) { const u32x4 w = *(const LAS u32x4*)(XRAW + (row + 1 + j) * 128 + cg * 8);
                acc8[0] += cw[j][0] * bflo(w.x); acc8[1] += cw[j][1] * bfhi(w.x); acc8[2] += cw[j][2] * bflo(w.y); acc8[3] += cw[j][3] * bfhi(w.y);
                acc8[4] += cw[j][4] * bflo(w.z); acc8[5] += cw[j][5] * bfhi(w.z); acc8[6] += cw[j][6] * bflo(w.w); acc8[7] += cw[j][7] * bfhi(w.w); }
            u32x4 o; o.x = pk2(acc8[0], acc8[1]); o.y = pk2(acc8[2], acc8[3]); o.z = pk2(acc8[4], acc8[5]); o.w = pk2(acc8[6], acc8[7]);
            *(LAS u32x4*)(XC + row * 136 + cg * 8) = o; }
        __syncthreads();
        { f32x4 ar[2], ai[2];
#pragma unroll
          for (int ct = 0; ct < 2; ++ct) { ar[ct] = (f32x4){gba[ct], gba[ct], gba[ct], gba[ct]}; ai[ct] = (f32x4){gbx[ct], gbx[ct], gbx[ct], gbx[ct]}; }
#pragma unroll
          for (int ks = 0; ks < 4; ++ks) { const bf16x8 af = *(const LAS bf16x8*)(XC + (wid * 16 + fr) * 136 + ks * 32 + fq * 8);
#pragma unroll
              for (int ct = 0; ct < 2; ++ct) { const bf16x8 ba = *(const LAS bf16x8*)(WAT + (ct * 16 + fr) * 136 + ks * 32 + fq * 8), bx = *(const LAS bf16x8*)(WXT + (ct * 16 + fr) * 136 + ks * 32 + fq * 8);
                  ar[ct] = __builtin_amdgcn_mfma_f32_16x16x32_bf16(af, ba, ar[ct], 0, 0, 0); ai[ct] = __builtin_amdgcn_mfma_f32_16x16x32_bf16(af, bx, ai[ct], 0, 0, 0); } }
#pragma unroll
          for (int ct = 0; ct < 2; ++ct)
#pragma unroll
              for (int j = 0; j < 4; ++j) { const int row = wid * 16 + fq * 4 + j, d = ct * 16 + fr;
                  const float rg = sigmoidf_(ar[ct][j]), ig = sigmoidf_(ai[ct][j]); const float l2 = sp8[ct] * rg;
                  const float a = __builtin_amdgcn_exp2f(l2); const float x = 1.3862943611f * l2;
                  const float om = (x > -0.05f) ? -x * (1.0f + x * (0.5f + x * (0.16666667f + x * 0.041666668f))) : 1.0f - a * a;
                  As[row * 32 + d] = a; Us[row * 32 + d] = __builtin_amdgcn_sqrtf(om) * ig * bf2f(XC[row * 136 + q * 32 + d]); } }
        __syncthreads();
        float hl[8], cl[8]; float h = 0.f, ca = 1.f;
#pragma unroll
        for (int i = 0; i < 8; ++i) { const int row = seg * 8 + i; const float a = As[row * 32 + sd]; h = a * h + Us[row * 32 + sd]; ca *= a; hl[i] = h; cl[i] = ca; }
        SA[seg * 32 + sd] = ca; SH[seg * 32 + sd] = h;
        __syncthreads();
        float hin = HC[sd];
        for (int s = 0; s < seg; ++s) hin = SA[s * 32 + sd] * hin + SH[s * 32 + sd];
        float hh = 0.f;
#pragma unroll
        for (int i = 0; i < 8; ++i) { hh = hl[i] + cl[i] * hin; As[(seg * 8 + i) * 32 + sd] = hh; }
        __syncthreads();
        if (seg == 15) { HC[sd] = hh; if (ck == 15) F.out[O_PRH + (size_t)b * 1024 + n * 128 + q * 32 + sd] = hh * SC_PRH; }
        { const LAS f32x4* hp = (const LAS f32x4*)(As + orow * 32 + ocg * 8); const f32x4 h0 = hp[0], h1 = hp[1];
          u32x4 o; o.x = pk2(h0.x * bflo(ggc.x), h0.y * bfhi(ggc.x)); o.y = pk2(h0.z * bflo(ggc.y), h0.w * bfhi(ggc.y)); o.z = pk2(h1.x * bflo(ggc.z), h1.y * bfhi(ggc.z)); o.w = pk2(h1.z * bflo(ggc.w), h1.w * bfhi(ggc.w));
          *(u32x4*)(Y + (size_t)(r0 + orow) * 1024 + n * 128 + q * 32 + ocg * 8) = o; }
    }
}

#ifndef QB_OF
#define QB_OF(x) (31 - (x))
#endif
namespace att {
#ifndef ATT_THR
#define ATT_THR 8.f
#endif
constexpr float SCALE = 0.08838834764831845f, THR = ATT_THR;
constexpr int A_V = 0, A_K = 16384, A_WS = 32768, A_IMPA = 36864, A_IMPB = 70656, A_IMP = 104448, A_SEL = 112896, A_UNI = 113152, A_SC = 113408, A_Q = 115712;
#define KSWZ(row, colB) ((row) * 256 + ((colB) ^ (((row) & 7) << 4)))
#define SBAR() __builtin_amdgcn_sched_barrier(0)
__device__ __forceinline__ int v_st(int k, int c) { const int kk = (k & ~0xC) | ((k & 4) << 1) | ((k & 8) >> 1); return ((kk >> 3) * 4 + (c >> 5)) * 512 + ((kk & 7) * 32 + (c & 31)) * 2; }
__device__ __forceinline__ int v_rd_base(int lane) { return ((lane & 3) << 3) | (((lane >> 2) & 3) << 6) | (((lane >> 4) & 1) << 5) | (((lane >> 5) & 1) << 8); }
constexpr int v_rd_off(int d0, int ks, int half) { return d0 * 512 + ks * 4096 + half * 2048; }
__device__ __forceinline__ int crow(int r, int hi) { return (r & 3) + 8 * (r >> 2) + 4 * hi; }
__device__ __forceinline__ unsigned cvtpk(float lo, float hi) { return pg8::cvt_pk_bf16(lo, hi); }

__device__ __forceinline__ void mask_tile(f32x16& p0, f32x16& p1, int dq, int kstep, unsigned W, bool rowsel) {
    const float NEG = -__builtin_inff();
#pragma unroll
    for (int r = 0; r < 16; ++r) { const int c = (r & 3) + 8 * (r >> 2);
        const bool bad0 = (!rowsel) | ((unsigned)(dq - kstep * c) > W), bad1 = (!rowsel) | ((unsigned)(dq - kstep * (c + 32)) > W);
        p0[r] = bad0 ? NEG : p0[r]; p1[r] = bad1 ? NEG : p1[r]; }
}
__device__ __forceinline__ void partialSM(f32x16& p0, f32x16& p1, float& m_reg, float& mn, float& alpha) {
    float pmax = p0[0];
#pragma unroll
    for (int r = 1; r < 16; ++r) pmax = fmaxf(pmax, p0[r]);
#pragma unroll
    for (int r = 0; r < 16; ++r) pmax = fmaxf(pmax, p1[r]);
    { auto rr = __builtin_amdgcn_permlane32_swap(__float_as_uint(pmax), __float_as_uint(pmax), false, false);
      pmax = fmaxf(__uint_as_float(rr[0]), __uint_as_float(rr[1])); }
    constexpr float C2 = 1.4426950408889634f * SCALE;
    if (__builtin_expect(__all((pmax - m_reg) * SCALE <= THR), 1)) { mn = m_reg; alpha = 1.f; }
    else { mn = fmaxf(m_reg, pmax); alpha = __builtin_amdgcn_exp2f((m_reg - mn) * C2); m_reg = mn; }
    const float mnL = -mn * C2;
#pragma unroll
    for (int r = 0; r < 16; ++r) { p0[r] = __builtin_amdgcn_exp2f(fmaf(p0[r], C2, mnL)); p1[r] = __builtin_amdgcn_exp2f(fmaf(p1[r], C2, mnL)); }
}
__device__ __forceinline__ void finishSM(f32x16& p0, f32x16& p1, float alpha, float& l_reg, bf16x8& pa0, bf16x8& pa1, bf16x8& pa2, bf16x8& pa3) {
    float ps = 0;
#pragma unroll
    for (int r = 0; r < 16; ++r) ps += p0[r];
#pragma unroll
    for (int r = 0; r < 16; ++r) ps += p1[r];
    { auto rr = __builtin_amdgcn_permlane32_swap(__float_as_uint(ps), __float_as_uint(ps), false, false);
      ps = __uint_as_float(rr[0]) + __uint_as_float(rr[1]); }
    l_reg = l_reg * alpha + ps;
#define PK4(P, B_, OUT) do { unsigned a0 = cvtpk(P[B_+0], P[B_+1]), a1 = cvtpk(P[B_+2], P[B_+3]);                          \
        unsigned b0 = cvtpk(P[B_+4], P[B_+5]), b1 = cvtpk(P[B_+6], P[B_+7]);                                             \
        auto r0 = __builtin_amdgcn_permlane32_swap(a0, b0, false, false); auto r1 = __builtin_amdgcn_permlane32_swap(a1, b1, false, false); \
        u32x4 w = {r0[0], r1[0], r0[1], r1[1]}; OUT = *reinterpret_cast<bf16x8*>(&w); } while (0)
    PK4(p0, 0, pa0); PK4(p0, 8, pa1); PK4(p1, 0, pa2); PK4(p1, 8, pa3);
#undef PK4
}
template <bool QLDS>
__device__ __forceinline__ void qkt(f32x16& p0, f32x16& p1, const LAS char* K_lds, int r32, int hi, const bf16x8* qr, const LAS char* Q_lds, float bbase, float bstep) {
#pragma unroll
    for (int r = 0; r < 16; ++r) { const int c = (r & 3) + 8 * (r >> 2); p0[r] = fmaf(bstep, (float)c, bbase); p1[r] = fmaf(bstep, (float)(c + 32), bbase); }
    const LAS char* kb[4];
#pragma unroll
    for (int dd = 0; dd < 4; ++dd) kb[dd] = K_lds + KSWZ(r32, (dd * 16 + hi * 8) * 2);
#pragma unroll
    for (int d0 = 0; d0 < 8; ++d0) { const LAS char* a = kb[d0 & 3] + (d0 >> 2) * 128;
        const bf16x8 b0 = *reinterpret_cast<const LAS bf16x8*>(a);
        const bf16x8 b1 = *reinterpret_cast<const LAS bf16x8*>(a + 32 * 256);
        const bf16x8 qf = QLDS ? *reinterpret_cast<const LAS bf16x8*>(Q_lds + d0 * 1024) : qr[d0];
        p0 = __builtin_amdgcn_mfma_f32_32x32x16_bf16(b0, qf, p0, 0, 0, 0);
        p1 = __builtin_amdgcn_mfma_f32_32x32x16_bf16(b1, qf, p1, 0, 0, 0); }
}
__device__ __forceinline__ void pv_tile(f32x16* o, int vb0, bf16x8 pa0, bf16x8 pa1, bf16x8 pa2, bf16x8 pa3) {
#define TRRD(dst, off) asm volatile("ds_read_b64_tr_b16 %0, %1 offset:%2" : "=&v"(dst) : "v"(vb0), "i"(off) : "memory")
#define PV_D0(d0) do { s16x4 l0, l1, l2, l3, h0, h1, h2, h3; constexpr int b_ = v_rd_off(d0, 0, 0); \
        TRRD(l0, b_); TRRD(h0, b_ + 2048); TRRD(l1, b_ + 4096); TRRD(h1, b_ + 6144); TRRD(l2, b_ + 8192); TRRD(h2, b_ + 10240); TRRD(l3, b_ + 12288); TRRD(h3, b_ + 14336); \
        asm volatile("s_waitcnt lgkmcnt(0)" ::: "memory"); SBAR();   \
        o[d0] = __builtin_amdgcn_mfma_f32_32x32x16_bf16(pa0, (bf16x8){l0[0], l0[1], l0[2], l0[3], h0[0], h0[1], h0[2], h0[3]}, o[d0], 0, 0, 0);   \
        o[d0] = __builtin_amdgcn_mfma_f32_32x32x16_bf16(pa1, (bf16x8){l1[0], l1[1], l1[2], l1[3], h1[0], h1[1], h1[2], h1[3]}, o[d0], 0, 0, 0);   \
        o[d0] = __builtin_amdgcn_mfma_f32_32x32x16_bf16(pa2, (bf16x8){l2[0], l2[1], l2[2], l2[3], h2[0], h2[1], h2[2], h2[3]}, o[d0], 0, 0, 0);   \
        o[d0] = __builtin_amdgcn_mfma_f32_32x32x16_bf16(pa3, (bf16x8){l3[0], l3[1], l3[2], l3[3], h3[0], h3[1], h3[2], h3[3]}, o[d0], 0, 0, 0); } while (0)
    PV_D0(0); PV_D0(1); PV_D0(2); PV_D0(3);
#undef PV_D0
#undef TRRD
}
struct Tile { const void* K; const void* V; int stride; int mode  ; int nvalid; int kp0, kstep; unsigned W; int selbit; int n0; int wrow  ; };

template <bool SAMPLE>
__device__ __forceinline__ void attn_unit(const Frame& F, int uidx, unsigned char* ldsg) {
    LAS char* lds = (LAS char*)ldsg;
    int tid = F.tid; asm volatile("" : "+v"(tid));
    const int wid = F.wave, lane = tid & 63, r32 = lane & 31, hi = lane >> 5;
    int b = 0, g, qb = 32, db = 0;
    if (SAMPLE) { db = uidx >> 1; g = uidx & 1; } else { qb = QB_OF(uidx >> 4); b = (uidx & 15) >> 1; g = uidx & 1; }
    const bool active = SAMPLE ? (wid == 0) : true;
    const int hl = SAMPLE ? ((r32 & 15) >> 2) : (wid >> 1), tok = SAMPLE ? (r32 & 3) : ((wid & 1) * 32 + r32);
    const bool rowvalid = SAMPLE ? (r32 < 16) : true;
    const int t = SAMPLE ? SEQ + tok : qb * 64 + tok;
    const size_t grow = SAMPLE ? (size_t)MP + db * 4 + tok : (size_t)b * SEQ + t;
    const int head = g * 4 + hl;
    const float sl_raw = __builtin_amdgcn_exp2f(-(float)(head + 1)) * (1.0f / SCALE);
    const bf16_t* Qg = WSP(bf16_t, WS_Q); const bf16_t* KVS = WSP(bf16_t, WS_KVS); const bf16_t* KVWb = WSP(bf16_t, WS_KVW);
    const float* FS = WSP(float, WS_FS); const float* POSB = WSP(float, WS_POSB); const float* GNSA = WSP(float, WS_GNSA);
    float* OMIX = WSP(float, WS_OMIX); bf16_t* OB = WSP(bf16_t, WS_OB);
    bf16x8 qr[8]; const LAS char* Q_lds = lds + A_Q + lane * 16;
    if (SAMPLE) { __syncthreads();
        if (wid == 0) {
#pragma unroll
            for (int d0 = 0; d0 < 8; ++d0) { bf16x8 qv = *(const bf16x8*)(Qg + grow * 1024 + head * 128 + d0 * 16 + hi * 8);
#ifdef QDEGRADE
                for (int e = 0; e < 8; ++e) qv[e] &= (short)0xFFFC;
#endif
                *(LAS bf16x8*)(lds + A_Q + d0 * 1024 + lane * 16) = qv; } }
    } else {
#pragma unroll
        for (int d0 = 0; d0 < 8; ++d0) { qr[d0] = *(const bf16x8*)(Qg + grow * 1024 + head * 128 + d0 * 16 + hi * 8);
#ifdef QDEGRADE
            for (int e = 0; e < 8; ++e) qr[d0][e] &= (short)0xFFFC;
#endif
        } }
    LAS char* V_lds = lds + A_V; LAS char* K_lds = lds + A_K;
    LAS float* li_l = (LAS float*)(lds + A_WS) + wid * 64; LAS float* al_l = li_l + 32;
    LAS float* IMPA = (LAS float*)(lds + A_IMPA); LAS float* IMPB = (LAS float*)(lds + A_IMPB); LAS float* IMP = (LAS float*)(lds + A_IMP);
    LAS unsigned* SEL = (LAS unsigned*)(lds + A_SEL); LAS unsigned* UNI = (LAS unsigned*)(lds + A_UNI); LAS float* SC = (LAS float*)(lds + A_SC);
    const int vb0 = (int)(unsigned)(size_t)V_lds + v_rd_base(lane);
    const int sr = tid >> 4, sc = (tid & 15) * 8, vst0 = v_st(sr, sc), vst1 = v_st(32 + sr, sc), kws = KSWZ(sr, sc * 2);
    const int fsunit = SAMPLE ? db * 2 : 256 + b * 2;
#ifdef ATT_EQUIV
    const int ncmp = 2; const int wlo = 0;
#else
    const int ncmp = SAMPLE ? 2 : (qb >= 16 ? 2 : 1);
    const int wlo = SAMPLE ? 0 : (qb >= 8 ? qb - 8 : 0);
#endif

    float m_reg = -1e30f, l_reg = 0.f; f32x16 o[4];
#pragma unroll
    for (int d = 0; d < 4; ++d)
#pragma unroll
        for (int r = 0; r < 16; ++r) o[d][r] = 0.f;
    float sc0 = 1.f;
    unsigned sel = 0u, rem = 0u; bool own_done = false;
    int br = 0, step = 0;
    auto gen = [&](Tile& T) -> bool {
        bool have = false; T.K = nullptr; T.V = nullptr; T.stride = 0; T.mode = 0; T.nvalid = 64; T.kp0 = 0; T.kstep = 1; T.W = 0x7fffffffu; T.selbit = -1; T.n0 = 0; T.wrow = -1;
        if (br == 0) { if (step < ncmp) { have = true; T.mode = 2; T.n0 = step * 64; T.kp0 = 31 + 1024 * step; T.kstep = 16; } }
        else if (br == 1) {
            if (rem != 0u) { const int kb = __builtin_ctz(rem); rem &= rem - 1u; have = true; T.selbit = kb; T.kp0 = kb * 64;
                if (SAMPLE) { const int page = F.pt[db * 16 + (kb >> 1)]; const float* base = F.c_slc + ((size_t)page * 128 + (kb & 1) * 64) * 512 + g * 128;
                    T.K = base; T.V = base + 256; T.stride = 512; T.mode = 1; }
                else { const bf16_t* base = KVS + ((size_t)b * SEQ + kb * 64) * 512 + g * 128; T.K = base; T.V = base + 256; T.stride = 512; T.mode = 0; } }
            else if (!own_done) { own_done = true; have = true;
                if (SAMPLE) { const bf16_t* base = KVS + ((size_t)MP + db * 4) * 512 + g * 128; T.K = base; T.V = base + 256; T.stride = 512; T.nvalid = 4; T.kp0 = SEQ; }
                else { const bf16_t* base = KVS + ((size_t)b * SEQ + qb * 64) * 512 + g * 128; T.K = base; T.V = base + 256; T.stride = 512; T.kp0 = qb * 64; } } }
        else {
            if (SAMPLE) { if (step < 8) { have = true; const float* base = F.c_win + ((size_t)db * 512 + step * 64) * 512 + g * 128; T.K = base; T.V = base + 256; T.stride = 512; T.mode = 1; T.kp0 = SEQ - 512 + step * 64; T.W = 512u; T.wrow = step * 64; }
                else if (step == 8) { have = true; const bf16_t* base = KVWb + ((size_t)MP + db * 4) * 512 + g * 128; T.K = base; T.V = base + 256; T.stride = 512; T.nvalid = 4; T.kp0 = SEQ; T.W = 512u; } }
            else { const int kb = wlo + step; if (kb <= qb) { have = true; const bf16_t* base = KVWb + ((size_t)b * SEQ + kb * 64) * 512 + g * 128; T.K = base; T.V = base + 256; T.stride = 512; T.kp0 = kb * 64; T.W = 512u; } } }
        if (have) ++step;
        return have; };
    u32x4 pk0 = {0u, 0u, 0u, 0u}, pk1 = pk0, pv0 = pk0, pv1 = pk0; f32x4 fk[4], fv[4];
    auto issue = [&](const Tile& T) {
        if (T.mode == 0) { const bf16_t* Kp = (const bf16_t*)T.K; const bf16_t* Vp = (const bf16_t*)T.V; pk0 = (u32x4){0u, 0u, 0u, 0u}; pk1 = pk0; pv0 = pk0; pv1 = pk0;
            if (sr < T.nvalid) { pk0 = *(const u32x4*)(Kp + (size_t)sr * T.stride + sc); pv0 = *(const u32x4*)(Vp + (size_t)sr * T.stride + sc); }
            if (sr + 32 < T.nvalid) { pk1 = *(const u32x4*)(Kp + (size_t)(sr + 32) * T.stride + sc); pv1 = *(const u32x4*)(Vp + (size_t)(sr + 32) * T.stride + sc); } }
        else if (SAMPLE && T.mode == 1) { const float* Kp = (const float*)T.K + (size_t)sr * T.stride + sc; const float* Vp = (const float*)T.V + (size_t)sr * T.stride + sc;
            fk[0] = *(const f32x4*)Kp; fk[1] = *(const f32x4*)(Kp + 4); fk[2] = *(const f32x4*)(Kp + 32 * 512); fk[3] = *(const f32x4*)(Kp + 32 * 512 + 4);
            fv[0] = *(const f32x4*)Vp; fv[1] = *(const f32x4*)(Vp + 4); fv[2] = *(const f32x4*)(Vp + 32 * 512); fv[3] = *(const f32x4*)(Vp + 32 * 512 + 4); } };
    auto commit = [&](const Tile& T) {
        if (T.mode == 0) { *(LAS u32x4*)(K_lds + kws) = pk0; *(LAS u32x4*)(K_lds + kws + 32 * 256) = pk1; *(LAS u32x4*)(V_lds + vst0) = pv0; *(LAS u32x4*)(V_lds + vst1) = pv1; }
        else if (SAMPLE && T.mode == 1) { *(LAS u32x4*)(K_lds + kws) = pack8u(fk[0], fk[1]); *(LAS u32x4*)(K_lds + kws + 32 * 256) = pack8u(fk[2], fk[3]);
            *(LAS u32x4*)(V_lds + vst0) = pack8u(fv[0], fv[1]); *(LAS u32x4*)(V_lds + vst1) = pack8u(fv[2], fv[3]);
            if (T.wrow >= 0) {
                float* dst = F.out + O_SKW + ((size_t)db * 512) * 512 + g * 128 + sc; const int i0 = T.wrow + sr - 4;
                if (i0 >= 0) { float* p = dst + (size_t)i0 * 512; *(f32x4*)p = fk[0]; *(f32x4*)(p + 4) = fk[1]; *(f32x4*)(p + 256) = fv[0]; *(f32x4*)(p + 260) = fv[1]; }
                { float* p = dst + (size_t)(i0 + 32) * 512; *(f32x4*)p = fk[2]; *(f32x4*)(p + 4) = fk[3]; *(f32x4*)(p + 256) = fv[2]; *(f32x4*)(p + 260) = fv[3]; } } }
        else if (T.mode == 2) { const float* Fk = FS + (size_t)fsunit * 65536; const float* Fv = Fk + 65536;
#pragma unroll 1
            for (int hh = 0; hh < 2; ++hh) { const int n = T.n0 + sr + 32 * hh; u32x4 kk = {0u, 0u, 0u, 0u}, vv = kk;
                if (n <= 126) { const size_t o1 = (size_t)(g * 128 + n) * 256 + sc, o2 = (size_t)(g * 128 + n + 1) * 256 + 128 + sc;
                    { const f32x4 a0 = *(const f32x4*)(Fk + o1) + *(const f32x4*)(Fk + o2) + *(const f32x4*)(POSB + sc), a1 = *(const f32x4*)(Fk + o1 + 4) + *(const f32x4*)(Fk + o2 + 4) + *(const f32x4*)(POSB + sc + 4); kk = pack8u(a0, a1); }
                    { const f32x4 c0 = *(const f32x4*)(Fv + o1) + *(const f32x4*)(Fv + o2) + *(const f32x4*)(POSB + 128 + sc), c1 = *(const f32x4*)(Fv + o1 + 4) + *(const f32x4*)(Fv + o2 + 4) + *(const f32x4*)(POSB + 128 + sc + 4); vv = pack8u(c0, c1); } }
                *(LAS u32x4*)(K_lds + kws + hh * 32 * 256) = kk; *(LAS u32x4*)(V_lds + (hh ? vst1 : vst0)) = vv; } } };
    Tile T; bool have = gen(T);
    if (have) issue(T);
    for (;;) {
        if (!have) {
            if (active) {
                const float inv = 1.0f / fmaxf(l_reg, 1e-30f);
                if (hi == 0) li_l[r32] = rowvalid ? GNSA[grow * 32 + br * 8 + head] * inv : 0.f;
                asm volatile("s_waitcnt lgkmcnt(0)" ::: "memory");
                int r32e = r32, hie = hi; asm volatile("" : "+v"(r32e), "+v"(hie));
#pragma unroll
                for (int r = 0; r < (SAMPLE ? 8 : 16); ++r) { const int rr = crow(r, hie); const float fac = li_l[rr];
                    size_t orow; int ohead; bool ok = true;
                    if (SAMPLE) { ok = rr < 16; orow = (size_t)MP + db * 4 + (rr & 3); ohead = g * 4 + ((rr & 15) >> 2); } else { orow = (size_t)b * SEQ + qb * 64 + (wid & 1) * 32 + rr; ohead = head; }
                    if (ok) { float* pm = OMIX + orow * 1024 + ohead * 128 + r32e; bf16_t* pb = OB + orow * 1024 + ohead * 128 + r32e;
                        float v0 = o[0][r] * fac, v1 = o[1][r] * fac, v2 = o[2][r] * fac, v3 = o[3][r] * fac;
                        if (br > 0) { v0 += pm[0]; v1 += pm[32]; v2 += pm[64]; v3 += pm[96]; }
                        if (br < 2) { pm[0] = v0; pm[32] = v1; pm[64] = v2; pm[96] = v3; }
                        else { pb[0] = (bf16_t)(cvtpk(v0, 0.f) & 0xffffu); pb[32] = (bf16_t)(cvtpk(v1, 0.f) & 0xffffu); pb[64] = (bf16_t)(cvtpk(v2, 0.f) & 0xffffu); pb[96] = (bf16_t)(cvtpk(v3, 0.f) & 0xffffu); } }
                    if ((r & 7) == 7) asm volatile("" ::: "memory"); }
                if (br == 0 && rowvalid && hi == 0) { SC[(hl * 64 + tok) * 2] = sc0 * inv; SC[(hl * 64 + tok) * 2 + 1] = inv; }
            }
            if (br == 0) {
                __syncthreads();
                constexpr int NTOK = SAMPLE ? 4 : 64; const int cur = SAMPLE ? 32 : qb;
                if (tid < NTOK) {
#pragma unroll 1
                    for (int k = 0; k < 32; ++k) { float s = 0.f;
#pragma unroll
                        for (int h = 0; h < 4; ++h) { s += IMPA[(h * 64 + tid) * 33 + k] * SC[(h * 64 + tid) * 2 + (k >> 4)]; if (k > 0) s += IMPB[(h * 64 + tid) * 33 + k - 1] * SC[(h * 64 + tid) * 2 + ((k - 1) >> 4)]; }
                        IMP[tid * 33 + k] = s; }
                    unsigned mask = 0u;
                    if (cur >= 1) { if (cur <= 7) mask = (1u << (cur & 31)) - 1u;
                        else { mask = 1u;
#pragma unroll 1
                            for (int it = 0; it < 6; ++it) { float best = -1.f; int bi = 0;
#pragma unroll 1
                                for (int k = 1; k < cur; ++k) { const float v = IMP[tid * 33 + k]; if (!((mask >> k) & 1u) && v > best) { best = v; bi = k; } }
                                mask |= 1u << bi; } } }
                    SEL[tid] = mask;
#ifdef ATT_CHECK
                    if (!SAMPLE) ((unsigned*)(F.ws + (size_t)1272 * MiB))[(b * 2 + g) * 2048 + qb * 64 + tid] = mask;
#endif
                }
                __syncthreads();
                if (wid == 0) { unsigned v = (lane < NTOK) ? SEL[lane] : 0u;
#pragma unroll
                    for (int off = 1; off < 64; off <<= 1) v |= __shfl_xor(v, off);
                    if (lane == 0) UNI[0] = v; }
                __syncthreads();
                rem = UNI[0]; sel = SEL[tok];
            }
            ++br; step = 0; if (br == 3) break;
            m_reg = -1e30f; l_reg = 0.f;
#pragma unroll
            for (int d = 0; d < 4; ++d)
#pragma unroll
                for (int r = 0; r < 16; ++r) o[d][r] = 0.f;
            have = gen(T); if (have) issue(T);
            continue;
        }
        asm volatile("s_waitcnt lgkmcnt(0)\n\ts_barrier" ::: "memory");
        commit(T);
        Tile TN; const bool have_n = gen(TN);
        if (have_n) issue(TN);
        asm volatile("s_waitcnt lgkmcnt(0)\n\ts_barrier" ::: "memory");
        if (active) {
            f32x16 p0, p1; float mn, al; bf16x8 pa0, pa1, pa2, pa3;
            const bool rowsel = rowvalid && (T.selbit < 0 || ((sel >> T.selbit) & 1u));
            const float bstep = sl_raw * (float)T.kstep, bbase = rowsel ? sl_raw * (float)(T.kp0 + T.kstep * 4 * hi) : -__builtin_inff();
            qkt<SAMPLE>(p0, p1, K_lds, r32, hi, qr, Q_lds, bbase, bstep);
            { const int kpl = T.kp0 + 63 * T.kstep, tlo = SAMPLE ? SEQ : t - r32, thi = tlo + (SAMPLE ? 3 : 31);
              if (kpl > tlo || (T.W < 0x7fffffffu && thi - T.kp0 > (int)T.W)) mask_tile(p0, p1, t - T.kp0 - T.kstep * 4 * hi, T.kstep, T.W, true); }
            partialSM(p0, p1, m_reg, mn, al);
            if (__any(al < 1.f)) { if (hi == 0) al_l[r32] = al; asm volatile("s_waitcnt lgkmcnt(0)" ::: "memory");
#pragma unroll
                for (int d_ = 0; d_ < 4; ++d_)
#pragma unroll
                    for (int r = 0; r < 16; ++r) o[d_][r] *= al_l[crow(r, hi)];
                if (br == 0 && T.n0 > 0) sc0 *= al; }
            if (br == 0 && rowvalid) { const int rowi = (hl * 64 + tok) * 33 + (T.n0 >> 2) + hi;
#pragma unroll
                for (int j = 0; j < 4; ++j) { IMPA[rowi + 2 * j] = (p0[4 * j] + p0[4 * j + 1]) + (p0[4 * j + 2] + p0[4 * j + 3]); IMPB[rowi + 2 * j] = p0[4 * j + 3];
                    IMPA[rowi + 8 + 2 * j] = (p1[4 * j] + p1[4 * j + 1]) + (p1[4 * j + 2] + p1[4 * j + 3]); IMPB[rowi + 8 + 2 * j] = p1[4 * j + 3]; } }
            finishSM(p0, p1, al, l_reg, pa0, pa1, pa2, pa3);
            pv_tile(o, vb0, pa0, pa1, pa2, pa3);
        }
        T = TN; have = have_n;
    }
}
}

#ifdef ATT_CHECK
__device__ __forceinline__ float bfr(float x) { return __uint_as_float(pk2(x, 0.f) << 16); }
__device__ __forceinline__ void att_check(const Frame& F, unsigned char* ldsg) {
    LAS float* L = (LAS float*)ldsg;
    LAS float* Qs = L;
    LAS float* Ss = L + 512;
    LAS float* Oc = L + 512 + 2560;
    LAS float* IMPs = Oc + 1536;
    LAS int* KP = (LAS int*)(IMPs + 32);
    LAS float* RED = (LAS float*)(KP + 640);
    LAS unsigned* MSK = (LAS unsigned*)(RED + 1024);
    const int tid = F.tid, bid = F.bid;
    const int b = bid & 7, g = (bid >> 3) & 1, t = (bid * CHK_MUL + CHK_ADD) & 2047;
    const size_t row = (size_t)b * SEQ + t;
    const bf16_t* Qg = WSP(bf16_t, WS_Q); const bf16_t* KVS = WSP(bf16_t, WS_KVS); const bf16_t* KVWb = WSP(bf16_t, WS_KVW);
    const float* FS = WSP(float, WS_FS); const float* POSB = WSP(float, WS_POSB); const float* GNSA = WSP(float, WS_GNSA); const bf16_t* OB = WSP(bf16_t, WS_OB);
    const float SCL = 0.08838834764831845f;
    __syncthreads();
    { const int h = tid >> 7, d = tid & 127; float qv = bf2f(Qg[row * 1024 + (g * 4 + h) * 128 + d]);
#ifdef CHK_QNOISE
      { unsigned hsh = (unsigned)(row * 1024 + (g * 4 + h) * 128 + d) * 2654435761u; hsh ^= hsh >> 15; hsh *= 2246822519u; hsh ^= hsh >> 13; qv *= 1.0f + CHK_QNOISE * ((float)(hsh & 0xffff) * (1.0f / 32768.0f) - 1.0f); }
#endif
      Qs[h * 128 + d] = qv; }
    __syncthreads();
    const int hh = tid >> 7, dd = tid & 127; const float slope = exp2f(-(float)(g * 4 + hh + 1));
    const float* Fk = FS + (size_t)(256 + b * 2) * 65536; const float* Fv = Fk + 65536;
    const int ncv = t >= 31 ? (t - 31) / 16 + 1 : 0;
    { const int n = dd; float s = -INFINITY;
      if (n < ncv && n <= 126) { float acc = 0.f; for (int d = 0; d < 128; ++d) { const float kc = bfr(Fk[(size_t)(g * 128 + n) * 256 + d] + Fk[(size_t)(g * 128 + n + 1) * 256 + 128 + d] + POSB[d]); acc += Qs[hh * 128 + d] * kc; }
          s = acc * SCL + slope * (float)(16 * n + 31); }
      Ss[hh * 640 + n] = s; }
    __syncthreads();
    if (tid < 4) { float mx = -INFINITY; for (int n = 0; n < 128; ++n) mx = fmaxf(mx, Ss[tid * 640 + n]); float sum = 0.f;
        for (int n = 0; n < 128; ++n) { const float e = (Ss[tid * 640 + n] == -INFINITY) ? 0.f : expf(Ss[tid * 640 + n] - mx); Ss[tid * 640 + n] = e; sum += e; }
        const float inv = 1.0f / fmaxf(sum, 1e-30f); for (int n = 0; n < 128; ++n) Ss[tid * 640 + n] *= inv; }
    __syncthreads();
    { float acc = 0.f; for (int n = 0; n < ncv && n <= 126; ++n) { const float kv = bfr(Fv[(size_t)(g * 128 + n) * 256 + dd] + Fv[(size_t)(g * 128 + n + 1) * 256 + 128 + dd] + POSB[128 + dd]); acc += Ss[hh * 640 + n] * kv; }
      Oc[(0 * 4 + hh) * 128 + dd] = acc; }
    if (tid < 32) { float s = 0.f; for (int h = 0; h < 4; ++h) for (int n = 4 * tid - 1; n <= 4 * tid + 3; ++n) if (n >= 0 && n < 127) s += Ss[h * 640 + n]; IMPs[tid] = s; }
    __syncthreads();
    const int cur = t >> 6;
    if (tid == 0) { unsigned mask = 0u;
        if (cur >= 1) { if (cur <= 7) mask = (1u << cur) - 1u; else { mask = 1u;
            for (int it = 0; it < 6; ++it) { float best = -1.f; int bi = 0; for (int k = 1; k < cur; ++k) { const float v = IMPs[k]; if (!((mask >> k) & 1u) && v > best) { best = v; bi = k; } } mask |= 1u << bi; } } }
        const unsigned kmask = ((const unsigned*)(F.ws + (size_t)1272 * MiB))[(b * 2 + g) * 2048 + t];
        MSK[2] = (kmask != mask) ? 1u : 0u;
#if CHK_USE_KMASK
        mask = kmask;
#endif
        int nk = 0; for (int k = 0; k < 32; ++k) if ((mask >> k) & 1u) for (int i = 0; i < 64; ++i) KP[nk++] = k * 64 + i;
        for (int s = cur * 64; s <= t; ++s) KP[nk++] = s;
        MSK[0] = mask; MSK[1] = (unsigned)nk; }
    __syncthreads();
    for (int br = 1; br <= 2; ++br) {
        const bf16_t* KV = (br == 1) ? KVS : KVWb; const int wl = t - 512 > 0 ? t - 512 : 0; const int nk = (br == 1) ? (int)MSK[1] : t - wl + 1;
        __syncthreads();
        for (int j = dd; j < 640; j += 128) { float s = -INFINITY;
            if (j < nk) { const int kp = (br == 1) ? KP[j] : wl + j; const bf16_t* kr = KV + ((size_t)b * SEQ + kp) * 512 + g * 128; float acc = 0.f; for (int d = 0; d < 128; ++d) acc += Qs[hh * 128 + d] * bf2f(kr[d]);
                s = acc * SCL + slope * (float)kp; }
            Ss[hh * 640 + j] = s; }
        __syncthreads();
        if (tid < 4) { float mx = -INFINITY; for (int n = 0; n < 640; ++n) mx = fmaxf(mx, Ss[tid * 640 + n]); float sum = 0.f;
            for (int n = 0; n < 640; ++n) { const float e = (Ss[tid * 640 + n] == -INFINITY) ? 0.f : expf(Ss[tid * 640 + n] - mx); Ss[tid * 640 + n] = e; sum += e; }
            const float inv = 1.0f / fmaxf(sum, 1e-30f); for (int n = 0; n < 640; ++n) Ss[tid * 640 + n] *= inv; }
        __syncthreads();
        { float acc = 0.f; for (int j = 0; j < nk; ++j) { const int kp = (br == 1) ? KP[j] : wl + j; acc += Ss[hh * 640 + j] * bf2f(KV[((size_t)b * SEQ + kp) * 512 + 256 + g * 128 + dd]); }
          Oc[(br * 4 + hh) * 128 + dd] = acc; }
    }
    __syncthreads();
    { const int head = g * 4 + hh; float ref = 0.f; for (int br = 0; br < 3; ++br) ref += GNSA[row * 32 + br * 8 + head] * Oc[(br * 4 + hh) * 128 + dd];
      const float mine = bf2f(OB[row * 1024 + head * 128 + dd]); RED[tid] = (mine - ref) * (mine - ref); RED[512 + tid] = ref * ref; }
    __syncthreads();
    if (tid == 0) { float e2 = 0.f, r2 = 0.f; for (int i = 0; i < 512; ++i) { e2 += RED[i]; r2 += RED[512 + i]; }
#if CHK_SELONLY
        if (MSK[2]) {
#else
        if (e2 > CHK_TOL * r2) {
#endif
          const float v = CHK_VEXPR;
            F.out[O_PRH + bid] = v; } }
}
#endif

#ifndef P7_ROWS
#define P7_ROWS 16
#endif
__device__ __forceinline__ void p7_act(const Frame& F) {
    const bf16_t* GB = WSP(bf16_t, WS_GB); const bf16_t* UB = WSP(bf16_t, WS_UB); bf16_t* ACT = WSP(bf16_t, WS_ACT);
    const int gt = F.bid * 512 + F.tid, NT = F.G * 512;
    for (int idx = gt; idx < (M / P7_ROWS) * 768; idx += NT) { const int cgp = idx % 768, r0 = (idx / 768) * P7_ROWS, c = cgp * 8; const bool samp = r0 >= MP;
        float w0[8], w1[8], w2[8], bb[8], g2[8], g1[8];
#pragma unroll
        for (int e = 0; e < 8; e += 4) { const f32x4 a = *(const f32x4*)(F.fconv_w + c + e), b4 = *(const f32x4*)(F.fconv_w + DFF + c + e), c4 = *(const f32x4*)(F.fconv_w + 2 * DFF + c + e), d4 = *(const f32x4*)(F.fconv_b + c + e);
#pragma unroll
            for (int j = 0; j < 4; ++j) { w0[e + j] = a[j]; w1[e + j] = b4[j]; w2[e + j] = c4[j]; bb[e + j] = d4[j]; } }
        if (!samp && (r0 & 2047) != 0) { const u32x4 a = *(const u32x4*)(GB + (size_t)(r0 - 2) * DFF + c), b4 = *(const u32x4*)(GB + (size_t)(r0 - 1) * DFF + c);
            g2[0] = bflo(a.x); g2[1] = bfhi(a.x); g2[2] = bflo(a.y); g2[3] = bfhi(a.y); g2[4] = bflo(a.z); g2[5] = bfhi(a.z); g2[6] = bflo(a.w); g2[7] = bfhi(a.w);
            g1[0] = bflo(b4.x); g1[1] = bfhi(b4.x); g1[2] = bflo(b4.y); g1[3] = bfhi(b4.y); g1[4] = bflo(b4.z); g1[5] = bfhi(b4.z); g1[6] = bflo(b4.w); g1[7] = bfhi(b4.w); }
        else {
#pragma unroll
            for (int e = 0; e < 8; ++e) { g2[e] = 0.f; g1[e] = 0.f; } }
#pragma unroll 4
        for (int i = 0; i < P7_ROWS; ++i) { const int r = r0 + i;
            if (samp && (i & 3) == 0) { const int db = (r - MP) >> 2; const float* sp = F.st_ffn + (size_t)db * 2 * DFF + c;
                const f32x4 a = *(const f32x4*)sp, a2 = *(const f32x4*)(sp + 4), b4 = *(const f32x4*)(sp + DFF), b5 = *(const f32x4*)(sp + DFF + 4);
#pragma unroll
                for (int j = 0; j < 4; ++j) { g2[j] = a[j]; g2[4 + j] = a2[j]; g1[j] = b4[j]; g1[4 + j] = b5[j]; } }
            const u32x4 gw = *(const u32x4*)(GB + (size_t)r * DFF + c), uw = *(const u32x4*)(UB + (size_t)r * DFF + c);
            float g0[8], uu[8], ov[8];
            g0[0] = bflo(gw.x); g0[1] = bfhi(gw.x); g0[2] = bflo(gw.y); g0[3] = bfhi(gw.y); g0[4] = bflo(gw.z); g0[5] = bfhi(gw.z); g0[6] = bflo(gw.w); g0[7] = bfhi(gw.w);
            uu[0] = bflo(uw.x); uu[1] = bfhi(uw.x); uu[2] = bflo(uw.y); uu[3] = bfhi(uw.y); uu[4] = bflo(uw.z); uu[5] = bfhi(uw.z); uu[6] = bflo(uw.w); uu[7] = bfhi(uw.w);
#pragma unroll
            for (int e = 0; e < 8; ++e) { const float pre = bb[e] + w0[e] * g2[e] + w1[e] * g1[e] + w2[e] * g0[e]; ov[e] = gelu_tanh(pre) * uu[e]; g2[e] = g1[e]; g1[e] = g0[e]; }
            u32x4 o; o.x = pk2(ov[0], ov[1]); o.y = pk2(ov[2], ov[3]); o.z = pk2(ov[4], ov[5]); o.w = pk2(ov[6], ov[7]);
            *(u32x4*)(ACT + (size_t)r * DFF + c) = o; } }
}
#ifndef ROWSC
#define ROWSC(m) 1.0f
#endif
__device__ __forceinline__ void p9_final(const Frame& F) {
    const int gw = F.bid * 8 + F.wave, NGW = F.G * 8, lane = F.lane; const float* SS = WSP(float, WS_SS3);
    f32x4 gv[8];
#pragma unroll
    for (int j = 0; j < 8; ++j) gv[j] = ((const f32x4*)F.norm_final)[lane + 64 * j];
    if (F.wave < 2) for (int s = F.wave * F.G + F.bid; s < MS; s += 2 * F.G) { const int m = MP + s; f32x4* row = (f32x4*)(F.out + (size_t)m * DM);
            const bf16_t* xb = WSP(bf16_t, WS_XB2) + (size_t)m * DM; const float* sl = WSP(float, WS_SLAB) + (size_t)(m - MP) * DM; f32x4 v[8]; float ss = 0.f;
#pragma unroll
            for (int j = 0; j < 8; ++j) { const u32x2 xw = *((const u32x2*)xb + lane + 64 * j); f32x4 a = {bflo(xw.x), bfhi(xw.x), bflo(xw.y), bfhi(xw.y)};
#pragma unroll 4
                for (int ks = 0; ks < 16; ++ks) a += *((const f32x4*)(sl + (size_t)ks * MS * DM) + lane + 64 * j);
                v[j] = a; ss += (a.x * a.x + a.y * a.y) + (a.z * a.z + a.w * a.w); }
            const float rs = 1.0f / sqrtf(wave_sum(ss) * (1.0f / DM) + EPS);
#pragma unroll
            for (int j = 0; j < 8; ++j) row[lane + 64 * j] = v[j] * (rs * SC_YS) * gv[j]; }
    { int m = gw; f32x4 cur[8]; float cs = 0.f;
      if (m < MP) { const f32x4* row = (const f32x4*)(F.out + (size_t)m * DM);
#pragma unroll
          for (int j = 0; j < 8; ++j) cur[j] = row[lane + 64 * j];
          cs = lane < 32 ? SS[(size_t)m * 32 + lane] : 0.f; }
#pragma unroll 1
      for (; m < MP; m += NGW) { const int mn = (m + NGW) < MP ? (m + NGW) : m; const f32x4* rown = (const f32x4*)(F.out + (size_t)mn * DM); f32x4 nx[8];
#pragma unroll
          for (int j = 0; j < 8; ++j) nx[j] = rown[lane + 64 * j];
          const float ns = lane < 32 ? SS[(size_t)mn * 32 + lane] : 0.f;
          const float rs = 1.0f / sqrtf(wave_sum(cs) * (1.0f / DM) + EPS); f32x4* row = (f32x4*)(F.out + (size_t)m * DM);
#pragma unroll
          for (int j = 0; j < 8; ++j) row[lane + 64 * j] = cur[j] * (rs * SC_YP * ROWSC(m)) * gv[j];
#pragma unroll
          for (int j = 0; j < 8; ++j) cur[j] = nx[j];
          cs = ns; } }
}

#ifndef PG_SP2
#define PG_SP2 true
#endif
#ifndef PG_ALIGN
#define PG_ALIGN true
#endif
__global__ void __launch_bounds__(512, 2) fwd(Args args) {
    extern __shared__ __attribute__((aligned(16))) unsigned char lds[];
    Frame F;
    F.tid = threadIdx.x; F.lane = F.tid & 63; F.wave = __builtin_amdgcn_readfirstlane(F.tid >> 6); F.G = gridDim.x; F.bid = blockIdx.x;
    F.x_p = (const float*)args.in[0]; F.x_s = (const float*)args.in[1]; F.c_cmp = (const float*)args.in[2]; F.c_slc = (const float*)args.in[3]; F.c_win = (const float*)args.in[4];
    F.st_h = (const float*)args.in[5]; F.st_conv = (const float*)args.in[6]; F.st_ffn = (const float*)args.in[7]; F.pt = (const int*)args.in[8];
    F.norm_mix = (const float*)args.in[9]; F.w_in = (const float*)args.in[10]; F.rconv_w = (const float*)args.in[11]; F.rconv_b = (const float*)args.in[12];
    F.rwa = (const float*)args.in[13]; F.rba = (const float*)args.in[14]; F.rwx = (const float*)args.in[15]; F.rbx = (const float*)args.in[16]; F.rlam = (const float*)args.in[17];
    F.cmp_w = (const float*)args.in[18]; F.cmp_pos = (const float*)args.in[19]; F.w_pr = (const float*)args.in[20]; F.w_pa = (const float*)args.in[21]; F.w_out = (const float*)args.in[22];
    F.norm_ffn = (const float*)args.in[23]; F.w_gate = (const float*)args.in[24]; F.w_up = (const float*)args.in[25]; F.fconv_w = (const float*)args.in[26]; F.fconv_b = (const float*)args.in[27];
    F.w_down = (const float*)args.in[28]; F.norm_final = (const float*)args.in[29];
    F.out = args.out; F.ws = args.ws;
    LAS unsigned char* ldsl = (LAS unsigned char*)lds;
    volatile LAS unsigned* MISC = (volatile LAS unsigned*)(ldsl + MISC_OFF);
    if (F.tid < 32) MISC[F.tid] = 0u;
    __syncthreads();
    const int lo = args.ph_lo, hi = args.ph_hi;
    const bool multi = (hi - lo) > 1;
    XcdBarrier bar; bar.bar = (unsigned*)(F.ws + WS_CTL) + CW_BAR; bar.x = 0; bar.st = nullptr;
    if (multi) bar = xcd_barrier_post((unsigned*)(F.ws + WS_CTL) + CW_BAR, MISC + 8);
#ifndef PH_MASK
#define PH_MASK 0xfff
#endif
#define IN(k) (((PH_MASK >> (k)) & 1) && lo <= (k) && (k) < hi)
#ifndef SEAM_REP
#define SEAM_REP 1
#endif
#define SEAM(k) do { if (IN(k) && IN((k) + 1)) { for (int rep_ = 0; rep_ < SEAM_REP; ++rep_) xcd_barrier(bar); } } while (0)

    #ifdef REPEAT_P0SKIP
    if (IN(0)) { p0_prologue(F, lds, args.qhi < 0 ? args.qlo : 0); } SEAM(0);
#else
    if (IN(0)) { p0_prologue(F, lds, 0); } SEAM(0);
#endif
        const int P1_BUSY = ((M / 256) * (N1 / 256)) % F.G;
    const int NEARLY = P1_BUSY > 0 ? ((F.G - P1_BUSY) < 256 ? (F.G - P1_BUSY) : 256) : 0;
    const int NCMP2 = NCU_UNITS - NEARLY;
#ifdef REPEAT_LD
    const int ld1 = (args.qhi < 0 && args.qlo > 0) ? args.qlo : DM;
#else
    constexpr int ld1 = DM;
#endif
    if (IN(1)) { pg8::Gemm g{WSP(bf16_t, WS_XB), WSP(bf16_t, WS_W1T), M, N1, DM, ld1, ld1};
#ifdef REPEAT_SWAPBUF
        if (args.qhi < 0) { g.A = WSP(bf16_t, WS_XB2); g.Bt = WSP(bf16_t, WS_WG); }
#endif
 pg8::StaticOrder S; S.init(M, N1, F.G, F.bid);
#ifdef REPEAT_WGM
        if (args.qhi < 0) S.wgm = REPEAT_WGM;
#endif

        EpiIn E{WSP(float, WS_RSTD1), WSP(bf16_t, WS_XR), WSP(bf16_t, WS_GG), WSP(bf16_t, WS_Q), WSP(bf16_t, WS_KVS), WSP(bf16_t, WS_KVW), WSP(bf16_t, WS_CC), WSP(bf16_t, WS_SGM), WSP(float, WS_GNSA), F.out, args.qhi < 0};
        pg8::gemm_phase<EpiIn, pg8::StaticOrder, PG_ALIGN, PG_SP2>(ldsl, g, S, E);
        if (F.bid >= P1_BUSY && NEARLY > 0) {
            pg8::Gemm gc{WSP(bf16_t, WS_CC), WSP(bf16_t, WS_WC), NCU_UNITS * 256, 512, 2048, 2048, 2048}; CmpOrder Sc{NEARLY, F.bid - P1_BUSY, 0, NEARLY}; EpiFS Ec{WSP(float, WS_FS)};
            pg8::gemm_phase<EpiFS, CmpOrder, PG_ALIGN, PG_SP2>(ldsl, gc, Sc, Ec); } } SEAM(1);

#ifdef REPEAT_P2SKIP
    const int p2skip = args.qhi < 0 ? args.qlo : 0;
#else
    constexpr int p2skip = 0;
#endif
    if (IN(2)) {
        { LAS float* red = (LAS float*)(ldsl + XL_OFF);
          for (int e = F.bid; e < 256; e += F.G) { float s = 0.f; for (int w = F.tid; w < F.G; w += 512) s += WSP(float, WS_POSP)[w * 256 + e];
              s = wave_sum(s); if (F.lane == 0) red[F.wave] = s; __syncthreads();
              if (F.tid == 0) WSP(float, WS_POSB)[e] = ((red[0] + red[1]) + (red[2] + red[3])) + ((red[4] + red[5]) + (red[6] + red[7])); __syncthreads(); } }
        if (!(p2skip & 1)) { pg8::Gemm g{WSP(bf16_t, WS_CC), WSP(bf16_t, WS_WC), NCU_UNITS * 256, 512, 2048, 2048, 2048}; CmpOrder S{F.G, F.bid, NEARLY, NCMP2}; EpiFS E{WSP(float, WS_FS)};
          pg8::gemm_phase<EpiFS, CmpOrder, PG_ALIGN, PG_SP2>(ldsl, g, S, E); }
        if (!(p2skip & 2)) for (int u = F.bid; u < 256; u += F.G) rglru_prompt_unit(F, u, lds);
        if (!(p2skip & 4)) for (int u = 256 + (F.G - 1 - F.bid); u < 384; u += F.G) rglru_unit(F, u, lds);
        __syncthreads(); if (!(p2skip & 8)) tr_deferred(F, lds, TR_A1, TR_A2 + TR_GDEF, NCMP2, F.G); } SEAM(2);
    if (IN(3)) {
        unsigned* qhead = (unsigned*)(F.ws + WS_CTL) + CW_QUEUE;
        for (;;) {
            if (F.tid == 0) MISC[16] = __hip_atomic_fetch_add(qhead, 1u, __ATOMIC_RELAXED, __HIP_MEMORY_SCOPE_AGENT);
            __syncthreads(); const int u = args.qlo + (int)MISC[16]; __syncthreads();
            if (u >= args.qhi) break;
            if (u < 512 && (u & 1)) att::attn_unit<true>(F, u >> 1, lds);
            else { const int gg = u < 512 ? 1 : 0, pp = u < 512 ? (u >> 1) : u - 512, qb = 31 - (pp >> 3), bb = pp & 7; att::attn_unit<false>(F, (31 - qb) * 16 + bb * 2 + gg, lds); } } } SEAM(3);
    if (IN(4)) { pg8::StaticOrder S; S.init(MP, DM, F.G, F.bid);
#ifdef PROJ_MERGED
        { pg8::Gemm g{WSP(bf16_t, WS_Y), WSP(bf16_t, WS_WPR), MP, DM, 2048, 1024, 1024, WSP(bf16_t, WS_OB), WSP(bf16_t, WS_WPA)}; EpiProjM E{WSP(bf16_t, WS_SGM), WSP(bf16_t, WS_MB)}; pg8::gemm_phase<EpiProjM, pg8::StaticOrder, PG_ALIGN, PG_SP2>(ldsl, g, S, E); }
#else
        { pg8::Gemm g{WSP(bf16_t, WS_Y), WSP(bf16_t, WS_WPR), MP, DM, 1024, 1024, 1024}; EpiProj<0> E{WSP(bf16_t, WS_SGM), WSP(bf16_t, WS_T1), WSP(bf16_t, WS_MB)}; pg8::gemm_phase<EpiProj<0>, pg8::StaticOrder, PG_ALIGN, PG_SP2>(ldsl, g, S, E); }
        { pg8::Gemm g{WSP(bf16_t, WS_OB), WSP(bf16_t, WS_WPA), MP, DM, 1024, 1024, 1024}; EpiProj<1> E{WSP(bf16_t, WS_SGM), WSP(bf16_t, WS_T1), WSP(bf16_t, WS_MB)}; pg8::gemm_phase<EpiProj<1>, pg8::StaticOrder, PG_ALIGN, PG_SP2>(ldsl, g, S, E); }
#endif
        { pg8::Gemm g{WSP(bf16_t, WS_Y), WSP(bf16_t, WS_WPR), 2 * M, DM, 256, 1024, 1024}; SplitOrder T{F.G, F.bid, 8, 256, 1}; EpiSlab<1> E{WSP(float, WS_SLAB2), 256, WSP(bf16_t, WS_SGM)};
          pg8::gemm_phase<EpiSlab<1>, SplitOrder, PG_ALIGN, PG_SP2>(ldsl, g, T, E); } } SEAM(4);
    if (IN(5)) {
        const int gt = F.bid * 512 + F.tid, NT = F.G * 512; const float* sl = WSP(float, WS_SLAB2); bf16_t* MB = WSP(bf16_t, WS_MB);
        for (int i = gt; i < MS * 256; i += NT) { const size_t o = (size_t)i * 8; f32x4 a = *(const f32x4*)(sl + o), b4 = *(const f32x4*)(sl + o + 4);
#pragma unroll
            for (int s = 1; s < 8; ++s) { a += *(const f32x4*)(sl + (size_t)s * MS * DM + o); b4 += *(const f32x4*)(sl + (size_t)s * MS * DM + o + 4); }
            *(u32x4*)(MB + (size_t)MP * DM + o) = pack8u(a, b4); } } SEAM(5);
    if (IN(6)) { { pg8::Gemm g{WSP(bf16_t, WS_MB), WSP(bf16_t, WS_WO), MP, DM, DM, DM, DM}; pg8::StaticOrder S; S.init(MP, DM, F.G, F.bid);
          EpiOut E{WSP(bf16_t, WS_XB), WSP(bf16_t, WS_XB2), WSP(float, WS_SS2)}; pg8::gemm_phase<EpiOut, pg8::StaticOrder, PG_ALIGN, PG_SP2>(ldsl, g, S, E); }
        { pg8::Gemm g{WSP(bf16_t, WS_MB), WSP(bf16_t, WS_WO), M, DM, 256, DM, DM}; SplitOrder T{F.G, F.bid, 8, 256, 0}; EpiSlab<0> E{WSP(float, WS_SLAB2), 256, nullptr};
          pg8::gemm_phase<EpiSlab<0>, SplitOrder, PG_ALIGN, PG_SP2>(ldsl, g, T, E); } } SEAM(6);
    if (IN(7)) {
        const int gw = F.bid * 8 + F.wave, NGW = F.G * 8, lane = F.lane; const float* sl = WSP(float, WS_SLAB2); const bf16_t* XB = WSP(bf16_t, WS_XB); bf16_t* XB2 = WSP(bf16_t, WS_XB2); float* SS = WSP(float, WS_SS2);
        for (int it = gw; it < MS * 4; it += NGW) { const int r = it >> 2, q = it & 3; const size_t o = (size_t)r * DM + q * 512 + lane * 8; const u32x4 xw = *(const u32x4*)(XB + (size_t)MP * DM + o);
            f32x4 a = {bflo(xw.x), bfhi(xw.x), bflo(xw.y), bfhi(xw.y)}, b4 = {bflo(xw.z), bfhi(xw.z), bflo(xw.w), bfhi(xw.w)};
#pragma unroll
            for (int s = 0; s < 8; ++s) { a += *(const f32x4*)(sl + (size_t)s * MS * DM + o); b4 += *(const f32x4*)(sl + (size_t)s * MS * DM + o + 4); }
            *(u32x4*)(XB2 + (size_t)MP * DM + o) = pack8u(a, b4);
            float ss = (a.x * a.x + a.y * a.y) + (a.z * a.z + a.w * a.w) + (b4.x * b4.x + b4.y * b4.y) + (b4.z * b4.z + b4.w * b4.w); ss = wave_sum(ss);
            if (lane < 8) SS[(size_t)(MP + r) * 32 + q * 8 + lane] = lane == 0 ? ss : 0.f; } } SEAM(7);
    if (IN(8)) { pg8::Gemm g{WSP(bf16_t, WS_XB2), WSP(bf16_t, WS_WG), M, 2 * DFF, DM, DM, DM}; pg8::StaticOrder S; S.init(M, 2 * DFF, F.G, F.bid);
        EpiFFN E{WSP(float, WS_SS2), F.fconv_w, F.fconv_b, F.st_ffn, WSP(bf16_t, WS_ACT), F.out, WSP(float, WS_GE), WSP(float, WS_G0), WSP(float, WS_U0), (LAS float*)(ldsl + XL_OFF), args.qhi < 0};
        pg8::gemm_phase<EpiFFN, pg8::StaticOrder, PG_ALIGN, PG_SP2>(ldsl, g, S, E);
        tr_deferred(F, lds, TR_A3, TR_A4, S.nwg % F.G, F.G); } SEAM(8);

    if (IN(9)) { const int gt = F.bid * 512 + F.tid, NT = F.G * 512; const float* GE = WSP(float, WS_GE); const float* G0 = WSP(float, WS_G0); const float* U0 = WSP(float, WS_U0); bf16_t* ACT = WSP(bf16_t, WS_ACT);
        for (int i = gt; i < 64 * 2 * 768; i += NT) { const int f = (i % 768) * 8, rr = (i / 768) & 1, pm = i / (2 * 768); if ((pm & 7) == 0) continue;
            const float* a0 = GE + ((size_t)(pm - 1) * 2 + 0) * DFF + f; const float* a1 = a0 + DFF; const float* b0 = G0 + ((size_t)pm * 2 + 0) * DFF + f; const float* b1 = b0 + DFF; const float* up = U0 + ((size_t)pm * 2 + rr) * DFF + f;
            float ov[8];
#pragma unroll
            for (int h = 0; h < 2; ++h) { const f32x4 gm2 = *(const f32x4*)(a0 + 4 * h), gm1 = *(const f32x4*)(a1 + 4 * h), g0 = *(const f32x4*)(b0 + 4 * h), g1 = *(const f32x4*)(b1 + 4 * h), uv = *(const f32x4*)(up + 4 * h);
                const f32x4 w0 = *(const f32x4*)(F.fconv_w + f + 4 * h), w1 = *(const f32x4*)(F.fconv_w + DFF + f + 4 * h), w2 = *(const f32x4*)(F.fconv_w + 2 * DFF + f + 4 * h), bb = *(const f32x4*)(F.fconv_b + f + 4 * h);
                const f32x4 pre = rr == 0 ? bb + w0 * gm2 + w1 * gm1 + w2 * g0 : bb + w0 * gm1 + w1 * g0 + w2 * g1;
#pragma unroll
                for (int j = 0; j < 4; ++j) ov[4 * h + j] = gelu_tanh(pre[j]) * uv[j]; }
            u32x4 o; o.x = pk2(ov[0], ov[1]); o.y = pk2(ov[2], ov[3]); o.z = pk2(ov[4], ov[5]); o.w = pk2(ov[6], ov[7]);
            *(u32x4*)(ACT + (size_t)(pm * 256 + rr) * DFF + f) = o; } } SEAM(9);
    if (IN(10)) { { pg8::Gemm g{WSP(bf16_t, WS_ACT), WSP(bf16_t, WS_WD), MP, DM, DFF, DFF, DFF}; pg8::StaticOrder S; S.init(MP, DM, F.G, F.bid);
          EpiDown E{WSP(bf16_t, WS_XB2), F.out, WSP(float, WS_SS3), args.qhi < 0}; pg8::gemm_phase<EpiDown, pg8::StaticOrder, PG_ALIGN, PG_SP2>(ldsl, g, S, E); }
        { pg8::Gemm g{WSP(bf16_t, WS_ACT), WSP(bf16_t, WS_WD), M, DM, 384, DFF, DFF}; SplitOrder S{F.G, F.bid, 16, 384, 0}; EpiSlab<0> E{WSP(float, WS_SLAB), 384, nullptr};
          pg8::gemm_phase<EpiSlab<0>, SplitOrder, PG_ALIGN, PG_SP2>(ldsl, g, S, E); } } SEAM(10);
    if (IN(11)) { p9_final(F); }
#ifdef ATT_CHECK
    if (lo <= 12 && 12 < hi) att_check(F, lds);
#endif
#ifdef PROBE
    if (lo <= 12 && 12 < hi) {
        const int gt = F.bid * 512 + F.tid, NT = F.G * 512;
        const bf16_t* P1 = WSP(bf16_t, PROBE_A); const bf16_t* P2 = WSP(bf16_t, PROBE_B);
        for (size_t i = gt; i < (size_t)M * 1024; i += NT) { const size_t r = i >> 10, c = i & 1023; F.out[r * DM + c] = bf2f(P1[(size_t)r * PROBE_LDA + c]); F.out[r * DM + 1024 + c] = bf2f(P2[(size_t)r * PROBE_LDB + c]); }
        for (size_t i = gt; i < (size_t)NBATCH * 2 * DFF; i += NT) F.out[O_PFC + i] = 0.f;
        for (size_t i = gt; i < (size_t)DBATCH * 2 * DFF; i += NT) F.out[O_SFC + i] = 0.f;
    }
#endif
#undef IN
#undef SEAM
}

extern "C" void kernel_launch(void* const* d_in, const int* in_sizes, int n_in, void* d_out, int out_size, void* d_ws, size_t ws_size, hipStream_t stream) {
    static int grid = 0;
    if (grid == 0) {
        if (n_in != 30 || (size_t)out_size != O_END || ws_size < WS_END) { fprintf(stderr, "kernel_launch: unexpected shapes: n_in %d out %d (want %zu) ws %zu (want %zu)\n", n_in, out_size, (size_t)O_END, ws_size, (size_t)WS_END); grid = -1; return; }
        int dev = 0, cus = 0, per_cu = 0;
        if (hipGetDevice(&dev) != hipSuccess || hipDeviceGetAttribute(&cus, hipDeviceAttributeMultiprocessorCount, dev) != hipSuccess) { grid = -1; return; }
        if (hipFuncSetAttribute((const void*)fwd, hipFuncAttributeMaxDynamicSharedMemorySize, LDS_BYTES) != hipSuccess) { fprintf(stderr, "kernel_launch: hipFuncSetAttribute failed\n"); grid = -1; return; }
        if (hipOccupancyMaxActiveBlocksPerMultiprocessor(&per_cu, (const void*)fwd, 512, LDS_BYTES) != hipSuccess || per_cu < 1) fprintf(stderr, "kernel_launch: occupancy query reports %d\n", per_cu);
        (void)hipGetLastError();
        grid = cus;
    }
    if (grid < 0) return;
    if (hipMemsetAsync((char*)d_ws + WS_CTL, 0, CTL_ZERO_BYTES, stream) != hipSuccess) return;
    Args a{};
    for (int i = 0; i < 30; ++i) a.in[i] = d_in[i];
    a.out = (float*)d_out; a.ws = (unsigned char*)d_ws; a.qlo = 0; a.qhi = 768;
#if MK_ONE_LAUNCH
    a.ph_lo = 0; a.ph_hi = NPHASE;
    hipLaunchKernelGGL(fwd, dim3(grid), dim3(512), LDS_BYTES, stream, a);
#else
#if defined(ATT_CHECK)
    for (int q = 0; q < NPHASE + 1; ++q) { const int p = q < 4 ? q : (q == 4 ? 12 : q - 1); a.ph_lo = p; a.ph_hi = p + 1; hipLaunchKernelGGL(fwd, dim3(grid), dim3(512), LDS_BYTES, stream, a); }
#elif defined(PROBE)
    for (int p = 0; p < NPHASE + 1; ++p) { a.ph_lo = p; a.ph_hi = p + 1; hipLaunchKernelGGL(fwd, dim3(grid), dim3(512), LDS_BYTES, stream, a); }
#else
    for (int p = 0; p < NPHASE; ++p) { a.ph_lo = p; a.ph_hi = p + 1; hipLaunchKernelGGL(fwd, dim3(grid), dim3(512), LDS_BYTES, stream, a);
#ifdef REPEAT_PH
#ifndef REPEAT_SKIP
#define REPEAT_SKIP 0
#endif
#ifndef REPEAT_QLO
#define REPEAT_QLO 0
#define REPEAT_QHI 768
#endif
        if (p == REPEAT_PH) { if (p == 1 || p == 8 || p == 10) a.qhi = REPEAT_SKIP ? -1 : 768;
#ifdef REPEAT_LD
            if (p == 1) a.qlo = REPEAT_LD;
#endif
#ifdef REPEAT_P0SKIP
            if (p == 0) { a.qhi = -1; a.qlo = REPEAT_P0SKIP; }
#endif
#ifdef REPEAT_P2SKIP
            if (p == 2) { a.qhi = -1; a.qlo = REPEAT_P2SKIP; }
#endif
 if (p == 3) { (void)hipMemsetAsync((char*)d_ws + WS_CTL + CW_QUEUE * 4, 0, 4, stream); a.qlo = REPEAT_QLO; a.qhi = REPEAT_QHI; } hipLaunchKernelGGL(fwd, dim3(grid), dim3(512), LDS_BYTES, stream, a); a.qlo = 0; a.qhi = 768; }
#endif
    }
#endif
#endif
}
```

```cpp
#include <hip/hip_runtime.h>
#include <cstdio>
#include <cstdint>
#define MK_ONE_LAUNCH 1
#define PROJ_MERGED 1
namespace pg8 {
#define PG8_LAS __attribute__((address_space(3)))
typedef unsigned short bf16_t;
typedef short bf16x8 __attribute__((ext_vector_type(8)));
typedef float f32x4 __attribute__((ext_vector_type(4)));
typedef unsigned u32x4 __attribute__((ext_vector_type(4)));
constexpr int BM = 256, BK = 64, HALF = 128, HTB = HALF * BK * 2  , STAGE_BYTES = 8 * HTB, NXCD = 8, WGM = 8;

__host__ __device__ __forceinline__ int lds_byte(int r, int c) { const int st = (r >> 4) * 2 + (c >> 5), rr = r & 15, cc = c & 31, ob = rr * 64 + cc * 2; return st * 1024 + (ob ^ (((ob >> 9) & 1) << 5)); }
__host__ __device__ __forceinline__ void stage_rc(int b, int& R, int& C) { const int st = b / 1024, sb = b % 1024, swz = sb ^ (((sb >> 9) & 1) << 5); R = (st >> 1) * 16 + swz / 64; C = (st & 1) * 32 + (swz % 64) / 2; }
__host__ __device__ __forceinline__ int perm32(int rho) { const int n = rho >> 4, i = rho & 15; return 8 * (i >> 2) + 4 * n + (i & 3); }

struct Unit { int pm, pn, ko; };
struct Gemm { const bf16_t* A; const bf16_t* Bt; int M, N, K, lda, ldb; const bf16_t* A2 = nullptr; const bf16_t* Bt2 = nullptr; };

struct StaticOrder {
    int nM, nN, nwg, G, c, wgm;
    __host__ __device__ void init(int M, int N, int G_, int c_, int wgm_ = WGM) { nM = M / BM; nN = N / BM; nwg = nM * nN; G = G_; c = c_; wgm = wgm_; }
    __host__ __device__ bool next(int i, Unit& u) const {
        const long L = (long)i * G + c; if (L >= nwg) return false;
        int wgid = (int)L; { const int q = nwg / NXCD, r = nwg % NXCD, xcd = wgid % NXCD, off = wgid / NXCD; wgid = (xcd < r ? xcd * (q + 1) : r * (q + 1) + (xcd - r) * q) + off; }
        const int nig = wgm * nN, gid = wgid / nig, fm = gid * wgm, gsz = (nM - fm) < wgm ? (nM - fm) : wgm;
        u.pm = fm + ((wgid % nig) % gsz); u.pn = (wgid % nig) / gsz; u.ko = 0; return true;
    }
    __device__ __forceinline__ void a_ready(const Unit&) const {}
    __device__ __forceinline__ void done(const Unit&) const {}
};
typedef __bf16 bf16x2n_t __attribute__((ext_vector_type(2)));
typedef float f32x2n_t __attribute__((ext_vector_type(2)));
__device__ __forceinline__ unsigned cvt_pk_bf16(float lo, float hi) { const f32x2n_t f = {lo, hi}; return __builtin_bit_cast(unsigned, __builtin_convertvector(f, bf16x2n_t)); }
template <class Epi, class Sched, bool ALIGN_EPI = false, bool SP2 = false>
__device__ __forceinline__ void gemm_phase(PG8_LAS unsigned char* lds, const Gemm g, const Sched& S, const Epi& E) {
    const int tid = threadIdx.x, wid = __builtin_amdgcn_readfirstlane(tid >> 6), lane = tid & 63, wr = wid >> 2, wc = wid & 3, fr = lane & 15, fq = lane >> 4;
    const int K = g.K, nt = K / BK;
    unsigned voffA[2], voffB[2];
#pragma unroll
    for (int i = 0; i < 2; ++i) { int R, C; stage_rc(tid * 16 + i * 8192, R, C); const int Rb = Epi::PERM ? ((R & ~31) + perm32(R & 31)) : R;
        voffA[i] = (unsigned)(R * g.lda + C) * 2u; voffB[i] = (unsigned)(Rb * g.ldb + C) * 2u; }
    const size_t kstep = (size_t)(BK * 2);
    const size_t hstepA = (size_t)HALF * g.lda * 2, hstepB = (size_t)HALF * g.ldb * 2;
    const size_t tstepA = 2 * hstepA, tstepB = 2 * hstepB;
    const unsigned ldsw = (unsigned)wid * 1024u;
    const int aoff = lds_byte(wr * 64 + fr, fq * 8), boff = lds_byte(wc * 32 + fr, fq * 8);
#define PG8_SA(b, h) (((b) * 2 + (h)) * HTB)
#define PG8_SB(b, h) ((4 + (b) * 2 + (h)) * HTB)
#define PG8_STAGE(bufoff, gbase, voff) do { _Pragma("unroll") for (int _i = 0; _i < 2; ++_i) \
        __builtin_amdgcn_global_load_lds((const unsigned*)((const char*)(gbase) + (voff)[_i]), (PG8_LAS unsigned*)(lds + (bufoff) + ldsw + _i * 8192), 16, 0, 0); } while (0)
#define PG8_LDA(dst, b, h) do { _Pragma("unroll") for (int m = 0; m < 4; ++m) _Pragma("unroll") for (int k = 0; k < 2; ++k) dst[m][k] = *(const PG8_LAS bf16x8*)(lds + PG8_SA(b, h) + aoff + m * 2048 + k * 1024); } while (0)
#define PG8_LDB(dst, b, h) do { _Pragma("unroll") for (int n = 0; n < 2; ++n) _Pragma("unroll") for (int k = 0; k < 2; ++k) dst[n][k] = *(const PG8_LAS bf16x8*)(lds + PG8_SB(b, h) + boff + n * 2048 + k * 1024); } while (0)
#define PG8_MMA(ai, bj, At, Bt) do { __builtin_amdgcn_s_setprio(1); _Pragma("unroll") for (int m = 0; m < 4; ++m) _Pragma("unroll") for (int n = 0; n < 2; ++n) _Pragma("unroll") for (int k = 0; k < 2; ++k) \
        acc[ai][bj][m][n] = __builtin_amdgcn_mfma_f32_16x16x32_bf16(Bt[n][k], At[m][k], acc[ai][bj][m][n], 0, 0, 0); __builtin_amdgcn_s_setprio(0); } while (0)
#define PG8_WAIT_V(n) asm volatile("s_waitcnt vmcnt(" #n ")" ::: "memory")
#define PG8_WAIT_L(n) asm volatile("s_waitcnt lgkmcnt(" #n ")" ::: "memory")
#define PG8_BAR __builtin_amdgcn_s_barrier()
#define PG8_SCHED __builtin_amdgcn_sched_barrier(0)
    Unit cur, nxt; int ui = 0;
    if (!S.next(0, cur)) return;
    f32x4 acc[2][2][4][2];
#pragma unroll
    for (int a = 0; a < 2; ++a)
#pragma unroll
        for (int b = 0; b < 2; ++b)
#pragma unroll
            for (int m = 0; m < 4; ++m)
#pragma unroll
                for (int n = 0; n < 2; ++n) acc[a][b][m][n] = (f32x4){0.f, 0.f, 0.f, 0.f};
    bf16x8 At[4][2], B0[2][2], B1[2][2];
    const char* cA = (const char*)g.A + (size_t)cur.pm * tstepA + (size_t)cur.ko * 2; const char* cB = (const char*)g.Bt + (size_t)cur.pn * tstepB + (size_t)cur.ko * 2;
    const int ks = nt / 2;
    const char* cA2 = nullptr; const char* cB2 = nullptr;
    if constexpr (Epi::MIDK) { cA2 = (const char*)g.A2 + (size_t)cur.pm * tstepA - (size_t)ks * kstep; cB2 = (const char*)g.Bt2 + (size_t)cur.pn * tstepB - (size_t)ks * kstep; }
    S.a_ready(cur);
    if constexpr (SP2) {
        PG8_STAGE(PG8_SB(0, 0), cB, voffB); PG8_STAGE(PG8_SB(0, 1), cB + hstepB, voffB); PG8_STAGE(PG8_SA(0, 0), cA, voffA); PG8_STAGE(PG8_SA(0, 1), cA + hstepA, voffA);
        if (wr == 1) PG8_BAR;
        PG8_WAIT_V(2); PG8_BAR;
        PG8_STAGE(PG8_SB(1, 0), cB + kstep, voffB); PG8_STAGE(PG8_SA(1, 0), cA + kstep, voffA); PG8_STAGE(PG8_SB(1, 1), cB + hstepB + kstep, voffB);
        PG8_WAIT_V(6); PG8_BAR;
    } else {
        PG8_STAGE(PG8_SB(0, 0), cB, voffB); PG8_STAGE(PG8_SA(0, 0), cA, voffA); PG8_STAGE(PG8_SB(0, 1), cB + hstepB, voffB); PG8_STAGE(PG8_SA(0, 1), cA + hstepA, voffA);
        if (wr == 1) PG8_BAR;
        PG8_WAIT_V(4); PG8_BAR;
        PG8_STAGE(PG8_SB(1, 0), cB + kstep, voffB); PG8_STAGE(PG8_SA(1, 0), cA + kstep, voffA); PG8_STAGE(PG8_SB(1, 1), cB + hstepB + kstep, voffB);
        PG8_WAIT_V(6); PG8_BAR;
    }
    for (;;) {
        const bool has_next = S.next(ui + 1, nxt);
        const char* nA = has_next ? (const char*)g.A + (size_t)nxt.pm * tstepA + (size_t)nxt.ko * 2 : cA; const char* nB = has_next ? (const char*)g.Bt + (size_t)nxt.pn * tstepB + (size_t)nxt.ko * 2 : cB;
#pragma unroll
        for (int seg = 0; seg < (Epi::MIDK ? 2 : 1); ++seg) {
        if constexpr (Epi::MIDK) { if (seg == 1) E.mid(acc, cur, wr, wc, fr, fq); }
        for (int t = (seg == 0 ? 0 : ks); t < ((Epi::MIDK && seg == 0) ? ks : nt); t += 2) {
            const bool last = (t == nt - 2);
            const char* pA1 = cA; const char* pA2 = cA; const char* pB2 = cB;
            if constexpr (Epi::MIDK) { if (t >= ks) pA1 = cA2; if (t + 2 >= ks) { pA2 = cA2; pB2 = cB2; } }
            const char* a1 = pA1 + (size_t)(t + 1) * kstep;
            const char* a2 = last ? nA : pA2 + (size_t)(t + 2) * kstep; const char* b2 = last ? nB : pB2 + (size_t)(t + 2) * kstep;
            const char* a3 = a2 + kstep; const char* b3 = b2 + kstep;
            if (last && has_next) S.a_ready(nxt);
            if constexpr (Epi::PRE) { if (last) E.pre(cur, wid, lane); }
            if constexpr (SP2) {
            PG8_LDB(B0, 0, 0); PG8_LDB(B1, 0, 1); PG8_SCHED; PG8_LDA(At, 0, 0); PG8_STAGE(PG8_SA(1, 1), a1 + hstepA, voffA);
            PG8_WAIT_V(8); PG8_WAIT_L(0); PG8_BAR; PG8_MMA(0, 0, At, B0); PG8_MMA(0, 1, At, B1); PG8_BAR; PG8_SCHED;
            PG8_LDA(At, 0, 1); PG8_STAGE(PG8_SB(0, 0), b2, voffB); PG8_STAGE(PG8_SB(0, 1), b2 + hstepB, voffB); PG8_STAGE(PG8_SA(0, 0), a2, voffA);
            PG8_WAIT_V(8); PG8_WAIT_L(0); PG8_BAR; PG8_MMA(1, 0, At, B0); PG8_MMA(1, 1, At, B1); PG8_BAR; PG8_SCHED;
            PG8_LDB(B0, 1, 0); PG8_LDB(B1, 1, 1); PG8_SCHED; PG8_LDA(At, 1, 0); PG8_STAGE(PG8_SA(0, 1), a2 + hstepA, voffA);
            PG8_WAIT_V(8); PG8_WAIT_L(0); PG8_BAR; PG8_MMA(0, 0, At, B0); PG8_MMA(0, 1, At, B1); PG8_BAR; PG8_SCHED;
            PG8_LDA(At, 1, 1); PG8_STAGE(PG8_SB(1, 0), b3, voffB); PG8_STAGE(PG8_SB(1, 1), b3 + hstepB, voffB); PG8_STAGE(PG8_SA(1, 0), a3, voffA);
            PG8_WAIT_V(8); PG8_WAIT_L(0); PG8_BAR; PG8_MMA(1, 0, At, B0); PG8_MMA(1, 1, At, B1); PG8_BAR; PG8_SCHED;
            } else {
            PG8_LDB(B0, 0, 0); PG8_SCHED; PG8_LDA(At, 0, 0); PG8_STAGE(PG8_SA(1, 1), a1 + hstepA, voffA);
            PG8_WAIT_L(8); PG8_BAR; PG8_WAIT_L(0); PG8_MMA(0, 0, At, B0); PG8_BAR; PG8_SCHED;
            PG8_LDB(B1, 0, 1); PG8_STAGE(PG8_SB(0, 0), b2, voffB);
            PG8_BAR; PG8_WAIT_L(0); PG8_MMA(0, 1, At, B1); PG8_BAR;
            PG8_LDA(At, 0, 1); PG8_STAGE(PG8_SA(0, 0), a2, voffA);
            PG8_BAR; PG8_WAIT_L(0); PG8_MMA(1, 0, At, B0); PG8_BAR; PG8_SCHED;
            PG8_STAGE(PG8_SB(0, 1), b2 + hstepB, voffB);
            PG8_WAIT_V(6); PG8_BAR; PG8_MMA(1, 1, At, B1); PG8_BAR;
            PG8_LDB(B0, 1, 0); PG8_SCHED; PG8_LDA(At, 1, 0); PG8_STAGE(PG8_SA(0, 1), a2 + hstepA, voffA);
            PG8_WAIT_L(8); PG8_BAR; PG8_WAIT_L(0); PG8_MMA(0, 0, At, B0); PG8_BAR; PG8_SCHED;
            PG8_LDB(B1, 1, 1); PG8_STAGE(PG8_SB(1, 0), b3, voffB);
            PG8_BAR; PG8_WAIT_L(0); PG8_MMA(0, 1, At, B1); PG8_BAR;
            PG8_LDA(At, 1, 1); PG8_STAGE(PG8_SA(1, 0), a3, voffA);
            PG8_BAR; PG8_WAIT_L(0); PG8_MMA(1, 0, At, B0); PG8_BAR; PG8_SCHED;
            PG8_STAGE(PG8_SB(1, 1), b3 + hstepB, voffB);
            PG8_WAIT_V(6); PG8_BAR; PG8_MMA(1, 1, At, B1); PG8_BAR;
            }
        }
        }
        if constexpr (ALIGN_EPI) { if (wr == 0) PG8_BAR; }
        if constexpr (!Epi::AFTER_DRAIN) { E(acc, cur, wr, wc, fr, fq); S.done(cur); }
        if (!has_next) break;
#pragma unroll
        for (int a = 0; a < 2; ++a)
#pragma unroll
            for (int b = 0; b < 2; ++b)
#pragma unroll
                for (int m = 0; m < 4; ++m)
#pragma unroll
                    for (int n = 0; n < 2; ++n) acc[a][b][m][n] = (f32x4){0.f, 0.f, 0.f, 0.f};
        cur = nxt; cA = nA; cB = nB; ++ui;
        if constexpr (Epi::MIDK) { cA2 = (const char*)g.A2 + (size_t)cur.pm * tstepA - (size_t)ks * kstep; cB2 = (const char*)g.Bt2 + (size_t)cur.pn * tstepB - (size_t)ks * kstep; }
        if constexpr (ALIGN_EPI) { if (wr == 1) PG8_BAR; }
    }
    PG8_WAIT_V(0);
    if constexpr (!ALIGN_EPI) { if (wr == 0) PG8_BAR; }
    PG8_BAR;
    if constexpr (Epi::AFTER_DRAIN) { E.fused(acc, cur, wr, wc, fr, fq, lds, wid, lane); S.done(cur); }
#undef PG8_SA
#undef PG8_SB
#undef PG8_STAGE
#undef PG8_LDA
#undef PG8_LDB
#undef PG8_MMA
#undef PG8_WAIT_V
#undef PG8_WAIT_L
#undef PG8_BAR
#undef PG8_SCHED
}
}

#define LAS __attribute__((address_space(3)))
using pg8::bf16_t; using pg8::bf16x8; using pg8::f32x4; using pg8::u32x4; using pg8::Unit;
typedef float f32x16 __attribute__((ext_vector_type(16)));
typedef short s16x4 __attribute__((ext_vector_type(4)));
typedef unsigned u32x2 __attribute__((ext_vector_type(2)));

#ifndef MK_ONE_LAUNCH
#define MK_ONE_LAUNCH 0
#endif
constexpr int NPHASE = 12;
#ifndef SC_YP
#define SC_YP 1.0f
#endif
#ifndef SC_YS
#define SC_YS 1.0f
#endif
#ifndef SC_PFC
#define SC_PFC 1.0f
#endif
#ifndef SC_SFC
#define SC_SFC 1.0f
#endif
#ifndef SC_PRH
#define SC_PRH 1.0f
#endif
#ifndef SC_SRH
#define SC_SRH 1.0f
#endif
constexpr int DM = 2048, NBATCH = 8, SEQ = 2048, DBATCH = 128, DSEQ = 4;
constexpr int MP = NBATCH * SEQ, MS = DBATCH * DSEQ, M = MP + MS;
constexpr int DFF = 6144, N1 = 8704;
constexpr float EPS = 1e-6f;
constexpr int NCU_UNITS = 272;

constexpr size_t O_YP = 0, O_YS = O_YP + (size_t)MP * DM, O_PKC = O_YS + (size_t)MS * DM, O_PKS = O_PKC + (size_t)MP * 512, O_PKW = O_PKS + (size_t)MP * 512,
    O_PRH = O_PKW + (size_t)NBATCH * 512 * 512, O_PRC = O_PRH + NBATCH * 1024, O_PFC = O_PRC + NBATCH * 3 * 1024, O_SKC = O_PFC + (size_t)NBATCH * 2 * DFF,
    O_SKS = O_SKC + (size_t)MS * 512, O_SKW = O_SKS + (size_t)MS * 512, O_SRH = O_SKW + (size_t)DBATCH * 512 * 512, O_SRC = O_SRH + DBATCH * 1024,
    O_SFC = O_SRC + DBATCH * 3 * 1024, O_END = O_SFC + (size_t)DBATCH * 2 * DFF;

constexpr size_t MiB = 1u << 20;
constexpr size_t WS_CTL = 0, CTL_ZERO_BYTES = 1 * MiB;
constexpr size_t WS_SS2 = 1265 * MiB, WS_SS3 = 1268 * MiB;
constexpr size_t WS_RSTD1 = 1 * MiB, WS_POSB = 1 * MiB + 128 * 1024, WS_POSP = 1 * MiB + 256 * 1024;
constexpr size_t WS_W1T = 2 * MiB, WS_WPR = 37 * MiB, WS_WPA = 41 * MiB, WS_WO = 45 * MiB, WS_WG = 53 * MiB, WS_WU = 77 * MiB, WS_WD = 101 * MiB, WS_WC = 125 * MiB;
constexpr size_t WS_XB = 128 * MiB, WS_XR = 194 * MiB, WS_GG = 227 * MiB, WS_Q = 260 * MiB, WS_KVS = 293 * MiB, WS_KVW = 310 * MiB, WS_CC = 327 * MiB, WS_FS = 600 * MiB,
    WS_SGM = 668 * MiB, WS_GNSA = 800 * MiB, WS_Y = 803 * MiB, WS_OB = 836 * MiB, WS_OMIX = 869 * MiB, WS_T1 = 935 * MiB, WS_MB = 1001 * MiB, WS_XP1 = 1067 * MiB, WS_XB2 = 1199 * MiB,
    WS_END = 1271 * MiB;
constexpr size_t WS_GE = WS_MB, WS_G0 = WS_MB + 4 * MiB, WS_U0 = WS_MB + 8 * MiB;
constexpr size_t WS_SLAB = WS_T1, WS_SLAB2 = WS_OMIX;
constexpr size_t WS_GB = 128 * MiB, WS_UB = 326 * MiB, WS_ACT = 524 * MiB;
static_assert(WS_W1T + (size_t)N1 * 2048 * 2 <= WS_WPR && WS_WD + (size_t)2048 * 6144 * 2 <= WS_WC && WS_WC + (size_t)512 * 2048 * 2 <= WS_XB, "ws map weights");
static_assert(WS_XB + (size_t)M * 2048 * 2 <= WS_XR && WS_XR + (size_t)M * 1024 * 2 <= WS_GG && WS_Q + (size_t)M * 1024 * 2 <= WS_KVS && WS_KVS + (size_t)M * 512 * 2 <= WS_KVW && WS_KVW + (size_t)M * 512 * 2 <= WS_CC, "ws map act");
static_assert(WS_CC + (size_t)(NCU_UNITS * 256 + 8) * 2048 * 2 <= WS_FS && WS_FS + (size_t)NCU_UNITS * 65536 * 4 <= WS_SGM && WS_SGM + (size_t)M * 4096 * 2 <= WS_GNSA && WS_GNSA + (size_t)M * 32 * 4 <= WS_Y, "ws map 2");
static_assert(WS_Y + (size_t)M * 1024 * 2 <= WS_OB && WS_OB + (size_t)M * 1024 * 2 <= WS_OMIX && WS_OMIX + (size_t)M * 1024 * 4 <= WS_T1 && WS_T1 + (size_t)M * 2048 * 2 <= WS_MB && WS_MB + (size_t)M * 2048 * 2 <= WS_XP1, "ws map 3");
static_assert(WS_XP1 + (size_t)M * 2048 * 4 <= WS_XB2 && WS_XB2 + (size_t)M * 2048 * 2 <= WS_SS2 && WS_SS2 + (size_t)M * 128 <= WS_SS3 && WS_SS3 + (size_t)M * 128 <= WS_END && WS_ACT + (size_t)M * DFF * 2 <= WS_GNSA && WS_GB + (size_t)M * DFF * 2 <= WS_UB && WS_UB + (size_t)M * DFF * 2 <= WS_ACT, "ws map 4");
constexpr int CW_BAR = 4096, CW_QUEUE = 64;

constexpr int RING_BYTES = 131072, MISC_OFF = RING_BYTES + 320, XL_OFF = RING_BYTES + 1024, LDS_BYTES = 147456;

__device__ __forceinline__ unsigned pk2(float lo, float hi) { return pg8::cvt_pk_bf16(lo, hi); }
__device__ __forceinline__ float bf2f(unsigned short b) { return __uint_as_float(((unsigned)b) << 16); }
__device__ __forceinline__ float bflo(unsigned w) { return __uint_as_float(w << 16); }
__device__ __forceinline__ float bfhi(unsigned w) { return __uint_as_float(w & 0xffff0000u); }
__device__ __forceinline__ float sigmoidf_(float v) { return __builtin_amdgcn_rcpf(1.0f + __builtin_amdgcn_exp2f(-1.4426950409f * v)); }
__device__ __forceinline__ float gelu_tanh(float x) { const float u = x * (1.0f + 0.044715f * x * x); return x * __builtin_amdgcn_rcpf(1.0f + __builtin_amdgcn_exp2f(-2.302208198f * u)); }
__device__ __forceinline__ float wave_sum(float v) {
    v += __int_as_float(__builtin_amdgcn_update_dpp(0, __float_as_int(v), 0xB1, 0xf, 0xf, true));
    v += __int_as_float(__builtin_amdgcn_update_dpp(0, __float_as_int(v), 0x4E, 0xf, 0xf, true));
    v += __int_as_float(__builtin_amdgcn_update_dpp(0, __float_as_int(v), 0x141, 0xf, 0xf, true));
    v += __int_as_float(__builtin_amdgcn_update_dpp(0, __float_as_int(v), 0x140, 0xf, 0xf, true));
    v += __shfl_xor(v, 16); v += __shfl_xor(v, 32);
    return v;
}
__device__ __forceinline__ u32x4 pack8u(f32x4 a, f32x4 b) { u32x4 w = {pk2(a[0], a[1]), pk2(a[2], a[3]), pk2(b[0], b[1]), pk2(b[2], b[3])}; return w; }

#define XB_TMO      128
#define XB_XCNT(j)  (256  + 64 * (j))
#define XB_XSUB(j)  (1280 + 64 * (j))
#define XB_XGEN(j)  (2304 + 64 * (j))
#define XB_TOP      3328
#define XB_TOPGEN   3392
#define XCD_BAR_WORDS 3456
#define XB_SPIN_CAP (1u << 18)
__device__ __forceinline__ unsigned xb_ld(unsigned* p)              { return __hip_atomic_load(p, __ATOMIC_RELAXED, __HIP_MEMORY_SCOPE_AGENT); }
__device__ __forceinline__ unsigned xb_add(unsigned* p, unsigned v) { return __hip_atomic_fetch_add(p, v, __ATOMIC_RELAXED, __HIP_MEMORY_SCOPE_AGENT); }
__device__ __forceinline__ unsigned xb_xcc_id() { return (unsigned)__builtin_amdgcn_s_getreg((3 << 11) | 20) & 0xFu; }
#define XB_SPIN(cond, bar) do { unsigned _sp = 0; while (cond) { __builtin_amdgcn_s_sleep(1); \
    if ((++_sp & 255u) == 0u) { if (xb_ld(&(bar)[XB_TMO])) break; if (_sp > XB_SPIN_CAP) { atomicAdd(&(bar)[XB_TMO], 1u); break; } } } } while (0)
struct XcdBarrier { unsigned* bar; unsigned x; volatile LAS unsigned* st; };
__device__ __forceinline__ XcdBarrier xcd_barrier_post(unsigned* bar, volatile LAS unsigned* st) {
    XcdBarrier b; b.bar = bar; b.x = xb_xcc_id(); b.st = st;
    if (threadIdx.x == 0) (void)xb_add(&bar[XB_XCNT(b.x)], 1u);
    return b;
}
__device__ __forceinline__ void xcd_barrier_complete(unsigned* bar, unsigned x, unsigned& nloc, unsigned& nx) {
    const unsigned G = gridDim.x * gridDim.y * gridDim.z;
    unsigned sum, cnt, mine, sp = 0u;
    for (;;) {
        sum = 0u; cnt = 0u; mine = 0u;
#pragma unroll
        for (unsigned j = 0; j < 16; ++j) { const unsigned c = xb_ld(&bar[XB_XCNT(j)]); sum += c; cnt += (c > 0u) ? 1u : 0u; mine = (j == x) ? c : mine; }
        if (sum == G) break;
        __builtin_amdgcn_s_sleep(1);
        if ((++sp & 255u) == 0u) { if (xb_ld(&bar[XB_TMO])) break; if (sp > XB_SPIN_CAP) { atomicAdd(&bar[XB_TMO], 1u); break; } }
    }
    nloc = mine > 0u ? mine : 1u; nx = cnt > 0u ? cnt : 1u;
}
__device__ __forceinline__ void xcd_barrier(const XcdBarrier& b) {
    asm volatile("s_waitcnt vmcnt(0)" ::: "memory");
    __syncthreads();
    if (threadIdx.x == 0) {
        unsigned* bar = b.bar;
        __builtin_amdgcn_s_waitcnt(0);
        unsigned nloc = b.st[0], nx = b.st[1];
        if (nloc == 0u) { xcd_barrier_complete(bar, b.x, nloc, nx); b.st[0] = nloc; b.st[1] = nx; }
        const unsigned old = xb_add(&bar[XB_XSUB(b.x)], 1u);
        const unsigned gen = old / nloc;
        if (old + 1u == (gen + 1u) * nloc) {
            __builtin_amdgcn_fence(__ATOMIC_RELEASE, "agent");
            asm volatile("s_waitcnt vmcnt(0)" ::: "memory");
            const unsigned og = xb_add(&bar[XB_TOP], 1u);
            const unsigned tg = og / nx;
            if (og + 1u == (tg + 1u) * nx) xb_add(&bar[XB_TOPGEN], 1u);
            else XB_SPIN(xb_ld(&bar[XB_TOPGEN]) == tg, bar);
            __builtin_amdgcn_fence(__ATOMIC_ACQUIRE, "agent");
            xb_add(&bar[XB_XGEN(b.x)], 1u);
            asm volatile("s_waitcnt vmcnt(0)" ::: "memory");
        } else {
            XB_SPIN(xb_ld(&bar[XB_XGEN(b.x)]) == gen, bar);
            __builtin_amdgcn_fence(__ATOMIC_ACQUIRE, "agent");
            asm volatile("s_waitcnt vmcnt(0)" ::: "memory");
        }
    }
    __syncthreads();
}

struct Args { const void* in[30]; float* out; unsigned char* ws; int ph_lo, ph_hi, qlo, qhi; };
struct Frame {
    int tid, lane, wave, G, bid;
    const float *x_p, *x_s, *c_cmp, *c_slc, *c_win, *st_h, *st_conv, *st_ffn; const int* pt;
    const float *norm_mix, *w_in, *rconv_w, *rconv_b, *rwa, *rba, *rwx, *rbx, *rlam, *cmp_w, *cmp_pos, *w_pr, *w_pa, *w_out, *norm_ffn, *w_gate, *w_up, *fconv_w, *fconv_b, *w_down, *norm_final;
    float* out; unsigned char* ws;
};
#define WSP(T, off) ((T*)(F.ws + (off)))

struct TrDesc { const float* src; const float* ks; bf16_t* dst; int ldw, ldk; };
__device__ __forceinline__ TrDesc tr_mk(const float* W, int ldw, int k0, int c0, const float* kscale, bf16_t* WT, int ldk, int dst_row0, int dst_k0) {
    TrDesc d; d.src = W + (size_t)k0 * ldw + c0; d.ks = kscale ? kscale + k0 : nullptr; d.dst = WT + (size_t)dst_row0 * ldk + dst_k0; d.ldw = ldw; d.ldk = ldk; return d; }
constexpr int TR_IN = 32 * (N1 / 32), TR_PR = 16 * 64, TR_O = 32 * 64, TR_G = 32 * 192, TR_D = 96 * 64, TR_C = 2 * 64 * 4;
constexpr int TR_A1 = TR_IN, TR_A2 = TR_A1 + 2 * TR_PR + TR_O, TR_A3 = TR_A2 + 2 * TR_G, TR_A4 = TR_A3 + TR_D, TR_A5 = TR_A4 + TR_C;
constexpr int TR_GDEF = 2048;
__device__ __forceinline__ TrDesc tr_desc(const Frame& F, int r) {
    if (r < TR_IN) { const int nblk = N1 / 32, kb = r / nblk, nb = r % nblk, n0 = nb * 32; const int src = n0 < 4608 ? n0 : n0 + 24;
        return tr_mk(F.w_in, 8728, kb * 64, src, F.norm_mix, WSP(bf16_t, WS_W1T), 2048, n0, kb * 64); } r -= TR_IN;
    if (r < TR_PR) { const int kb = r / 64, nb = r % 64; return tr_mk(F.w_pr, 2048, kb * 64, nb * 32, nullptr, WSP(bf16_t, WS_WPR), 1024, nb * 32, kb * 64); } r -= TR_PR;
    if (r < TR_PR) { const int kb = r / 64, nb = r % 64; return tr_mk(F.w_pa, 2048, kb * 64, nb * 32, nullptr, WSP(bf16_t, WS_WPA), 1024, nb * 32, kb * 64); } r -= TR_PR;
    if (r < TR_O) { const int kb = r / 64, nb = r % 64; return tr_mk(F.w_out, 2048, kb * 64, nb * 32, nullptr, WSP(bf16_t, WS_WO), 2048, nb * 32, kb * 64); } r -= TR_O;
    if (r < TR_G) { const int kb = r / 192, nb = r % 192; return tr_mk(F.w_gate, DFF, kb * 64, nb * 32, F.norm_ffn, WSP(bf16_t, WS_WG), 2048, (nb >> 2) * 256 + (nb & 3) * 32, kb * 64); } r -= TR_G;
    if (r < TR_G) { const int kb = r / 192, nb = r % 192; return tr_mk(F.w_up, DFF, kb * 64, nb * 32, F.norm_ffn, WSP(bf16_t, WS_WG), 2048, (nb >> 2) * 256 + 128 + (nb & 3) * 32, kb * 64); } r -= TR_G;
    if (r < TR_D) { const int kb = r / 64, nb = r % 64; return tr_mk(F.w_down, 2048, kb * 64, nb * 32, nullptr, WSP(bf16_t, WS_WD), DFF, nb * 32, kb * 64); } r -= TR_D;
    { const int c = r / 256, rr = r % 256, kb = rr / 4, nb = rr % 4, k0 = kb * 64, lw = k0 >> 7;
      return tr_mk(F.cmp_w + (size_t)c * 4096 * 128, 128, k0, nb * 32, nullptr, WSP(bf16_t, WS_WC), 2048, c * 256 + (lw >> 4) * 128 + nb * 32, (lw & 15) * 128 + (k0 & 127)); }
}
__device__ __forceinline__ void tr_load(const TrDesc& d, float (&tv)[32], f32x4 (&ks)[2], int lane) {
    const float* p = d.src + (size_t)(lane >> 5) * d.ldw + (lane & 31);
#pragma unroll
    for (int i = 0; i < 32; ++i) tv[i] = p[(size_t)(2 * i) * d.ldw];
    if (d.ks) { ks[0] = *(const f32x4*)(d.ks + 8 * (lane & 7)); ks[1] = *(const f32x4*)(d.ks + 8 * (lane & 7) + 4); } else { ks[0] = (f32x4){1.f, 1.f, 1.f, 1.f}; ks[1] = ks[0]; }
}
__device__ __forceinline__ void tr_store(const TrDesc& d, const float (&tv)[32], const f32x4 (&ks)[2], LAS float* scr, int lane) {
#pragma unroll
    for (int i = 0; i < 32; ++i) scr[(2 * i + (lane >> 5)) * 33 + (lane & 31)] = tv[i];
    asm volatile("s_waitcnt lgkmcnt(0)" ::: "memory");
    const int c = lane & 7;
#pragma unroll
    for (int j4 = 0; j4 < 4; ++j4) { const int n = (lane >> 3) + 8 * j4; const LAS float* s = scr + (8 * c) * 33 + n;
        u32x4 o; o.x = pk2(s[0 * 33] * ks[0].x, s[1 * 33] * ks[0].y); o.y = pk2(s[2 * 33] * ks[0].z, s[3 * 33] * ks[0].w); o.z = pk2(s[4 * 33] * ks[1].x, s[5 * 33] * ks[1].y); o.w = pk2(s[6 * 33] * ks[1].z, s[7 * 33] * ks[1].w);
        *(u32x4*)(d.dst + (size_t)n * d.ldk + 8 * c) = o; }
    asm volatile("s_waitcnt lgkmcnt(0)" ::: "memory");
}
__device__ __forceinline__ int tr_map(int v, int mode) { return mode == 0 ? v : v < TR_IN ? v : v < TR_IN + (2 * TR_G - TR_GDEF) ? v - TR_IN + TR_A2 + TR_GDEF : v - (TR_IN + 2 * TR_G - TR_GDEF) + TR_A4; }
__device__ __forceinline__ void tr_run(const Frame& F, LAS float* scr, int lane, int first, int step, int end, int mode) {
    int v = first; if (v >= end) return;
    TrDesc d = tr_desc(F, tr_map(v, mode)); float tv[32]; f32x4 ks[2]; tr_load(d, tv, ks, lane);
#pragma unroll 1
    for (;;) { const int vn = v + step; const bool more = vn < end;
        const TrDesc dn = tr_desc(F, tr_map(more ? vn : v, mode)); float tn[32]; f32x4 kn[2]; tr_load(dn, tn, kn, lane);
        tr_store(d, tv, ks, scr, lane);
        if (!more) break;
        d = dn; v = vn; ks[0] = kn[0]; ks[1] = kn[1];
#pragma unroll
        for (int i = 0; i < 32; ++i) tv[i] = tn[i]; }
}
__device__ __forceinline__ void tr_deferred(const Frame& F, unsigned char* ldsg, int lo, int hi, int wg_lo, int wg_hi) {
    if (wg_lo >= wg_hi) { wg_lo = 0; wg_hi = F.G; }
    if (F.bid < wg_lo || F.bid >= wg_hi) return;
    LAS float* scr = (LAS float*)((LAS unsigned char*)ldsg + F.wave * 16384);
    tr_run(F, scr, F.lane, lo + (F.bid - wg_lo) * 8 + F.wave, (wg_hi - wg_lo) * 8, hi, 0);
}
constexpr int CC_EARLY = 24;
__device__ __forceinline__ void cc_item(const Frame& F, int it, int lane) { bf16_t* CC = WSP(bf16_t, WS_CC);
    const int db = it >> 7, n = it & 127; const int phys = F.pt[db * 16 + (n >> 3)];
    const float* src = F.c_cmp + ((size_t)phys * 128 + (n & 7) * 16) * 512 + lane * 4; const int g = lane >> 5, d = (lane & 31) * 4;
#pragma unroll 1
    for (int l0 = 0; l0 < 16; l0 += 8) { f32x4 t[16];
#pragma unroll
        for (int u = 0; u < 16; ++u) t[u] = *(const f32x4*)(src + (l0 + (u >> 1)) * 512 + (u & 1) * 256);
#pragma unroll
        for (int u = 0; u < 16; ++u) { u32x2 w; w.x = pk2(t[u].x, t[u].y); w.y = pk2(t[u].z, t[u].w);
            *(u32x2*)(CC + ((size_t)((db * 2 + (u & 1)) * 256 + g * 128 + n)) * 2048 + (l0 + (u >> 1)) * 128 + d) = w; } }
}
__device__ __forceinline__ void p0_prologue(const Frame& F, unsigned char* ldsg, const int skipmask) {
    LAS float* scr = (LAS float*)((LAS unsigned char*)ldsg + F.wave * 16384);
    const int gw = F.bid * 8 + F.wave, NGW = F.G * 8, lane = F.lane;
    if (!(skipmask & 1)) { LAS bf16_t* WL = (LAS bf16_t*)ldsg; constexpr int WLS = 2056;
      { f32x4 wv[4][6];
#pragma unroll
        for (int r = 0; r < 4; ++r)
#pragma unroll
            for (int q = 0; q < 6; ++q) wv[r][q] = *(const f32x4*)(F.w_in + (size_t)(F.tid + 512 * r) * 8728 + 4608 + 4 * q);
#pragma unroll
        for (int r = 0; r < 4; ++r) { const int k = F.tid + 512 * r; const float nm = F.norm_mix[k];
#pragma unroll
            for (int q = 0; q < 6; ++q)
#pragma unroll
                for (int e = 0; e < 4; ++e) WL[(4 * q + e) * WLS + k] = (bf16_t)(pk2(wv[r][q][e] * nm, 0.f) & 0xffffu);
#pragma unroll
            for (int c = 24; c < 32; ++c) WL[c * WLS + k] = (bf16_t)0; } }
      __syncthreads();
      bf16_t* XB = WSP(bf16_t, WS_XB); float* RS = WSP(float, WS_RSTD1); float* GN = WSP(float, WS_GNSA);
      const int fr = lane & 15, fq = lane >> 4;
      if (F.wave >= 5 && !(skipmask & 4)) { const int ipw = (DBATCH * 128 + F.G - 1) / F.G, lo = F.bid * ipw, hi0 = (lo + ipw) < DBATCH * 128 ? (lo + ipw) : DBATCH * 128, hi = (lo + CC_EARLY) < hi0 ? (lo + CC_EARLY) : hi0;
          for (int it = lo + (F.wave - 5); it < hi; it += 3) cc_item(F, it, lane); }
      for (int grp = F.wave * F.G + F.bid; grp < M / 16; grp += NGW) { const int m0 = grp * 16, m = m0 + fr;
          const float* xrow = ((m < MP) ? F.x_p + (size_t)m * DM : F.x_s + (size_t)(m - MP) * DM) + 8 * fq;
          bf16_t* xb = XB + (size_t)m * DM + 8 * fq; const LAS bf16_t* w0 = WL + fr * WLS + 8 * fq; const LAS bf16_t* w1 = w0 + 16 * WLS;
          f32x4 a0 = {0.f, 0.f, 0.f, 0.f}, a1 = {0.f, 0.f, 0.f, 0.f}; float ss = 0.f;
          f32x4 cur[16], nxt[16];
#pragma unroll
          for (int j = 0; j < 8; ++j) { cur[2 * j] = *(const f32x4*)(xrow + 32 * j); cur[2 * j + 1] = *(const f32x4*)(xrow + 32 * j + 4); }
#pragma unroll 1
          for (int b = 0; b < 8; ++b) { const int bn = b < 7 ? b + 1 : 7;
#pragma unroll
              for (int j = 0; j < 8; ++j) { nxt[2 * j] = *(const f32x4*)(xrow + 256 * bn + 32 * j); nxt[2 * j + 1] = *(const f32x4*)(xrow + 256 * bn + 32 * j + 4); }
#pragma unroll
              for (int j = 0; j < 8; ++j) { const f32x4 p = cur[2 * j], q = cur[2 * j + 1];
                  ss += (p.x * p.x + p.y * p.y) + (p.z * p.z + p.w * p.w) + (q.x * q.x + q.y * q.y) + (q.z * q.z + q.w * q.w);
                  const u32x4 pk = pack8u(p, q); *(u32x4*)(xb + 256 * b + 32 * j) = pk; const bf16x8 af = __builtin_bit_cast(bf16x8, pk);
                  const bf16x8 b0 = *(const LAS bf16x8*)(w0 + 256 * b + 32 * j), b1 = *(const LAS bf16x8*)(w1 + 256 * b + 32 * j);
                  a0 = __builtin_amdgcn_mfma_f32_16x16x32_bf16(af, b0, a0, 0, 0, 0); a1 = __builtin_amdgcn_mfma_f32_16x16x32_bf16(af, b1, a1, 0, 0, 0); }
#pragma unroll
              for (int j = 0; j < 16; ++j) cur[j] = nxt[j]; }
          ss += __shfl_xor(ss, 16); ss += __shfl_xor(ss, 32);
          const float rstd = 1.0f / sqrtf(ss * (1.0f / DM) + EPS);
          if (fq == 0) RS[m] = rstd;
#pragma unroll
          for (int i = 0; i < 4; ++i) { const float rsr = __shfl(rstd, 4 * fq + i);
              GN[(size_t)(m0 + 4 * fq + i) * 32 + fr] = sigmoidf_(a0[i] * rsr); GN[(size_t)(m0 + 4 * fq + i) * 32 + 16 + fr] = sigmoidf_(fr < 8 ? a1[i] * rsr : 0.f); } }
      __syncthreads(); }
    if (!(skipmask & 2)) { constexpr int NV = TR_IN + (2 * TR_G - TR_GDEF) + TR_C; tr_run(F, scr, lane, gw, NGW, NV, 1); }
    if (!(skipmask & 4)) { const int ipw = (DBATCH * 128 + F.G - 1) / F.G, lo = F.bid * ipw, hi = (lo + ipw) < DBATCH * 128 ? (lo + ipw) : DBATCH * 128;
      for (int it = lo + CC_EARLY + F.wave; it < hi; it += 8) cc_item(F, it, lane); }
    if (F.tid < 256) { const int c = F.tid >> 7, e2 = F.tid & 127, kb = F.bid * (4096 / F.G), ke = kb + 4096 / F.G; float s = 0.f;
        const float* pw = F.cmp_w + (size_t)c * 4096 * 128 + e2; const float* pp = F.cmp_pos + c * 4096;
#pragma unroll 8
        for (int k = kb; k < ke; ++k) s += pp[k] * pw[(size_t)k * 128];
        WSP(float, WS_POSP)[F.bid * 256 + F.tid] = s; }
}

#define EPI_ROWS(r_) _Pragma("unroll") for (int ai = 0; ai < 2; ++ai) _Pragma("unroll") for (int m = 0; m < 4; ++m) { const int r_ = row0 + ai * 128 + m * 16;
#define EPI_COLS(c_) _Pragma("unroll") for (int bj = 0; bj < 2; ++bj) { const int c_ = col0 + bj * 128; f32x4 v0 = acc[ai][bj][m][0], v1 = acc[ai][bj][m][1];
#define EPI_END } }
#define EPI_PIN(x) asm volatile("" : "+v"(x))
__device__ __forceinline__ void st_bf8(bf16_t* p, f32x4 a, f32x4 b) { *(u32x4*)p = pack8u(a, b); }
__device__ __forceinline__ void st_f8(float* p, f32x4 a, f32x4 b) { *(f32x4*)p = a; *(f32x4*)(p + 4) = b; }

struct EpiIn {
    static constexpr bool PERM = true, AFTER_DRAIN = false, MIDK = false, PRE = true;
    const float* rstd; bf16_t *XR, *GG, *Q, *KVS, *KVW, *CC, *SGM; float* GNSA; float* out; int skip; LAS float* RSL;
    __device__ __forceinline__ void pre(const Unit& u, int wid, int lane) const {
        if (wid < 4) __builtin_amdgcn_global_load_lds((const unsigned*)(rstd + u.pm * 256 + wid * 64 + lane), (LAS unsigned*)(RSL + wid * 64), 4, 0, 0); }
    __device__ __forceinline__ void operator()(const f32x4 (&acc)[2][2][4][2], const Unit& u, int wr, int wc, int fr, int fq) const {
        if (skip) { if (acc[0][0][0][0].x == 123456.789f) out[0] = 1.f; return; }
        const int row0 = u.pm * 256 + wr * 64 + fr, col0 = u.pn * 256 + wc * 32 + 8 * fq, pn = u.pn; const bool samp = u.pm >= 64;
        float rsv[2][4];
#pragma unroll
        for (int ai = 0; ai < 2; ++ai)
#pragma unroll
            for (int m = 0; m < 4; ++m) rsv[ai][m] = RSL[wr * 64 + fr + ai * 128 + m * 16];
#pragma unroll
        for (int ai = 0; ai < 2; ++ai)
#pragma unroll
            for (int m = 0; m < 4; ++m) EPI_PIN(rsv[ai][m]);
        EPI_ROWS(r) const float rs = rsv[ai][m];
            EPI_COLS(c) v0 *= rs; v1 *= rs;
                if (pn < 4) { st_bf8(XR + (size_t)r * 1024 + c, v0, v1);
                    if (!samp) { const int t = r & 2047; if (t >= 2045) st_f8(out + O_PRC + (size_t)((r >> 11) * 3 + (t - 2045)) * 1024 + c, v0, v1); }
                    else { const int tq = r & 3; if (tq >= 1) st_f8(out + O_SRC + (size_t)(((r - MP) >> 2) * 3 + tq - 1) * 1024 + c, v0, v1); } }
                else if (pn < 8) { f32x4 a, b;
#pragma unroll
                    for (int j = 0; j < 4; ++j) { a[j] = gelu_tanh(v0[j]); b[j] = gelu_tanh(v1[j]); }
                    st_bf8(GG + (size_t)r * 1024 + (c - 1024), a, b); }
                else if (pn < 12) { st_bf8(Q + (size_t)r * 1024 + (c - 2048), v0, v1); }
                else if (pn < 14) { const int cc = c - 3072;
                    if (!samp) { st_f8(out + O_PKC + (size_t)r * 512 + cc, v0, v1); const int t = r & 2047, b = r >> 11;
                        st_bf8(CC + ((size_t)((256 + b * 2 + (cc >> 8)) * 256 + ((cc >> 7) & 1) * 128 + (t >> 4))) * 2048 + (t & 15) * 128 + (cc & 127), v0, v1); }
                    else st_f8(out + O_SKC + (size_t)(r - MP) * 512 + cc, v0, v1); }
                else if (pn < 16) { const int cc = c - 3584; st_bf8(KVS + (size_t)r * 512 + cc, v0, v1);
                    if (!samp) st_f8(out + O_PKS + (size_t)r * 512 + cc, v0, v1); else st_f8(out + O_SKS + (size_t)(r - MP) * 512 + cc, v0, v1); }
                else if (pn < 18) { const int cc = c - 4096; st_bf8(KVW + (size_t)r * 512 + cc, v0, v1);
                    if (!samp) { const int t = r & 2047; if (t >= 1536) st_f8(out + O_PKW + (size_t)((r >> 11) * 512 + t - 1536) * 512 + cc, v0, v1); }
                    else { const int q = r - MP; st_f8(out + O_SKW + (size_t)((q >> 2) * 512 + 508 + (q & 3)) * 512 + cc, v0, v1); } }
                else { f32x4 a, b;
#pragma unroll
                    for (int j = 0; j < 4; ++j) { a[j] = sigmoidf_(v0[j]); b[j] = sigmoidf_(v1[j]); }
                    st_bf8(SGM + (size_t)r * 4096 + (c - 4608), a, b); }
            EPI_END
    }
};
struct EpiFS {
    static constexpr bool PERM = false, AFTER_DRAIN = false, MIDK = false, PRE = false;
    float* FS;
    __device__ __forceinline__ void operator()(const f32x4 (&acc)[2][2][4][2], const Unit& u, int wr, int wc, int fr, int fq) const {
        float* base = FS + (size_t)u.pm * 65536 + (size_t)(wr * 64 + fr) * 256 + wc * 32 + 4 * fq;
#pragma unroll
        for (int ai = 0; ai < 2; ++ai)
#pragma unroll
            for (int m = 0; m < 4; ++m)
#pragma unroll
                for (int bj = 0; bj < 2; ++bj)
#pragma unroll
                    for (int n = 0; n < 2; ++n) *(f32x4*)(base + (size_t)(ai * 128 + m * 16) * 256 + bj * 128 + n * 16) = acc[ai][bj][m][n];
    }
};
template <int PASS> struct EpiProj {
    static constexpr bool PERM = true, AFTER_DRAIN = false, MIDK = false, PRE = false;
    const bf16_t* SGM; bf16_t* T1; bf16_t* MB;
    __device__ __forceinline__ void operator()(const f32x4 (&acc)[2][2][4][2], const Unit& u, int wr, int wc, int fr, int fq) const {
        const int row0 = u.pm * 256 + wr * 64 + fr, col0 = u.pn * 256 + wc * 32 + 8 * fq;
#pragma unroll
        for (int ai = 0; ai < 2; ++ai) { u32x4 gw[4][2], tw[4][2];
#pragma unroll
            for (int m = 0; m < 4; ++m)
#pragma unroll
                for (int bj = 0; bj < 2; ++bj) { const size_t r = (size_t)(row0 + ai * 128 + m * 16); const int c = col0 + bj * 128; gw[m][bj] = *(const u32x4*)(SGM + r * 4096 + PASS * 2048 + c);
                    if (PASS == 1) tw[m][bj] = *(const u32x4*)(T1 + r * 2048 + c); }
#pragma unroll
            for (int m = 0; m < 4; ++m)
#pragma unroll
                for (int bj = 0; bj < 2; ++bj) { EPI_PIN(gw[m][bj]); if (PASS == 1) EPI_PIN(tw[m][bj]); }
#pragma unroll
            for (int m = 0; m < 4; ++m)
#pragma unroll
                for (int bj = 0; bj < 2; ++bj) { const size_t r = (size_t)(row0 + ai * 128 + m * 16); const int c = col0 + bj * 128; const u32x4 g_ = gw[m][bj];
                    const f32x4 g0 = {bflo(g_.x), bfhi(g_.x), bflo(g_.y), bfhi(g_.y)}, g1 = {bflo(g_.z), bfhi(g_.z), bflo(g_.w), bfhi(g_.w)};
                    f32x4 v0 = acc[ai][bj][m][0] * g0, v1 = acc[ai][bj][m][1] * g1;
                    if (PASS == 0) st_bf8(T1 + r * 2048 + c, v0, v1);
                    else { const u32x4 t_ = tw[m][bj]; v0 += (f32x4){bflo(t_.x), bfhi(t_.x), bflo(t_.y), bfhi(t_.y)}; v1 += (f32x4){bflo(t_.z), bfhi(t_.z), bflo(t_.w), bfhi(t_.w)};
                        st_bf8(MB + r * 2048 + c, v0, v1); } } }
    }
};
struct EpiProjM {
    static constexpr bool PERM = true, AFTER_DRAIN = false, MIDK = true, PRE = false;
    const bf16_t* SGM; bf16_t* MB;
    __device__ __forceinline__ void mid(f32x4 (&acc)[2][2][4][2], const Unit& u, int wr, int wc, int fr, int fq) const {
        asm volatile("" : "+v"(fr), "+v"(fq));
        const int row0 = u.pm * 256 + wr * 64 + fr, col0 = u.pn * 256 + wc * 32 + 8 * fq;
#pragma unroll
        for (int ai = 0; ai < 2; ++ai) { u32x4 gr[4][2], ga[4][2];
#pragma unroll
            for (int m = 0; m < 4; ++m)
#pragma unroll
                for (int bj = 0; bj < 2; ++bj) { const bf16_t* p = SGM + (size_t)(row0 + ai * 128 + m * 16) * 4096 + col0 + bj * 128; gr[m][bj] = *(const u32x4*)p; ga[m][bj] = *(const u32x4*)(p + 2048); }
#pragma unroll
            for (int m = 0; m < 4; ++m)
#pragma unroll
                for (int bj = 0; bj < 2; ++bj) { EPI_PIN(gr[m][bj]); EPI_PIN(ga[m][bj]); }
#pragma unroll
            for (int m = 0; m < 4; ++m)
#pragma unroll
                for (int bj = 0; bj < 2; ++bj) { const u32x4 r_ = gr[m][bj], a_ = ga[m][bj];
                    const f32x4 r0 = {bflo(r_.x), bfhi(r_.x), bflo(r_.y), bfhi(r_.y)}, r1 = {bflo(r_.z), bfhi(r_.z), bflo(r_.w), bfhi(r_.w)};
                    f32x4 a0 = {bflo(a_.x), bfhi(a_.x), bflo(a_.y), bfhi(a_.y)}, a1 = {bflo(a_.z), bfhi(a_.z), bflo(a_.w), bfhi(a_.w)};
#pragma unroll
                    for (int j = 0; j < 4; ++j) { a0[j] = __builtin_amdgcn_rcpf(fmaxf(a0[j], 1e-20f)); a1[j] = __builtin_amdgcn_rcpf(fmaxf(a1[j], 1e-20f)); }
                    acc[ai][bj][m][0] *= r0 * a0; acc[ai][bj][m][1] *= r1 * a1; } }
    }
    __device__ __forceinline__ void operator()(const f32x4 (&acc)[2][2][4][2], const Unit& u, int wr, int wc, int fr, int fq) const {
        const int row0 = u.pm * 256 + wr * 64 + fr, col0 = u.pn * 256 + wc * 32 + 8 * fq;
#pragma unroll
        for (int ai = 0; ai < 2; ++ai) { u32x4 ga[4][2];
#pragma unroll
            for (int m = 0; m < 4; ++m)
#pragma unroll
                for (int bj = 0; bj < 2; ++bj) ga[m][bj] = *(const u32x4*)(SGM + (size_t)(row0 + ai * 128 + m * 16) * 4096 + 2048 + col0 + bj * 128);
#pragma unroll
            for (int m = 0; m < 4; ++m)
#pragma unroll
                for (int bj = 0; bj < 2; ++bj) EPI_PIN(ga[m][bj]);
#pragma unroll
            for (int m = 0; m < 4; ++m)
#pragma unroll
                for (int bj = 0; bj < 2; ++bj) { const u32x4 a_ = ga[m][bj]; f32x4 a0 = {bflo(a_.x), bfhi(a_.x), bflo(a_.y), bfhi(a_.y)}, a1 = {bflo(a_.z), bfhi(a_.z), bflo(a_.w), bfhi(a_.w)};
#pragma unroll
                    for (int j = 0; j < 4; ++j) { a0[j] = fmaxf(a0[j], 1e-20f); a1[j] = fmaxf(a1[j], 1e-20f); }
                    st_bf8(MB + (size_t)(row0 + ai * 128 + m * 16) * 2048 + col0 + bj * 128, acc[ai][bj][m][0] * a0, acc[ai][bj][m][1] * a1); } }
    }
};
struct EpiOut {
    static constexpr bool PERM = true, AFTER_DRAIN = false, MIDK = false, PRE = false;
    const bf16_t* XB; bf16_t* XB2; float* SS;
    __device__ __forceinline__ void operator()(const f32x4 (&acc)[2][2][4][2], const Unit& u, int wr, int wc, int fr, int fq) const {
        const int row0 = u.pm * 256 + wr * 64 + fr, col0 = u.pn * 256 + wc * 32 + 8 * fq;
#pragma unroll
        for (int ai = 0; ai < 2; ++ai) { u32x4 xw[4][2];
#pragma unroll
            for (int m = 0; m < 4; ++m)
#pragma unroll
                for (int bj = 0; bj < 2; ++bj) xw[m][bj] = *(const u32x4*)(XB + (size_t)(row0 + ai * 128 + m * 16) * DM + col0 + bj * 128);
#pragma unroll
            for (int m = 0; m < 4; ++m)
#pragma unroll
                for (int bj = 0; bj < 2; ++bj) EPI_PIN(xw[m][bj]);
#pragma unroll
            for (int m = 0; m < 4; ++m) { const int r = row0 + ai * 128 + m * 16; float ss = 0.f;
#pragma unroll
                for (int bj = 0; bj < 2; ++bj) { const int c = col0 + bj * 128; const u32x4 w = xw[m][bj];
                    const f32x4 v0 = acc[ai][bj][m][0] + (f32x4){bflo(w.x), bfhi(w.x), bflo(w.y), bfhi(w.y)}, v1 = acc[ai][bj][m][1] + (f32x4){bflo(w.z), bfhi(w.z), bflo(w.w), bfhi(w.w)};
                    st_bf8(XB2 + (size_t)r * DM + c, v0, v1);
                    ss += (v0.x * v0.x + v0.y * v0.y) + (v0.z * v0.z + v0.w * v0.w) + (v1.x * v1.x + v1.y * v1.y) + (v1.z * v1.z + v1.w * v1.w); }
                ss += __shfl_xor(ss, 16); ss += __shfl_xor(ss, 32);
                if (fq == 0) SS[(size_t)r * 32 + u.pn * 4 + wc] = ss; } }
    }
};
__device__ __forceinline__ float dppf(float x, int ctrl_sel) {
    const int v = __float_as_int(x);
    const int r = ctrl_sel == 0 ? __builtin_amdgcn_update_dpp(0, v, 0x111, 0xf, 0xf, true) : ctrl_sel == 1 ? __builtin_amdgcn_update_dpp(0, v, 0x112, 0xf, 0xf, true)
                : ctrl_sel == 2 ? __builtin_amdgcn_update_dpp(0, v, 0x121, 0xf, 0xf, true) : __builtin_amdgcn_update_dpp(0, v, 0x122, 0xf, 0xf, true);
    return __int_as_float(r);
}
struct EpiFFN {
    static constexpr bool PERM = true, AFTER_DRAIN = false, MIDK = false, PRE = false;
    const float* SS; const float* cw; const float* cbias; const float* st_ffn; bf16_t* ACT; float* out; float* GE; float* G0; float* U0; LAS float* XL; int skip;
    __device__ __forceinline__ void operator()(const f32x4 (&acc)[2][2][4][2], const Unit& u, int wr, int wc, int fr, int fq) const {
        if (skip) { if (acc[0][0][0][0].x == 123456.789f) out[0] = 1.f; return; }
        const int row0 = u.pm * 256 + wr * 64 + fr, f0 = u.pn * 128 + wc * 32 + 8 * fq; const bool samp = u.pm >= 64;
        float w0[8], w1[8], w2[8], bb[8];
#pragma unroll
        for (int e = 0; e < 8; e += 4) { const f32x4 a = *(const f32x4*)(cw + f0 + e), b4 = *(const f32x4*)(cw + DFF + f0 + e), c4 = *(const f32x4*)(cw + 2 * DFF + f0 + e), d4 = *(const f32x4*)(cbias + f0 + e);
#pragma unroll
            for (int j = 0; j < 4; ++j) { w0[e + j] = a[j]; w1[e + j] = b4[j]; w2[e + j] = c4[j]; bb[e + j] = d4[j]; } }
        LAS float* RSL = XL + 1024;
        { const int tl = (((wr << 2) | wc) << 6) | (fq << 4) | fr, rr = tl >> 1, hh = tl & 1; const float* sp = SS + (size_t)(u.pm * 256 + rr) * 32 + hh * 16;
          const f32x4 a = *(const f32x4*)sp, b4 = *(const f32x4*)(sp + 4), c4 = *(const f32x4*)(sp + 8), d4 = *(const f32x4*)(sp + 12);
          float t = (((a.x + a.y) + (a.z + a.w)) + ((b4.x + b4.y) + (b4.z + b4.w))) + (((c4.x + c4.y) + (c4.z + c4.w)) + ((d4.x + d4.y) + (d4.z + d4.w)));
          t += __int_as_float(__builtin_amdgcn_update_dpp(0, __float_as_int(t), 0xB1, 0xf, 0xf, true));
          if (hh == 0) RSL[rr] = 1.0f / sqrtf(t * (1.0f / DM) + EPS); }
        LAS float* xw = XL + ((wr * 4 + wc) * 2) * 32 + 8 * fq;
#pragma unroll
        for (int ai = 0; ai < 2; ++ai) if (fr >= 14) { LAS float* p = xw + ai * (2 * 4 * 2 * 32) + (fr - 14) * 32; *(LAS f32x4*)p = acc[ai][0][3][0]; *(LAS f32x4*)(p + 4) = acc[ai][0][3][1]; }
        asm volatile("s_waitcnt lgkmcnt(0)\n\ts_barrier" ::: "memory");
        float rs[2][4];
#pragma unroll
        for (int ai = 0; ai < 2; ++ai)
#pragma unroll
            for (int m = 0; m < 4; ++m) rs[ai][m] = RSL[ai * 128 + wr * 64 + m * 16 + fr];
#pragma unroll
        for (int ai = 0; ai < 2; ++ai) {
            float x0[8], x1[8]; const int pb = ai * 2 + wr;
            if (pb > 0) { const LAS float* p = XL + (((pb - 1) * 4 + wc) * 2) * 32 + 8 * fq; const f32x4 a = *(const LAS f32x4*)p, b4 = *(const LAS f32x4*)(p + 4), c4 = *(const LAS f32x4*)(p + 32), d4 = *(const LAS f32x4*)(p + 36);
                const float sa = RSL[(pb - 1) * 64 + 62], sb = RSL[(pb - 1) * 64 + 63];
#pragma unroll
                for (int j = 0; j < 4; ++j) { x0[j] = a[j] * sa; x0[4 + j] = b4[j] * sa; x1[j] = c4[j] * sb; x1[4 + j] = d4[j] * sb; } }
            else {
#pragma unroll
                for (int j = 0; j < 8; ++j) { x0[j] = 0.f; x1[j] = 0.f; } }
            float gp[8];
#pragma unroll
            for (int j = 0; j < 8; ++j) gp[j] = 0.f;
#pragma unroll
            for (int m = 0; m < 4; ++m) { const int r = row0 + ai * 128 + m * 16; const float s = rs[ai][m];
                float g[8], uu[8], q1[8], q2[8];
#pragma unroll
                for (int j = 0; j < 4; ++j) { g[j] = acc[ai][0][m][0][j] * s; g[4 + j] = acc[ai][0][m][1][j] * s; uu[j] = acc[ai][1][m][0][j] * s; uu[4 + j] = acc[ai][1][m][1][j] * s; }
#pragma unroll
                for (int j = 0; j < 8; ++j) {
                    if (m == 0) { const float s1 = dppf(g[j], 0), s2 = dppf(g[j], 1); q1[j] = (fr == 0) ? x1[j] : s1; q2[j] = (fr == 0) ? x0[j] : (fr == 1) ? x1[j] : s2; }
                    else { const float r1 = dppf(gp[j], 2), r2 = dppf(gp[j], 3);
                        q1[j] = __int_as_float(__builtin_amdgcn_update_dpp(__float_as_int(r1), __float_as_int(g[j]), 0x111, 0xf, 0xf, false));
                        q2[j] = __int_as_float(__builtin_amdgcn_update_dpp(__float_as_int(r2), __float_as_int(g[j]), 0x112, 0xf, 0xf, false)); } }
                if (samp) { const int qq = r - MP, tq = qq & 3;
                    if (tq < 2) { const float* sp = st_ffn + (size_t)(qq >> 2) * 2 * DFF + f0; const f32x4 a = *(const f32x4*)(sp + DFF), b4 = *(const f32x4*)(sp + DFF + 4);
                        if (tq == 0) { const f32x4 c4 = *(const f32x4*)sp, d4 = *(const f32x4*)(sp + 4);
#pragma unroll
                            for (int j = 0; j < 4; ++j) { q1[j] = a[j]; q1[4 + j] = b4[j]; q2[j] = c4[j]; q2[4 + j] = d4[j]; } }
                        else {
#pragma unroll
                            for (int j = 0; j < 4; ++j) { q2[j] = a[j]; q2[4 + j] = b4[j]; } } }
                    if (tq >= 2) { float* op = out + O_SFC + (size_t)((qq >> 2) * 2 + tq - 2) * DFF + f0; *(f32x4*)op = (f32x4){g[0] * SC_SFC, g[1] * SC_SFC, g[2] * SC_SFC, g[3] * SC_SFC}; *(f32x4*)(op + 4) = (f32x4){g[4] * SC_SFC, g[5] * SC_SFC, g[6] * SC_SFC, g[7] * SC_SFC}; } }
                else { const int t = r & 2047; if (t >= 2046) { float* op = out + O_PFC + (size_t)((r >> 11) * 2 + t - 2046) * DFF + f0; *(f32x4*)op = (f32x4){g[0] * SC_PFC, g[1] * SC_PFC, g[2] * SC_PFC, g[3] * SC_PFC}; *(f32x4*)(op + 4) = (f32x4){g[4] * SC_PFC, g[5] * SC_PFC, g[6] * SC_PFC, g[7] * SC_PFC}; } }
                float ov[8];
#pragma unroll
                for (int j = 0; j < 8; j += 2) {
                    typedef float f32x2 __attribute__((ext_vector_type(2)));
                    const f32x2 W0 = {w0[j], w0[j + 1]}, W1 = {w1[j], w1[j + 1]}, W2 = {w2[j], w2[j + 1]}, BB = {bb[j], bb[j + 1]}, Q2 = {q2[j], q2[j + 1]}, Q1 = {q1[j], q1[j + 1]}, GG2 = {g[j], g[j + 1]}, UU = {uu[j], uu[j + 1]};
                    const f32x2 x = W2 * GG2 + (W1 * Q1 + (W0 * Q2 + BB));
                    const f32x2 t = (x * x) * 0.044715f + 1.0f, a2 = (x * t) * (-2.302208198f);
                    f32x2 ex; ex.x = __builtin_amdgcn_exp2f(a2.x); ex.y = __builtin_amdgcn_exp2f(a2.y);
                    const f32x2 dn = ex + 1.0f; f32x2 rc; rc.x = __builtin_amdgcn_rcpf(dn.x); rc.y = __builtin_amdgcn_rcpf(dn.y);
                    const f32x2 r2 = (x * rc) * UU; ov[j] = r2.x; ov[j + 1] = r2.y; }
                u32x4 o; o.x = pk2(ov[0], ov[1]); o.y = pk2(ov[2], ov[3]); o.z = pk2(ov[4], ov[5]); o.w = pk2(ov[6], ov[7]);
                *(u32x4*)(ACT + (size_t)r * DFF + f0) = o;
                if (ai == 1 && m == 3 && wr == 1 && fr >= 14) { float* p = GE + ((size_t)u.pm * 2 + (fr - 14)) * DFF + f0; *(f32x4*)p = (f32x4){g[0], g[1], g[2], g[3]}; *(f32x4*)(p + 4) = (f32x4){g[4], g[5], g[6], g[7]}; }
                if (ai == 0 && m == 0 && wr == 0 && fr < 2) { float* p = G0 + ((size_t)u.pm * 2 + fr) * DFF + f0; *(f32x4*)p = (f32x4){g[0], g[1], g[2], g[3]}; *(f32x4*)(p + 4) = (f32x4){g[4], g[5], g[6], g[7]};
                    float* p2 = U0 + ((size_t)u.pm * 2 + fr) * DFF + f0; *(f32x4*)p2 = (f32x4){uu[0], uu[1], uu[2], uu[3]}; *(f32x4*)(p2 + 4) = (f32x4){uu[4], uu[5], uu[6], uu[7]}; }
#pragma unroll
                for (int j = 0; j < 8; ++j) gp[j] = g[j];
            }
        }
    }
};
struct EpiDown {
    static constexpr bool PERM = false, AFTER_DRAIN = false, MIDK = false, PRE = false;
    const bf16_t* XB2; float* out; float* SS; int skip;
    __device__ __forceinline__ void operator()(const f32x4 (&acc)[2][2][4][2], const Unit& u, int wr, int wc, int fr, int fq) const {
        if (skip) { if (acc[0][0][0][0].x == 123456.789f) out[0] = 1.f; return; }
        const int row0 = u.pm * 256 + wr * 64 + fr, col0 = u.pn * 256 + wc * 32 + 4 * fq;
#pragma unroll
        for (int ai = 0; ai < 2; ++ai) { u32x2 xw[4][2][2];
#pragma unroll
            for (int m = 0; m < 4; ++m)
#pragma unroll
                for (int bj = 0; bj < 2; ++bj)
#pragma unroll
                    for (int n = 0; n < 2; ++n) xw[m][bj][n] = *(const u32x2*)(XB2 + (size_t)(row0 + ai * 128 + m * 16) * DM + col0 + bj * 128 + n * 16);
#pragma unroll
            for (int m = 0; m < 4; ++m)
#pragma unroll
                for (int bj = 0; bj < 2; ++bj)
#pragma unroll
                    for (int n = 0; n < 2; ++n) EPI_PIN(xw[m][bj][n]);
#pragma unroll
            for (int m = 0; m < 4; ++m) { const int r = row0 + ai * 128 + m * 16; float ss = 0.f;
#pragma unroll
                for (int bj = 0; bj < 2; ++bj)
#pragma unroll
                    for (int n = 0; n < 2; ++n) { const size_t o = (size_t)r * DM + col0 + bj * 128 + n * 16; const u32x2 w = xw[m][bj][n]; const f32x4 v = acc[ai][bj][m][n] + (f32x4){bflo(w.x), bfhi(w.x), bflo(w.y), bfhi(w.y)};
                        *(f32x4*)(out + o) = v; ss += (v.x * v.x + v.y * v.y) + (v.z * v.z + v.w * v.w); }
                ss += __shfl_xor(ss, 16); ss += __shfl_xor(ss, 32);
                if (fq == 0) SS[(size_t)r * 32 + u.pn * 4 + wc] = ss; } }
    }
};
template <int MODE  > struct EpiSlab {
    static constexpr bool PERM = false, AFTER_DRAIN = false, MIDK = false, PRE = false;
    float* SLAB; int kslice; const bf16_t* SGM;
    __device__ __forceinline__ void operator()(const f32x4 (&acc)[2][2][4][2], const Unit& u, int wr, int wc, int fr, int fq) const {
        int pm = u.pm, pn = u.pn, s = u.ko / kslice, pass = 0;
        if (MODE == 1 && pm >= 130) { pass = 1; pm -= 66; pn -= 8; s += 4; }
        float* base = SLAB + ((size_t)s * MS + (size_t)(pm - 64) * 256 + wr * 64 + fr) * DM + pn * 256 + wc * 32 + 4 * fq;
        const bf16_t* gb = SGM + (size_t)(pm * 256 + wr * 64 + fr) * 4096 + pass * 2048 + pn * 256 + wc * 32 + 4 * fq;
#pragma unroll
        for (int ai = 0; ai < 2; ++ai)
#pragma unroll
            for (int m = 0; m < 4; ++m)
#pragma unroll
                for (int bj = 0; bj < 2; ++bj)
#pragma unroll
                    for (int n = 0; n < 2; ++n) { f32x4 v = acc[ai][bj][m][n];
                        if (MODE == 1) { const u32x2 gw = *(const u32x2*)(gb + (size_t)(ai * 128 + m * 16) * 4096 + bj * 128 + n * 16); v *= (f32x4){bflo(gw.x), bfhi(gw.x), bflo(gw.y), bfhi(gw.y)}; }
                        *(f32x4*)(base + (size_t)(ai * 128 + m * 16) * DM + bj * 128 + n * 16) = v; }
    }
};
struct SplitOrder {
    int G, c, NS, kslice, mode;
    __device__ __forceinline__ bool next(int i, Unit& u) const { const int L = i * G + c; if (L >= 16 * NS) return false; const int un = L / NS; int s = L - un * NS; u.pm = 64 + (un >> 3); u.pn = un & 7;
        if (mode == 1 && s >= NS / 2) { s -= NS / 2; u.pm += 66; u.pn += 8; } u.ko = s * kslice; return true; }
    __device__ __forceinline__ void a_ready(const Unit&) const {}
    __device__ __forceinline__ void done(const Unit&) const {}
};
struct CmpOrder {
    int G, c, base, count;
    __device__ __forceinline__ bool next(int i, Unit& u) const { const int L = i * G + c; if (L >= count) return false; u.pm = base + L; u.pn = (base + L) & 1; u.ko = 0; return true; }
    __device__ __forceinline__ void a_ready(const Unit&) const {}
    __device__ __forceinline__ void done(const Unit&) const {}
};

constexpr int RG_XC = 0, RG_WA = 34816, RG_WX = 43520, RG_A = 52224, RG_B = 68608, RG_U = 84992, RG_SA = 101376, RG_SH = 103424, RG_HC = 105472;
__device__ __forceinline__ void rglru_unit(const Frame& F, int unit, unsigned char* ldsg) {
    LAS unsigned char* lds = (LAS unsigned char*)ldsg;
    int tid = F.tid; asm volatile("" : "+v"(tid));
    const int lane = tid & 63, wid = F.wave, r32 = lane & 31, hi = lane >> 5;
    const bool samp = unit >= 256; int b = 0, n, q, grp = 0;
    if (!samp) { b = unit >> 5; n = (unit >> 2) & 7; q = unit & 3; } else { const int u2 = unit - 256; n = u2 >> 4; q = (u2 >> 2) & 3; grp = u2 & 3; }
    const int rowbase = samp ? MP + grp * 128 : b * SEQ, nchunks = samp ? 1 : 16;
    const bf16_t* XR = WSP(bf16_t, WS_XR); const bf16_t* GG = WSP(bf16_t, WS_GG); bf16_t* Y = WSP(bf16_t, WS_Y);
    LAS bf16_t* XC = (LAS bf16_t*)(lds + RG_XC); LAS bf16_t* WAT = (LAS bf16_t*)(lds + RG_WA); LAS bf16_t* WXT = (LAS bf16_t*)(lds + RG_WX);
    LAS float* As = (LAS float*)(lds + RG_A); LAS float* Bs = (LAS float*)(lds + RG_B); LAS float* Us = (LAS float*)(lds + RG_U);
    LAS float* SA = (LAS float*)(lds + RG_SA); LAS float* SH = (LAS float*)(lds + RG_SH); LAS float* HC = (LAS float*)(lds + RG_HC);
    __syncthreads();
    for (int idx = tid; idx < 4096; idx += 512) { const int c = idx >> 5, d = idx & 31; const size_t o = ((size_t)n * 128 + c) * 128 + q * 32 + d;
        WAT[d * 136 + c] = (bf16_t)(pk2(F.rwa[o], 0.f) & 0xffffu); WXT[d * 136 + c] = (bf16_t)(pk2(F.rwx[o], 0.f) & 0xffffu); }
    if (tid < 32) HC[tid] = 0.f;
    const int cg = tid & 15; float cw[4][8], cb[8];
#pragma unroll
    for (int e = 0; e < 8; ++e) { const int ch = n * 128 + cg * 8 + e; cb[e] = F.rconv_b[ch];
#pragma unroll
        for (int j = 0; j < 4; ++j) cw[j][e] = F.rconv_w[j * 1024 + ch]; }
    const int which = wid >> 2, rt = wid & 3, chd = n * 128 + q * 32 + r32;
    const float gbias = which ? F.rbx[chd] : F.rba[chd];
    const float sp8 = -8.0f * log1pf(expf(-F.rlam[chd]));
    const int sd = tid & 31, seg = tid >> 5, sch = n * 128 + q * 32 + sd;
    for (int ck = 0; ck < nchunks; ++ck) {
        const int r0 = rowbase + ck * 128;
        __syncthreads();
#pragma unroll
        for (int k = 0; k < 4; ++k) { const int item = tid + 512 * k, row = item >> 4; const int gr = r0 + row; float acc8[8];
#pragma unroll
            for (int e = 0; e < 8; ++e) acc8[e] = cb[e];
#pragma unroll
            for (int j = 0; j < 4; ++j) { float xv[8]; bool have = true;
                if (!samp) { const int t = ck * 128 + row - 3 + j; have = t >= 0;
                    if (have) { const u32x4 w = *(const u32x4*)(XR + (size_t)(gr - 3 + j) * 1024 + n * 128 + cg * 8);
                        xv[0] = bflo(w.x); xv[1] = bfhi(w.x); xv[2] = bflo(w.y); xv[3] = bfhi(w.y); xv[4] = bflo(w.z); xv[5] = bfhi(w.z); xv[6] = bflo(w.w); xv[7] = bfhi(w.w); } }
                else { const int qq = gr - MP, db = qq >> 2, tq = qq & 3, tt = tq - 3 + j;
                    if (tt >= 0) { const u32x4 w = *(const u32x4*)(XR + (size_t)(gr - 3 + j) * 1024 + n * 128 + cg * 8);
                        xv[0] = bflo(w.x); xv[1] = bfhi(w.x); xv[2] = bflo(w.y); xv[3] = bfhi(w.y); xv[4] = bflo(w.z); xv[5] = bfhi(w.z); xv[6] = bflo(w.w); xv[7] = bfhi(w.w); }
                    else { const float* sp = F.st_conv + ((size_t)db * 3 + (tq + j)) * 1024 + n * 128 + cg * 8; const f32x4 a = *(const f32x4*)sp, c4 = *(const f32x4*)(sp + 4);
                        xv[0] = a.x; xv[1] = a.y; xv[2] = a.z; xv[3] = a.w; xv[4] = c4.x; xv[5] = c4.y; xv[6] = c4.z; xv[7] = c4.w; } }
                if (have) {
#pragma unroll
                    for (int e = 0; e < 8; ++e) acc8[e] += cw[j][e] * xv[e]; } }
            u32x4 o; o.x = pk2(acc8[0], acc8[1]); o.y = pk2(acc8[2], acc8[3]); o.z = pk2(acc8[4], acc8[5]); o.w = pk2(acc8[6], acc8[7]);
            *(LAS u32x4*)(XC + row * 136 + cg * 8) = o; }
        __syncthreads();
        { f32x16 acc;
#pragma unroll
          for (int r = 0; r < 16; ++r) acc[r] = gbias;
          const LAS bf16_t* wt = which ? WXT : WAT;
#pragma unroll
          for (int ks = 0; ks < 8; ++ks) { const bf16x8 af = *(const LAS bf16x8*)(XC + (rt * 32 + r32) * 136 + ks * 16 + hi * 8); const bf16x8 bfr = *(const LAS bf16x8*)(wt + r32 * 136 + ks * 16 + hi * 8);
              acc = __builtin_amdgcn_mfma_f32_32x32x16_bf16(af, bfr, acc, 0, 0, 0); }
#pragma unroll
          for (int r = 0; r < 16; ++r) { const int row = rt * 32 + (r & 3) + 8 * (r >> 2) + 4 * hi; const float sg = sigmoidf_(acc[r]);
              if (which == 0) { const float la = sp8 * sg; As[row * 32 + r32] = expf(la); Bs[row * 32 + r32] = sqrtf(-expm1f(2.0f * la)); }
              else { Us[row * 32 + r32] = sg * bf2f(XC[row * 136 + q * 32 + r32]); } } }
        __syncthreads();
        if (!samp) { float hl[8], cl[8]; float h = 0.f, ca = 1.f;
#pragma unroll
            for (int i = 0; i < 8; ++i) { const int row = seg * 8 + i; const float a = As[row * 32 + sd], uu = Bs[row * 32 + sd] * Us[row * 32 + sd]; h = a * h + uu; ca *= a; hl[i] = h; cl[i] = ca; }
            SA[seg * 32 + sd] = ca; SH[seg * 32 + sd] = h;
            __syncthreads();
            float hin = HC[sd];
            for (int s = 0; s < seg; ++s) hin = SA[s * 32 + sd] * hin + SH[s * 32 + sd];
            float hh = 0.f;
#pragma unroll
            for (int i = 0; i < 8; ++i) { const int gr = r0 + seg * 8 + i; hh = hl[i] + cl[i] * hin; const float gg = bf2f(GG[(size_t)gr * 1024 + sch]);
                Y[(size_t)gr * 1024 + sch] = (bf16_t)(pk2(hh * gg, 0.f) & 0xffffu); }
            __syncthreads();
            if (seg == 15) { HC[sd] = hh; if (ck == nchunks - 1) F.out[O_PRH + (size_t)b * 1024 + sch] = hh * SC_PRH; }
        } else { float h = 0.f;
#pragma unroll
            for (int i = 0; i < 8; ++i) { const int row = seg * 8 + i, gr = r0 + row, qq = gr - MP, db = qq >> 2, tq = qq & 3;
                if (tq == 0) h = F.st_h[(size_t)db * 1024 + sch];
                const float a = As[row * 32 + sd], uu = Bs[row * 32 + sd] * Us[row * 32 + sd]; h = a * h + uu;
                const float gg = bf2f(GG[(size_t)gr * 1024 + sch]); Y[(size_t)gr * 1024 + sch] = (bf16_t)(pk2(h * gg, 0.f) & 0xffffu);
                if (tq == 3) F.out[O_SRH + (size_t)db * 1024 + sch] = h * SC_SRH; } }
    }
}

constexpr int RP_XRAW = 0, RP_XC = 33792, RP_WA = 68608, RP_WX = 77312, RP_A = 86016, RP_U = 102400, RP_SA = 118784, RP_SH = 120832, RP_HC = 122880;
__device__ __forceinline__ void rglru_prompt_unit(const Frame& F, int unit, unsigned char* ldsg) {
    LAS unsigned char* lds = (LAS unsigned char*)ldsg;
    int tid = F.tid; asm volatile("" : "+v"(tid));
    const int lane = tid & 63, wid = F.wave;
    const int b = unit >> 5, n = (unit >> 2) & 7, q = unit & 3, rowbase = b * SEQ;
    const bf16_t* XR = WSP(bf16_t, WS_XR); const bf16_t* GG = WSP(bf16_t, WS_GG); bf16_t* Y = WSP(bf16_t, WS_Y);
    LAS bf16_t* XRAW = (LAS bf16_t*)(lds + RP_XRAW); LAS bf16_t* XC = (LAS bf16_t*)(lds + RP_XC); LAS bf16_t* WAT = (LAS bf16_t*)(lds + RP_WA); LAS bf16_t* WXT = (LAS bf16_t*)(lds + RP_WX);
    LAS float* As = (LAS float*)(lds + RP_A); LAS float* Us = (LAS float*)(lds + RP_U);
    LAS float* SA = (LAS float*)(lds + RP_SA); LAS float* SH = (LAS float*)(lds + RP_SH); LAS float* HC = (LAS float*)(lds + RP_HC);
    __syncthreads();
    for (int idx = tid; idx < 4096; idx += 512) { const int c = idx >> 5, d = idx & 31; const size_t o = ((size_t)n * 128 + c) * 128 + q * 32 + d;
        WAT[d * 136 + c] = (bf16_t)(pk2(F.rwa[o], 0.f) & 0xffffu); WXT[d * 136 + c] = (bf16_t)(pk2(F.rwx[o], 0.f) & 0xffffu); }
    if (tid < 32) HC[tid] = 0.f;
    const int cg = tid & 15; float cw[4][8], cb[8];
#pragma unroll
    for (int e = 0; e < 8; ++e) { const int ch = n * 128 + cg * 8 + e; cb[e] = F.rconv_b[ch];
#pragma unroll
        for (int j = 0; j < 4; ++j) cw[j][e] = F.rconv_w[j * 1024 + ch]; }
    const int fr = lane & 15, fq = lane >> 4; float gba[2], gbx[2], sp8[2];
#pragma unroll
    for (int ct = 0; ct < 2; ++ct) { const int chd = n * 128 + q * 32 + ct * 16 + fr; gba[ct] = F.rba[chd]; gbx[ct] = F.rbx[chd]; sp8[ct] = -8.0f * 1.4426950409f * log1pf(expf(-F.rlam[chd])); }
    const int sd = tid & 31, seg = tid >> 5;
    const int orow = tid >> 2, ocg = tid & 3;
    u32x4 raw[5], ggp;
#pragma unroll
    for (int k = 0; k < 5; ++k) { const int p = tid + 512 * k, rr = (p >> 4) - 4; raw[k] = (u32x4){0u, 0u, 0u, 0u};
        if (p < 2112 && rr >= 0) raw[k] = *(const u32x4*)(XR + (size_t)(rowbase + rr) * 1024 + n * 128 + (p & 15) * 8); }
    ggp = *(const u32x4*)(GG + (size_t)(rowbase + orow) * 1024 + n * 128 + q * 32 + ocg * 8);
    for (int ck = 0; ck < 16; ++ck) {
        const int r0 = rowbase + ck * 128;
        __syncthreads();
#pragma unroll
        for (int k = 0; k < 5; ++k) { const int p = tid + 512 * k; if (p < 2112) *(LAS u32x4*)(XRAW + (p >> 4) * 128 + (p & 15) * 8) = raw[k]; }
        const u32x4 ggc = ggp;
        if (ck < 15) {
#pragma unroll
            for (int k = 0; k < 5; ++k) { const int p = tid + 512 * k; if (p < 2112) raw[k] = *(const u32x4*)(XR + (size_t)(r0 + 124 + (p >> 4)) * 1024 + n * 128 + (p & 15) * 8); }
            ggp = *(const u32x4*)(GG + (size_t)(r0 + 128 + orow) * 1024 + n * 128 + q * 32 + ocg * 8); }
        __syncthreads();
#pragma unroll
        for (int k = 0; k < 4; ++k) { const int row = (tid >> 4) + 32 * k; float acc8[8];
#pragma unroll
            for (int e = 0; e < 8; ++e) acc8[e] = cb[e];
#pragma unroll
            for (int j = 0; j < 4; ++j) { const u32x4 w = *(const LAS u32x4*)(XRAW + (row + 1 + j) * 128 + cg * 8);
                acc8[0] += cw[j][0] * bflo(w.x); acc8[1] += cw[j][1] * bfhi(w.x); acc8[2] += cw[j][2] * bflo(w.y); acc8[3] += cw[j][3] * bfhi(w.y);
                acc8[4] += cw[j][4] * bflo(w.z); acc8[5] += cw[j][5] * bfhi(w.z); acc8[6] += cw[j][6] * bflo(w.w); acc8[7] += cw[j][7] * bfhi(w.w); }
            u32x4 o; o.x = pk2(acc8[0], acc8[1]); o.y = pk2(acc8[2], acc8[3]); o.z = pk2(acc8[4], acc8[5]); o.w = pk2(acc8[6], acc8[7]);
            *(LAS u32x4*)(XC + row * 136 + cg * 8) = o; }
        __syncthreads();
        { f32x4 ar[2], ai[2];
#pragma unroll
          for (int ct = 0; ct < 2; ++ct) { ar[ct] = (f32x4){gba[ct], gba[ct], gba[ct], gba[ct]}; ai[ct] = (f32x4){gbx[ct], gbx[ct], gbx[ct], gbx[ct]}; }
#pragma unroll
          for (int ks = 0; ks < 4; ++ks) { const bf16x8 af = *(const LAS bf16x8*)(XC + (wid * 16 + fr) * 136 + ks * 32 + fq * 8);
#pragma unroll
              for (int ct = 0; ct < 2; ++ct) { const bf16x8 ba = *(const LAS bf16x8*)(WAT + (ct * 16 + fr) * 136 + ks * 32 + fq * 8), bx = *(const LAS bf16x8*)(WXT + (ct * 16 + fr) * 136 + ks * 32 + fq * 8);
                  ar[ct] = __builtin_amdgcn_mfma_f32_16x16x32_bf16(af, ba, ar[ct], 0, 0, 0); ai[ct] = __builtin_amdgcn_mfma_f32_16x16x32_bf16(af, bx, ai[ct], 0, 0, 0); } }
#pragma unroll
          for (int ct = 0; ct < 2; ++ct)
#pragma unroll
              for (int j = 0; j < 4; ++j) { const int row = wid * 16 + fq * 4 + j, d = ct * 16 + fr;
                  const float rg = sigmoidf_(ar[ct][j]), ig = sigmoidf_(ai[ct][j]); const float l2 = sp8[ct] * rg;
                  const float a = __builtin_amdgcn_exp2f(l2); const float x = 1.3862943611f * l2;
                  const float om = (x > -0.05f) ? -x * (1.0f + x * (0.5f + x * (0.16666667f + x * 0.041666668f))) : 1.0f - a * a;
                  As[row * 32 + d] = a; Us[row * 32 + d] = __builtin_amdgcn_sqrtf(om) * ig * bf2f(XC[row * 136 + q * 32 + d]); } }
        __syncthreads();
        float hl[8], cl[8]; float h = 0.f, ca = 1.f;
#pragma unroll
        for (int i = 0; i < 8; ++i) { const int row = seg * 8 + i; const float a = As[row * 32 + sd]; h = a * h + Us[row * 32 + sd]; ca *= a; hl[i] = h; cl[i] = ca; }
        SA[seg * 32 + sd] = ca; SH[seg * 32 + sd] = h;
        __syncthreads();
        float hin = HC[sd];
        for (int s = 0; s < seg; ++s) hin = SA[s * 32 + sd] * hin + SH[s * 32 + sd];
        float hh = 0.f;
#pragma unroll
        for (int i = 0; i < 8; ++i) { hh = hl[i] + cl[i] * hin; As[(seg * 8 + i) * 32 + sd] = hh; }
        __syncthreads();
        if (seg == 15) { HC[sd] = hh; if (ck == 15) F.out[O_PRH + (size_t)b * 1024 + n * 128 + q * 32 + sd] = hh * SC_PRH; }
        { const LAS f32x4* hp = (const LAS f32x4*)(As + orow * 32 + ocg * 8); const f32x4 h0 = hp[0], h1 = hp[1];
          u32x4 o; o.x = pk2(h0.x * bflo(ggc.x), h0.y * bfhi(ggc.x)); o.y = pk2(h0.z * bflo(ggc.y), h0.w * bfhi(ggc.y)); o.z = pk2(h1.x * bflo(ggc.z), h1.y * bfhi(ggc.z)); o.w = pk2(h1.z * bflo(ggc.w), h1.w * bfhi(ggc.w));
          *(u32x4*)(Y + (size_t)(r0 + orow) * 1024 + n * 128 + q * 32 + ocg * 8) = o; }
    }
}

#ifndef QB_OF
#define QB_OF(x) (31 - (x))
#endif
namespace att {
#ifndef ATT_THR
#define ATT_THR 8.f
#endif
constexpr float SCALE = 0.08838834764831845f, THR = ATT_THR;
constexpr int A_V = 0, A_K = 16384, A_WS = 32768, A_IMPA = 36864, A_IMPB = 70656, A_IMP = 104448, A_SEL = 112896, A_UNI = 113152, A_SC = 113408, A_Q = 115712;
#define KSWZ(row, colB) ((row) * 256 + ((colB) ^ (((row) & 7) << 4)))
#define SBAR() __builtin_amdgcn_sched_barrier(0)
__device__ __forceinline__ int v_st(int k, int c) { const int kk = (k & ~0xC) | ((k & 4) << 1) | ((k & 8) >> 1); return ((kk >> 3) * 4 + (c >> 5)) * 512 + ((kk & 7) * 32 + (c & 31)) * 2; }
__device__ __forceinline__ int v_rd_base(int lane) { return ((lane & 3) << 3) | (((lane >> 2) & 3) << 6) | (((lane >> 4) & 1) << 5) | (((lane >> 5) & 1) << 8); }
constexpr int v_rd_off(int d0, int ks, int half) { return d0 * 512 + ks * 4096 + half * 2048; }
__device__ __forceinline__ int crow(int r, int hi) { return (r & 3) + 8 * (r >> 2) + 4 * hi; }
__device__ __forceinline__ unsigned cvtpk(float lo, float hi) { return pg8::cvt_pk_bf16(lo, hi); }

__device__ __forceinline__ void mask_tile(f32x16& p0, f32x16& p1, int dq, int kstep, unsigned W, bool rowsel) {
    const float NEG = -__builtin_inff();
#pragma unroll
    for (int r = 0; r < 16; ++r) { const int c = (r & 3) + 8 * (r >> 2);
        const bool bad0 = (!rowsel) | ((unsigned)(dq - kstep * c) > W), bad1 = (!rowsel) | ((unsigned)(dq - kstep * (c + 32)) > W);
        p0[r] = bad0 ? NEG : p0[r]; p1[r] = bad1 ? NEG : p1[r]; }
}
__device__ __forceinline__ void partialSM(f32x16& p0, f32x16& p1, float& m_reg, float& mn, float& alpha) {
    float pmax = p0[0];
#pragma unroll
    for (int r = 1; r < 16; ++r) pmax = fmaxf(pmax, p0[r]);
#pragma unroll
    for (int r = 0; r < 16; ++r) pmax = fmaxf(pmax, p1[r]);
    { auto rr = __builtin_amdgcn_permlane32_swap(__float_as_uint(pmax), __float_as_uint(pmax), false, false);
      pmax = fmaxf(__uint_as_float(rr[0]), __uint_as_float(rr[1])); }
    constexpr float C2 = 1.4426950408889634f * SCALE;
    if (__builtin_expect(__all((pmax - m_reg) * SCALE <= THR), 1)) { mn = m_reg; alpha = 1.f; }
    else { mn = fmaxf(m_reg, pmax); alpha = __builtin_amdgcn_exp2f((m_reg - mn) * C2); m_reg = mn; }
    const float mnL = -mn * C2;
#pragma unroll
    for (int r = 0; r < 16; ++r) { p0[r] = __builtin_amdgcn_exp2f(fmaf(p0[r], C2, mnL)); p1[r] = __builtin_amdgcn_exp2f(fmaf(p1[r], C2, mnL)); }
}
__device__ __forceinline__ void finishSM(f32x16& p0, f32x16& p1, float alpha, float& l_reg, bf16x8& pa0, bf16x8& pa1, bf16x8& pa2, bf16x8& pa3) {
    float ps = 0;
#pragma unroll
    for (int r = 0; r < 16; ++r) ps += p0[r];
#pragma unroll
    for (int r = 0; r < 16; ++r) ps += p1[r];
    { auto rr = __builtin_amdgcn_permlane32_swap(__float_as_uint(ps), __float_as_uint(ps), false, false);
      ps = __uint_as_float(rr[0]) + __uint_as_float(rr[1]); }
    l_reg = l_reg * alpha + ps;
#define PK4(P, B_, OUT) do { unsigned a0 = cvtpk(P[B_+0], P[B_+1]), a1 = cvtpk(P[B_+2], P[B_+3]);                          \
        unsigned b0 = cvtpk(P[B_+4], P[B_+5]), b1 = cvtpk(P[B_+6], P[B_+7]);                                             \
        auto r0 = __builtin_amdgcn_permlane32_swap(a0, b0, false, false); auto r1 = __builtin_amdgcn_permlane32_swap(a1, b1, false, false); \
        u32x4 w = {r0[0], r1[0], r0[1], r1[1]}; OUT = *reinterpret_cast<bf16x8*>(&w); } while (0)
    PK4(p0, 0, pa0); PK4(p0, 8, pa1); PK4(p1, 0, pa2); PK4(p1, 8, pa3);
#undef PK4
}
template <bool QLDS>
__device__ __forceinline__ void qkt(f32x16& p0, f32x16& p1, const LAS char* K_lds, int r32, int hi, const bf16x8* qr, const LAS char* Q_lds, float bbase, float bstep) {
#pragma unroll
    for (int r = 0; r < 16; ++r) { const int c = (r & 3) + 8 * (r >> 2); p0[r] = fmaf(bstep, (float)c, bbase); p1[r] = fmaf(bstep, (float)(c + 32), bbase); }
    const LAS char* kb[4];
#pragma unroll
    for (int dd = 0; dd < 4; ++dd) kb[dd] = K_lds + KSWZ(r32, (dd * 16 + hi * 8) * 2);
#pragma unroll
    for (int d0 = 0; d0 < 8; ++d0) { const LAS char* a = kb[d0 & 3] + (d0 >> 2) * 128;
        const bf16x8 b0 = *reinterpret_cast<const LAS bf16x8*>(a);
        const bf16x8 b1 = *reinterpret_cast<const LAS bf16x8*>(a + 32 * 256);
        const bf16x8 qf = QLDS ? *reinterpret_cast<const LAS bf16x8*>(Q_lds + d0 * 1024) : qr[d0];
        p0 = __builtin_amdgcn_mfma_f32_32x32x16_bf16(b0, qf, p0, 0, 0, 0);
        p1 = __builtin_amdgcn_mfma_f32_32x32x16_bf16(b1, qf, p1, 0, 0, 0); }
}
__device__ __forceinline__ void pv_tile(f32x16* o, int vb0, bf16x8 pa0, bf16x8 pa1, bf16x8 pa2, bf16x8 pa3) {
#define TRRD(dst, off) asm volatile("ds_read_b64_tr_b16 %0, %1 offset:%2" : "=&v"(dst) : "v"(vb0), "i"(off) : "memory")
#define PV_D0(d0) do { s16x4 l0, l1, l2, l3, h0, h1, h2, h3; constexpr int b_ = v_rd_off(d0, 0, 0); \
        TRRD(l0, b_); TRRD(h0, b_ + 2048); TRRD(l1, b_ + 4096); TRRD(h1, b_ + 6144); TRRD(l2, b_ + 8192); TRRD(h2, b_ + 10240); TRRD(l3, b_ + 12288); TRRD(h3, b_ + 14336); \
        asm volatile("s_waitcnt lgkmcnt(0)" ::: "memory"); SBAR();   \
        o[d0] = __builtin_amdgcn_mfma_f32_32x32x16_bf16(pa0, (bf16x8){l0[0], l0[1], l0[2], l0[3], h0[0], h0[1], h0[2], h0[3]}, o[d0], 0, 0, 0);   \
        o[d0] = __builtin_amdgcn_mfma_f32_32x32x16_bf16(pa1, (bf16x8){l1[0], l1[1], l1[2], l1[3], h1[0], h1[1], h1[2], h1[3]}, o[d0], 0, 0, 0);   \
        o[d0] = __builtin_amdgcn_mfma_f32_32x32x16_bf16(pa2, (bf16x8){l2[0], l2[1], l2[2], l2[3], h2[0], h2[1], h2[2], h2[3]}, o[d0], 0, 0, 0);   \
        o[d0] = __builtin_amdgcn_mfma_f32_32x32x16_bf16(pa3, (bf16x8){l3[0], l3[1], l3[2], l3[3], h3[0], h3[1], h3[2], h3[3]}, o[d0], 0, 0, 0); } while (0)
    PV_D0(0); PV_D0(1); PV_D0(2); PV_D0(3);
#undef PV_D0
#undef TRRD
}
struct Tile { const void* K; const void* V; int stride; int mode  ; int nvalid; int kp0, kstep; unsigned W; int selbit; int n0; int wrow  ; };

template <bool SAMPLE>
__device__ __forceinline__ void attn_unit(const Frame& F, int uidx, unsigned char* ldsg) {
    LAS char* lds = (LAS char*)ldsg;
    int tid = F.tid; asm volatile("" : "+v"(tid));
    const int wid = F.wave, lane = tid & 63, r32 = lane & 31, hi = lane >> 5;
    int b = 0, g, qb = 32, db = 0;
    if (SAMPLE) { db = uidx >> 1; g = uidx & 1; } else { qb = QB_OF(uidx >> 4); b = (uidx & 15) >> 1; g = uidx & 1; }
    const bool active = SAMPLE ? (wid == 0) : true;
    const int hl = SAMPLE ? ((r32 & 15) >> 2) : (wid >> 1), tok = SAMPLE ? (r32 & 3) : ((wid & 1) * 32 + r32);
    const bool rowvalid = SAMPLE ? (r32 < 16) : true;
    const int t = SAMPLE ? SEQ + tok : qb * 64 + tok;
    const size_t grow = SAMPLE ? (size_t)MP + db * 4 + tok : (size_t)b * SEQ + t;
    const int head = g * 4 + hl;
    const float sl_raw = __builtin_amdgcn_exp2f(-(float)(head + 1)) * (1.0f / SCALE);
    const bf16_t* Qg = WSP(bf16_t, WS_Q); const bf16_t* KVS = WSP(bf16_t, WS_KVS); const bf16_t* KVWb = WSP(bf16_t, WS_KVW);
    const float* FS = WSP(float, WS_FS); const float* POSB = WSP(float, WS_POSB); const float* GNSA = WSP(float, WS_GNSA);
    float* OMIX = WSP(float, WS_OMIX); bf16_t* OB = WSP(bf16_t, WS_OB);
    bf16x8 qr[8]; const LAS char* Q_lds = lds + A_Q + lane * 16;
    if (SAMPLE) { __syncthreads();
        if (wid == 0) {
#pragma unroll
            for (int d0 = 0; d0 < 8; ++d0) { bf16x8 qv = *(const bf16x8*)(Qg + grow * 1024 + head * 128 + d0 * 16 + hi * 8);
#ifdef QDEGRADE
                for (int e = 0; e < 8; ++e) qv[e] &= (short)0xFFFC;
#endif
                *(LAS bf16x8*)(lds + A_Q + d0 * 1024 + lane * 16) = qv; } }
    } else {
#pragma unroll
        for (int d0 = 0; d0 < 8; ++d0) { qr[d0] = *(const bf16x8*)(Qg + grow * 1024 + head * 128 + d0 * 16 + hi * 8);
#ifdef QDEGRADE
            for (int e = 0; e < 8; ++e) qr[d0][e] &= (short)0xFFFC;
#endif
        } }
    LAS char* V_lds = lds + A_V; LAS char* K_lds = lds + A_K;
    LAS float* li_l = (LAS float*)(lds + A_WS) + wid * 64; LAS float* al_l = li_l + 32;
    LAS float* IMPA = (LAS float*)(lds + A_IMPA); LAS float* IMPB = (LAS float*)(lds + A_IMPB); LAS float* IMP = (LAS float*)(lds + A_IMP);
    LAS unsigned* SEL = (LAS unsigned*)(lds + A_SEL); LAS unsigned* UNI = (LAS unsigned*)(lds + A_UNI); LAS float* SC = (LAS float*)(lds + A_SC);
    const int vb0 = (int)(unsigned)(size_t)V_lds + v_rd_base(lane);
    const int sr = tid >> 4, sc = (tid & 15) * 8, vst0 = v_st(sr, sc), vst1 = v_st(32 + sr, sc), kws = KSWZ(sr, sc * 2);
    const int fsunit = SAMPLE ? db * 2 : 256 + b * 2;
#ifdef ATT_EQUIV
    const int ncmp = 2; const int wlo = 0;
#else
    const int ncmp = SAMPLE ? 2 : (qb >= 16 ? 2 : 1);
    const int wlo = SAMPLE ? 0 : (qb >= 8 ? qb - 8 : 0);
#endif

    float m_reg = -1e30f, l_reg = 0.f; f32x16 o[4];
#pragma unroll
    for (int d = 0; d < 4; ++d)
#pragma unroll
        for (int r = 0; r < 16; ++r) o[d][r] = 0.f;
    float sc0 = 1.f;
    unsigned sel = 0u, rem = 0u; bool own_done = false;
    int br = 0, step = 0;
    auto gen = [&](Tile& T) -> bool {
        bool have = false; T.K = nullptr; T.V = nullptr; T.stride = 0; T.mode = 0; T.nvalid = 64; T.kp0 = 0; T.kstep = 1; T.W = 0x7fffffffu; T.selbit = -1; T.n0 = 0; T.wrow = -1;
        if (br == 0) { if (step < ncmp) { have = true; T.mode = 2; T.n0 = step * 64; T.kp0 = 31 + 1024 * step; T.kstep = 16; } }
        else if (br == 1) {
            if (rem != 0u) { const int kb = __builtin_ctz(rem); rem &= rem - 1u; have = true; T.selbit = kb; T.kp0 = kb * 64;
                if (SAMPLE) { const int page = F.pt[db * 16 + (kb >> 1)]; const float* base = F.c_slc + ((size_t)page * 128 + (kb & 1) * 64) * 512 + g * 128;
                    T.K = base; T.V = base + 256; T.stride = 512; T.mode = 1; }
                else { const bf16_t* base = KVS + ((size_t)b * SEQ + kb * 64) * 512 + g * 128; T.K = base; T.V = base + 256; T.stride = 512; T.mode = 0; } }
            else if (!own_done) { own_done = true; have = true;
                if (SAMPLE) { const bf16_t* base = KVS + ((size_t)MP + db * 4) * 512 + g * 128; T.K = base; T.V = base + 256; T.stride = 512; T.nvalid = 4; T.kp0 = SEQ; }
                else { const bf16_t* base = KVS + ((size_t)b * SEQ + qb * 64) * 512 + g * 128; T.K = base; T.V = base + 256; T.stride = 512; T.kp0 = qb * 64; } } }
        else {
            if (SAMPLE) { if (step < 8) { have = true; const float* base = F.c_win + ((size_t)db * 512 + step * 64) * 512 + g * 128; T.K = base; T.V = base + 256; T.stride = 512; T.mode = 1; T.kp0 = SEQ - 512 + step * 64; T.W = 512u; T.wrow = step * 64; }
                else if (step == 8) { have = true; const bf16_t* base = KVWb + ((size_t)MP + db * 4) * 512 + g * 128; T.K = base; T.V = base + 256; T.stride = 512; T.nvalid = 4; T.kp0 = SEQ; T.W = 512u; } }
            else { const int kb = wlo + step; if (kb <= qb) { have = true; const bf16_t* base = KVWb + ((size_t)b * SEQ + kb * 64) * 512 + g * 128; T.K = base; T.V = base + 256; T.stride = 512; T.kp0 = kb * 64; T.W = 512u; } } }
        if (have) ++step;
        return have; };
    u32x4 pk0 = {0u, 0u, 0u, 0u}, pk1 = pk0, pv0 = pk0, pv1 = pk0; f32x4 fk[4], fv[4];
    auto issue = [&](const Tile& T) {
        if (T.mode == 0) { const bf16_t* Kp = (const bf16_t*)T.K; const bf16_t* Vp = (const bf16_t*)T.V; pk0 = (u32x4){0u, 0u, 0u, 0u}; pk1 = pk0; pv0 = pk0; pv1 = pk0;
            if (sr < T.nvalid) { pk0 = *(const u32x4*)(Kp + (size_t)sr * T.stride + sc); pv0 = *(const u32x4*)(Vp + (size_t)sr * T.stride + sc); }
            if (sr + 32 < T.nvalid) { pk1 = *(const u32x4*)(Kp + (size_t)(sr + 32) * T.stride + sc); pv1 = *(const u32x4*)(Vp + (size_t)(sr + 32) * T.stride + sc); } }
        else if (SAMPLE && T.mode == 1) { const float* Kp = (const float*)T.K + (size_t)sr * T.stride + sc; const float* Vp = (const float*)T.V + (size_t)sr * T.stride + sc;
            fk[0] = *(const f32x4*)Kp; fk[1] = *(const f32x4*)(Kp + 4); fk[2] = *(const f32x4*)(Kp + 32 * 512); fk[3] = *(const f32x4*)(Kp + 32 * 512 + 4);
            fv[0] = *(const f32x4*)Vp; fv[1] = *(const f32x4*)(Vp + 4); fv[2] = *(const f32x4*)(Vp + 32 * 512); fv[3] = *(const f32x4*)(Vp + 32 * 512 + 4); } };
    auto commit = [&](const Tile& T) {
        if (T.mode == 0) { *(LAS u32x4*)(K_lds + kws) = pk0; *(LAS u32x4*)(K_lds + kws + 32 * 256) = pk1; *(LAS u32x4*)(V_lds + vst0) = pv0; *(LAS u32x4*)(V_lds + vst1) = pv1; }
        else if (SAMPLE && T.mode == 1) { *(LAS u32x4*)(K_lds + kws) = pack8u(fk[0], fk[1]); *(LAS u32x4*)(K_lds + kws + 32 * 256) = pack8u(fk[2], fk[3]);
            *(LAS u32x4*)(V_lds + vst0) = pack8u(fv[0], fv[1]); *(LAS u32x4*)(V_lds + vst1) = pack8u(fv[2], fv[3]);
            if (T.wrow >= 0) {
                float* dst = F.out + O_SKW + ((size_t)db * 512) * 512 + g * 128 + sc; const int i0 = T.wrow + sr - 4;
                if (i0 >= 0) { float* p = dst + (size_t)i0 * 512; *(f32x4*)p = fk[0]; *(f32x4*)(p + 4) = fk[1]; *(f32x4*)(p + 256) = fv[0]; *(f32x4*)(p + 260) = fv[1]; }
                { float* p = dst + (size_t)(i0 + 32) * 512; *(f32x4*)p = fk[2]; *(f32x4*)(p + 4) = fk[3]; *(f32x4*)(p + 256) = fv[2]; *(f32x4*)(p + 260) = fv[3]; } } }
        else if (T.mode == 2) { const float* Fk = FS + (size_t)fsunit * 65536; const float* Fv = Fk + 65536;
#pragma unroll 1
            for (int hh = 0; hh < 2; ++hh) { const int n = T.n0 + sr + 32 * hh; u32x4 kk = {0u, 0u, 0u, 0u}, vv = kk;
                if (n <= 126) { const size_t o1 = (size_t)(g * 128 + n) * 256 + sc, o2 = (size_t)(g * 128 + n + 1) * 256 + 128 + sc;
                    { const f32x4 a0 = *(const f32x4*)(Fk + o1) + *(const f32x4*)(Fk + o2) + *(const f32x4*)(POSB + sc), a1 = *(const f32x4*)(Fk + o1 + 4) + *(const f32x4*)(Fk + o2 + 4) + *(const f32x4*)(POSB + sc + 4); kk = pack8u(a0, a1); }
                    { const f32x4 c0 = *(const f32x4*)(Fv + o1) + *(const f32x4*)(Fv + o2) + *(const f32x4*)(POSB + 128 + sc), c1 = *(const f32x4*)(Fv + o1 + 4) + *(const f32x4*)(Fv + o2 + 4) + *(const f32x4*)(POSB + 128 + sc + 4); vv = pack8u(c0, c1); } }
                *(LAS u32x4*)(K_lds + kws + hh * 32 * 256) = kk; *(LAS u32x4*)(V_lds + (hh ? vst1 : vst0)) = vv; } } };
    Tile T; bool have = gen(T);
    if (have) issue(T);
    for (;;) {
        if (!have) {
            if (active) {
                const float inv = 1.0f / fmaxf(l_reg, 1e-30f);
                if (hi == 0) li_l[r32] = rowvalid ? GNSA[grow * 32 + br * 8 + head] * inv : 0.f;
                asm volatile("s_waitcnt lgkmcnt(0)" ::: "memory");
                int r32e = r32, hie = hi; asm volatile("" : "+v"(r32e), "+v"(hie));
#pragma unroll
                for (int r = 0; r < (SAMPLE ? 8 : 16); ++r) { const int rr = crow(r, hie); const float fac = li_l[rr];
                    size_t orow; int ohead; bool ok = true;
                    if (SAMPLE) { ok = rr < 16; orow = (size_t)MP + db * 4 + (rr & 3); ohead = g * 4 + ((rr & 15) >> 2); } else { orow = (size_t)b * SEQ + qb * 64 + (wid & 1) * 32 + rr; ohead = head; }
                    if (ok) { float* pm = OMIX + orow * 1024 + ohead * 128 + r32e; bf16_t* pb = OB + orow * 1024 + ohead * 128 + r32e;
                        float v0 = o[0][r] * fac, v1 = o[1][r] * fac, v2 = o[2][r] * fac, v3 = o[3][r] * fac;
                        if (br > 0) { v0 += pm[0]; v1 += pm[32]; v2 += pm[64]; v3 += pm[96]; }
                        if (br < 2) { pm[0] = v0; pm[32] = v1; pm[64] = v2; pm[96] = v3; }
                        else { pb[0] = (bf16_t)(cvtpk(v0, 0.f) & 0xffffu); pb[32] = (bf16_t)(cvtpk(v1, 0.f) & 0xffffu); pb[64] = (bf16_t)(cvtpk(v2, 0.f) & 0xffffu); pb[96] = (bf16_t)(cvtpk(v3, 0.f) & 0xffffu); } }
                    if ((r & 7) == 7) asm volatile("" ::: "memory"); }
                if (br == 0 && rowvalid && hi == 0) { SC[(hl * 64 + tok) * 2] = sc0 * inv; SC[(hl * 64 + tok) * 2 + 1] = inv; }
            }
            if (br == 0) {
                __syncthreads();
                constexpr int NTOK = SAMPLE ? 4 : 64; const int cur = SAMPLE ? 32 : qb;
                if (tid < NTOK) {
#pragma unroll 1
                    for (int k = 0; k < 32; ++k) { float s = 0.f;
#pragma unroll
                        for (int h = 0; h < 4; ++h) { s += IMPA[(h * 64 + tid) * 33 + k] * SC[(h * 64 + tid) * 2 + (k >> 4)]; if (k > 0) s += IMPB[(h * 64 + tid) * 33 + k - 1] * SC[(h * 64 + tid) * 2 + ((k - 1) >> 4)]; }
                        IMP[tid * 33 + k] = s; }
                    unsigned mask = 0u;
                    if (cur >= 1) { if (cur <= 7) mask = (1u << (cur & 31)) - 1u;
                        else { mask = 1u;
#pragma unroll 1
                            for (int it = 0; it < 6; ++it) { float best = -1.f; int bi = 0;
#pragma unroll 1
                                for (int k = 1; k < cur; ++k) { const float v = IMP[tid * 33 + k]; if (!((mask >> k) & 1u) && v > best) { best = v; bi = k; } }
                                mask |= 1u << bi; } } }
                    SEL[tid] = mask;
#ifdef ATT_CHECK
                    if (!SAMPLE) ((unsigned*)(F.ws + (size_t)1272 * MiB))[(b * 2 + g) * 2048 + qb * 64 + tid] = mask;
#endif
                }
                __syncthreads();
                if (wid == 0) { unsigned v = (lane < NTOK) ? SEL[lane] : 0u;
#pragma unroll
                    for (int off = 1; off < 64; off <<= 1) v |= __shfl_xor(v, off);
                    if (lane == 0) UNI[0] = v; }
                __syncthreads();
                rem = UNI[0]; sel = SEL[tok];
            }
            ++br; step = 0; if (br == 3) break;
            m_reg = -1e30f; l_reg = 0.f;
#pragma unroll
            for (int d = 0; d < 4; ++d)
#pragma unroll
                for (int r = 0; r < 16; ++r) o[d][r] = 0.f;
            have = gen(T); if (have) issue(T);
            continue;
        }
        asm volatile("s_waitcnt lgkmcnt(0)\n\ts_barrier" ::: "memory");
        commit(T);
        Tile TN; const bool have_n = gen(TN);
        if (have_n) issue(TN);
        asm volatile("s_waitcnt lgkmcnt(0)\n\ts_barrier" ::: "memory");
        if (active) {
            f32x16 p0, p1; float mn, al; bf16x8 pa0, pa1, pa2, pa3;
            const bool rowsel = rowvalid && (T.selbit < 0 || ((sel >> T.selbit) & 1u));
            const float bstep = sl_raw * (float)T.kstep, bbase = rowsel ? sl_raw * (float)(T.kp0 + T.kstep * 4 * hi) : -__builtin_inff();
            qkt<SAMPLE>(p0, p1, K_lds, r32, hi, qr, Q_lds, bbase, bstep);
            { const int kpl = T.kp0 + 63 * T.kstep, tlo = SAMPLE ? SEQ : t - r32, thi = tlo + (SAMPLE ? 3 : 31);
              if (kpl > tlo || (T.W < 0x7fffffffu && thi - T.kp0 > (int)T.W)) mask_tile(p0, p1, t - T.kp0 - T.kstep * 4 * hi, T.kstep, T.W, true); }
            partialSM(p0, p1, m_reg, mn, al);
            if (__any(al < 1.f)) { if (hi == 0) al_l[r32] = al; asm volatile("s_waitcnt lgkmcnt(0)" ::: "memory");
#pragma unroll
                for (int d_ = 0; d_ < 4; ++d_)
#pragma unroll
                    for (int r = 0; r < 16; ++r) o[d_][r] *= al_l[crow(r, hi)];
                if (br == 0 && T.n0 > 0) sc0 *= al; }
            if (br == 0 && rowvalid) { const int rowi = (hl * 64 + tok) * 33 + (T.n0 >> 2) + hi;
#pragma unroll
                for (int j = 0; j < 4; ++j) { IMPA[rowi + 2 * j] = (p0[4 * j] + p0[4 * j + 1]) + (p0[4 * j + 2] + p0[4 * j + 3]); IMPB[rowi + 2 * j] = p0[4 * j + 3];
                    IMPA[rowi + 8 + 2 * j] = (p1[4 * j] + p1[4 * j + 1]) + (p1[4 * j + 2] + p1[4 * j + 3]); IMPB[rowi + 8 + 2 * j] = p1[4 * j + 3]; } }
            finishSM(p0, p1, al, l_reg, pa0, pa1, pa2, pa3);
            pv_tile(o, vb0, pa0, pa1, pa2, pa3);
        }
        T = TN; have = have_n;
    }
}
}

#ifdef ATT_CHECK
__device__ __forceinline__ float bfr(float x) { return __uint_as_float(pk2(x, 0.f) << 16); }
__device__ __forceinline__ void att_check(const Frame& F, unsigned char* ldsg) {
    LAS float* L = (LAS float*)ldsg;
    LAS float* Qs = L;
    LAS float* Ss = L + 512;
    LAS float* Oc = L + 512 + 2560;
    LAS float* IMPs = Oc + 1536;
    LAS int* KP = (LAS int*)(IMPs + 32);
    LAS float* RED = (LAS float*)(KP + 640);
    LAS unsigned* MSK = (LAS unsigned*)(RED + 1024);
    const int tid = F.tid, bid = F.bid;
    const int b = bid & 7, g = (bid >> 3) & 1, t = (bid * CHK_MUL + CHK_ADD) & 2047;
    const size_t row = (size_t)b * SEQ + t;
    const bf16_t* Qg = WSP(bf16_t, WS_Q); const bf16_t* KVS = WSP(bf16_t, WS_KVS); const bf16_t* KVWb = WSP(bf16_t, WS_KVW);
    const float* FS = WSP(float, WS_FS); const float* POSB = WSP(float, WS_POSB); const float* GNSA = WSP(float, WS_GNSA); const bf16_t* OB = WSP(bf16_t, WS_OB);
    const float SCL = 0.08838834764831845f;
    __syncthreads();
    { const int h = tid >> 7, d = tid & 127; float qv = bf2f(Qg[row * 1024 + (g * 4 + h) * 128 + d]);
#ifdef CHK_QNOISE
      { unsigned hsh = (unsigned)(row * 1024 + (g * 4 + h) * 128 + d) * 2654435761u; hsh ^= hsh >> 15; hsh *= 2246822519u; hsh ^= hsh >> 13; qv *= 1.0f + CHK_QNOISE * ((float)(hsh & 0xffff) * (1.0f / 32768.0f) - 1.0f); }
#endif
      Qs[h * 128 + d] = qv; }
    __syncthreads();
    const int hh = tid >> 7, dd = tid & 127; const float slope = exp2f(-(float)(g * 4 + hh + 1));
    const float* Fk = FS + (size_t)(256 + b * 2) * 65536; const float* Fv = Fk + 65536;
    const int ncv = t >= 31 ? (t - 31) / 16 + 1 : 0;
    { const int n = dd; float s = -INFINITY;
      if (n < ncv && n <= 126) { float acc = 0.f; for (int d = 0; d < 128; ++d) { const float kc = bfr(Fk[(size_t)(g * 128 + n) * 256 + d] + Fk[(size_t)(g * 128 + n + 1) * 256 + 128 + d] + POSB[d]); acc += Qs[hh * 128 + d] * kc; }
          s = acc * SCL + slope * (float)(16 * n + 31); }
      Ss[hh * 640 + n] = s; }
    __syncthreads();
    if (tid < 4) { float mx = -INFINITY; for (int n = 0; n < 128; ++n) mx = fmaxf(mx, Ss[tid * 640 + n]); float sum = 0.f;
        for (int n = 0; n < 128; ++n) { const float e = (Ss[tid * 640 + n] == -INFINITY) ? 0.f : expf(Ss[tid * 640 + n] - mx); Ss[tid * 640 + n] = e; sum += e; }
        const float inv = 1.0f / fmaxf(sum, 1e-30f); for (int n = 0; n < 128; ++n) Ss[tid * 640 + n] *= inv; }
    __syncthreads();
    { float acc = 0.f; for (int n = 0; n < ncv && n <= 126; ++n) { const float kv = bfr(Fv[(size_t)(g * 128 + n) * 256 + dd] + Fv[(size_t)(g * 128 + n + 1) * 256 + 128 + dd] + POSB[128 + dd]); acc += Ss[hh * 640 + n] * kv; }
      Oc[(0 * 4 + hh) * 128 + dd] = acc; }
    if (tid < 32) { float s = 0.f; for (int h = 0; h < 4; ++h) for (int n = 4 * tid - 1; n <= 4 * tid + 3; ++n) if (n >= 0 && n < 127) s += Ss[h * 640 + n]; IMPs[tid] = s; }
    __syncthreads();
    const int cur = t >> 6;
    if (tid == 0) { unsigned mask = 0u;
        if (cur >= 1) { if (cur <= 7) mask = (1u << cur) - 1u; else { mask = 1u;
            for (int it = 0; it < 6; ++it) { float best = -1.f; int bi = 0; for (int k = 1; k < cur; ++k) { const float v = IMPs[k]; if (!((mask >> k) & 1u) && v > best) { best = v; bi = k; } } mask |= 1u << bi; } } }
        const unsigned kmask = ((const unsigned*)(F.ws + (size_t)1272 * MiB))[(b * 2 + g) * 2048 + t];
        MSK[2] = (kmask != mask) ? 1u : 0u;
#if CHK_USE_KMASK
        mask = kmask;
#endif
        int nk = 0; for (int k = 0; k < 32; ++k) if ((mask >> k) & 1u) for (int i = 0; i < 64; ++i) KP[nk++] = k * 64 + i;
        for (int s = cur * 64; s <= t; ++s) KP[nk++] = s;
        MSK[0] = mask; MSK[1] = (unsigned)nk; }
    __syncthreads();
    for (int br = 1; br <= 2; ++br) {
        const bf16_t* KV = (br == 1) ? KVS : KVWb; const int wl = t - 512 > 0 ? t - 512 : 0; const int nk = (br == 1) ? (int)MSK[1] : t - wl + 1;
        __syncthreads();
        for (int j = dd; j < 640; j += 128) { float s = -INFINITY;
            if (j < nk) { const int kp = (br == 1) ? KP[j] : wl + j; const bf16_t* kr = KV + ((size_t)b * SEQ + kp) * 512 + g * 128; float acc = 0.f; for (int d = 0; d < 128; ++d) acc += Qs[hh * 128 + d] * bf2f(kr[d]);
                s = acc * SCL + slope * (float)kp; }
            Ss[hh * 640 + j] = s; }
        __syncthreads();
        if (tid < 4) { float mx = -INFINITY; for (int n = 0; n < 640; ++n) mx = fmaxf(mx, Ss[tid * 640 + n]); float sum = 0.f;
            for (int n = 0; n < 640; ++n) { const float e = (Ss[tid * 640 + n] == -INFINITY) ? 0.f : expf(Ss[tid * 640 + n] - mx); Ss[tid * 640 + n] = e; sum += e; }
            const float inv = 1.0f / fmaxf(sum, 1e-30f); for (int n = 0; n < 640; ++n) Ss[tid * 640 + n] *= inv; }
        __syncthreads();
        { float acc = 0.f; for (int j = 0; j < nk; ++j) { const int kp = (br == 1) ? KP[j] : wl + j; acc += Ss[hh * 640 + j] * bf2f(KV[((size_t)b * SEQ + kp) * 512 + 256 + g * 128 + dd]); }
          Oc[(br * 4 + hh) * 128 + dd] = acc; }
    }
    __syncthreads();
    { const int head = g * 4 + hh; float ref = 0.f; for (int br = 0; br < 3; ++br) ref += GNSA[row * 32 + br * 8 + head] * Oc[(br * 4 + hh) * 128 + dd];
      const float mine = bf2f(OB[row * 1024 + head * 128 + dd]); RED[tid] = (mine - ref) * (mine - ref); RED[512 + tid] = ref * ref; }
    __syncthreads();
    if (tid == 0) { float e2 = 0.f, r2 = 0.f; for (int i = 0; i < 512; ++i) { e2 += RED[i]; r2 += RED[512 + i]; }
#if CHK_SELONLY
        if (MSK[2]) {
#else
        if (e2 > CHK_TOL * r2) {
#endif
          const float v = CHK_VEXPR;
            F.out[O_PRH + bid] = v; } }
}
#endif

#ifndef P7_ROWS
#define P7_ROWS 16
#endif
__device__ __forceinline__ void p7_act(const Frame& F) {
    const bf16_t* GB = WSP(bf16_t, WS_GB); const bf16_t* UB = WSP(bf16_t, WS_UB); bf16_t* ACT = WSP(bf16_t, WS_ACT);
    const int gt = F.bid * 512 + F.tid, NT = F.G * 512;
    for (int idx = gt; idx < (M / P7_ROWS) * 768; idx += NT) { const int cgp = idx % 768, r0 = (idx / 768) * P7_ROWS, c = cgp * 8; const bool samp = r0 >= MP;
        float w0[8], w1[8], w2[8], bb[8], g2[8], g1[8];
#pragma unroll
        for (int e = 0; e < 8; e += 4) { const f32x4 a = *(const f32x4*)(F.fconv_w + c + e), b4 = *(const f32x4*)(F.fconv_w + DFF + c + e), c4 = *(const f32x4*)(F.fconv_w + 2 * DFF + c + e), d4 = *(const f32x4*)(F.fconv_b + c + e);
#pragma unroll
            for (int j = 0; j < 4; ++j) { w0[e + j] = a[j]; w1[e + j] = b4[j]; w2[e + j] = c4[j]; bb[e + j] = d4[j]; } }
        if (!samp && (r0 & 2047) != 0) { const u32x4 a = *(const u32x4*)(GB + (size_t)(r0 - 2) * DFF + c), b4 = *(const u32x4*)(GB + (size_t)(r0 - 1) * DFF + c);
            g2[0] = bflo(a.x); g2[1] = bfhi(a.x); g2[2] = bflo(a.y); g2[3] = bfhi(a.y); g2[4] = bflo(a.z); g2[5] = bfhi(a.z); g2[6] = bflo(a.w); g2[7] = bfhi(a.w);
            g1[0] = bflo(b4.x); g1[1] = bfhi(b4.x); g1[2] = bflo(b4.y); g1[3] = bfhi(b4.y); g1[4] = bflo(b4.z); g1[5] = bfhi(b4.z); g1[6] = bflo(b4.w); g1[7] = bfhi(b4.w); }
        else {
#pragma unroll
            for (int e = 0; e < 8; ++e) { g2[e] = 0.f; g1[e] = 0.f; } }
#pragma unroll 4
        for (int i = 0; i < P7_ROWS; ++i) { const int r = r0 + i;
            if (samp && (i & 3) == 0) { const int db = (r - MP) >> 2; const float* sp = F.st_ffn + (size_t)db * 2 * DFF + c;
                const f32x4 a = *(const f32x4*)sp, a2 = *(const f32x4*)(sp + 4), b4 = *(const f32x4*)(sp + DFF), b5 = *(const f32x4*)(sp + DFF + 4);
#pragma unroll
                for (int j = 0; j < 4; ++j) { g2[j] = a[j]; g2[4 + j] = a2[j]; g1[j] = b4[j]; g1[4 + j] = b5[j]; } }
            const u32x4 gw = *(const u32x4*)(GB + (size_t)r * DFF + c), uw = *(const u32x4*)(UB + (size_t)r * DFF + c);
            float g0[8], uu[8], ov[8];
            g0[0] = bflo(gw.x); g0[1] = bfhi(gw.x); g0[2] = bflo(gw.y); g0[3] = bfhi(gw.y); g0[4] = bflo(gw.z); g0[5] = bfhi(gw.z); g0[6] = bflo(gw.w); g0[7] = bfhi(gw.w);
            uu[0] = bflo(uw.x); uu[1] = bfhi(uw.x); uu[2] = bflo(uw.y); uu[3] = bfhi(uw.y); uu[4] = bflo(uw.z); uu[5] = bfhi(uw.z); uu[6] = bflo(uw.w); uu[7] = bfhi(uw.w);
#pragma unroll
            for (int e = 0; e < 8; ++e) { const float pre = bb[e] + w0[e] * g2[e] + w1[e] * g1[e] + w2[e] * g0[e]; ov[e] = gelu_tanh(pre) * uu[e]; g2[e] = g1[e]; g1[e] = g0[e]; }
            u32x4 o; o.x = pk2(ov[0], ov[1]); o.y = pk2(ov[2], ov[3]); o.z = pk2(ov[4], ov[5]); o.w = pk2(ov[6], ov[7]);
            *(u32x4*)(ACT + (size_t)r * DFF + c) = o; } }
}
#ifndef ROWSC
#define ROWSC(m) 1.0f
#endif
__device__ __forceinline__ void p9_final(const Frame& F) {
    const int gw = F.bid * 8 + F.wave, NGW = F.G * 8, lane = F.lane; const float* SS = WSP(float, WS_SS3);
    f32x4 gv[8];
#pragma unroll
    for (int j = 0; j < 8; ++j) gv[j] = ((const f32x4*)F.norm_final)[lane + 64 * j];
    if (F.wave < 2) for (int s = F.wave * F.G + F.bid; s < MS; s += 2 * F.G) { const int m = MP + s; f32x4* row = (f32x4*)(F.out + (size_t)m * DM);
            const bf16_t* xb = WSP(bf16_t, WS_XB2) + (size_t)m * DM; const float* sl = WSP(float, WS_SLAB) + (size_t)(m - MP) * DM; f32x4 v[8]; float ss = 0.f;
#pragma unroll
            for (int j = 0; j < 8; ++j) { const u32x2 xw = *((const u32x2*)xb + lane + 64 * j); f32x4 a = {bflo(xw.x), bfhi(xw.x), bflo(xw.y), bfhi(xw.y)};
#pragma unroll 4
                for (int ks = 0; ks < 16; ++ks) a += *((const f32x4*)(sl + (size_t)ks * MS * DM) + lane + 64 * j);
                v[j] = a; ss += (a.x * a.x + a.y * a.y) + (a.z * a.z + a.w * a.w); }
            const float rs = 1.0f / sqrtf(wave_sum(ss) * (1.0f / DM) + EPS);
#pragma unroll
            for (int j = 0; j < 8; ++j) row[lane + 64 * j] = v[j] * (rs * SC_YS) * gv[j]; }
    { int m = gw; f32x4 cur[8]; float cs = 0.f;
      if (m < MP) { const f32x4* row = (const f32x4*)(F.out + (size_t)m * DM);
#pragma unroll
          for (int j = 0; j < 8; ++j) cur[j] = row[lane + 64 * j];
          cs = lane < 32 ? SS[(size_t)m * 32 + lane] : 0.f; }
#pragma unroll 1
      for (; m < MP; m += NGW) { const int mn = (m + NGW) < MP ? (m + NGW) : m; const f32x4* rown = (const f32x4*)(F.out + (size_t)mn * DM); f32x4 nx[8];
#pragma unroll
          for (int j = 0; j < 8; ++j) nx[j] = rown[lane + 64 * j];
          const float ns = lane < 32 ? SS[(size_t)mn * 32 + lane] : 0.f;
          const float rs = 1.0f / sqrtf(wave_sum(cs) * (1.0f / DM) + EPS); f32x4* row = (f32x4*)(F.out + (size_t)m * DM);
#pragma unroll
          for (int j = 0; j < 8; ++j) row[lane + 64 * j] = cur[j] * (rs * SC_YP * ROWSC(m)) * gv[j];
#pragma unroll
          for (int j = 0; j < 8; ++j) cur[j] = nx[j];
          cs = ns; } }
}

#ifndef PG_SP2
#define PG_SP2 true
#endif
#ifndef PG_ALIGN
#define PG_ALIGN true
#endif
__global__ void __launch_bounds__(512, 2) fwd(Args args) {
    extern __shared__ __attribute__((aligned(16))) unsigned char lds[];
    Frame F;
    F.tid = threadIdx.x; F.lane = F.tid & 63; F.wave = __builtin_amdgcn_readfirstlane(F.tid >> 6); F.G = gridDim.x; F.bid = blockIdx.x;
    F.x_p = (const float*)args.in[0]; F.x_s = (const float*)args.in[1]; F.c_cmp = (const float*)args.in[2]; F.c_slc = (const float*)args.in[3]; F.c_win = (const float*)args.in[4];
    F.st_h = (const float*)args.in[5]; F.st_conv = (const float*)args.in[6]; F.st_ffn = (const float*)args.in[7]; F.pt = (const int*)args.in[8];
    F.norm_mix = (const float*)args.in[9]; F.w_in = (const float*)args.in[10]; F.rconv_w = (const float*)args.in[11]; F.rconv_b = (const float*)args.in[12];
    F.rwa = (const float*)args.in[13]; F.rba = (const float*)args.in[14]; F.rwx = (const float*)args.in[15]; F.rbx = (const float*)args.in[16]; F.rlam = (const float*)args.in[17];
    F.cmp_w = (const float*)args.in[18]; F.cmp_pos = (const float*)args.in[19]; F.w_pr = (const float*)args.in[20]; F.w_pa = (const float*)args.in[21]; F.w_out = (const float*)args.in[22];
    F.norm_ffn = (const float*)args.in[23]; F.w_gate = (const float*)args.in[24]; F.w_up = (const float*)args.in[25]; F.fconv_w = (const float*)args.in[26]; F.fconv_b = (const float*)args.in[27];
    F.w_down = (const float*)args.in[28]; F.norm_final = (const float*)args.in[29];
    F.out = args.out; F.ws = args.ws;
    LAS unsigned char* ldsl = (LAS unsigned char*)lds;
    volatile LAS unsigned* MISC = (volatile LAS unsigned*)(ldsl + MISC_OFF);
    if (F.tid < 32) MISC[F.tid] = 0u;
    __syncthreads();
    const int lo = args.ph_lo, hi = args.ph_hi;
    const bool multi = (hi - lo) > 1;
    XcdBarrier bar; bar.bar = (unsigned*)(F.ws + WS_CTL) + CW_BAR; bar.x = 0; bar.st = nullptr;
    if (multi) bar = xcd_barrier_post((unsigned*)(F.ws + WS_CTL) + CW_BAR, MISC + 8);
#ifndef PH_MASK
#define PH_MASK 0xfff
#endif
#define IN(k) (((PH_MASK >> (k)) & 1) && lo <= (k) && (k) < hi)
#ifndef SEAM_REP
#define SEAM_REP 1
#endif
#define SEAM(k) do { if (IN(k) && IN((k) + 1)) { for (int rep_ = 0; rep_ < SEAM_REP; ++rep_) xcd_barrier(bar); } } while (0)

    #ifdef REPEAT_P0SKIP
    if (IN(0)) { p0_prologue(F, lds, args.qhi < 0 ? args.qlo : 0); } SEAM(0);
#else
    if (IN(0)) { p0_prologue(F, lds, 0); } SEAM(0);
#endif
        const int P1_BUSY = ((M / 256) * (N1 / 256)) % F.G;
    const int NEARLY = P1_BUSY > 0 ? ((F.G - P1_BUSY) < 256 ? (F.G - P1_BUSY) : 256) : 0;
    const int NCMP2 = NCU_UNITS - NEARLY;
#ifdef REPEAT_LD
    const int ld1 = (args.qhi < 0 && args.qlo > 0) ? args.qlo : DM;
#else
    constexpr int ld1 = DM;
#endif
    if (IN(1)) { pg8::Gemm g{WSP(bf16_t, WS_XB), WSP(bf16_t, WS_W1T), M, N1, DM, ld1, ld1};
#ifdef REPEAT_SWAPBUF
        if (args.qhi < 0) { g.A = WSP(bf16_t, WS_XB2); g.Bt = WSP(bf16_t, WS_WG); }
#endif
 pg8::StaticOrder S; S.init(M, N1, F.G, F.bid);
#ifdef REPEAT_WGM
        if (args.qhi < 0) S.wgm = REPEAT_WGM;
#endif

        EpiIn E{WSP(float, WS_RSTD1), WSP(bf16_t, WS_XR), WSP(bf16_t, WS_GG), WSP(bf16_t, WS_Q), WSP(bf16_t, WS_KVS), WSP(bf16_t, WS_KVW), WSP(bf16_t, WS_CC), WSP(bf16_t, WS_SGM), WSP(float, WS_GNSA), F.out, args.qhi < 0, (LAS float*)(ldsl + XL_OFF) + 1024};
        pg8::gemm_phase<EpiIn, pg8::StaticOrder, PG_ALIGN, PG_SP2>(ldsl, g, S, E);
        if (F.bid >= P1_BUSY && NEARLY > 0) {
            pg8::Gemm gc{WSP(bf16_t, WS_CC), WSP(bf16_t, WS_WC), NCU_UNITS * 256, 512, 2048, 2048, 2048}; CmpOrder Sc{NEARLY, F.bid - P1_BUSY, 0, NEARLY}; EpiFS Ec{WSP(float, WS_FS)};
            pg8::gemm_phase<EpiFS, CmpOrder, PG_ALIGN, PG_SP2>(ldsl, gc, Sc, Ec); } } SEAM(1);

#ifdef REPEAT_P2SKIP
    const int p2skip = args.qhi < 0 ? args.qlo : 0;
#else
    constexpr int p2skip = 0;
#endif
    if (IN(2)) {
        { LAS float* red = (LAS float*)(ldsl + XL_OFF);
          for (int e = F.bid; e < 256; e += F.G) { float s = 0.f; for (int w = F.tid; w < F.G; w += 512) s += WSP(float, WS_POSP)[w * 256 + e];
              s = wave_sum(s); if (F.lane == 0) red[F.wave] = s; __syncthreads();
              if (F.tid == 0) WSP(float, WS_POSB)[e] = ((red[0] + red[1]) + (red[2] + red[3])) + ((red[4] + red[5]) + (red[6] + red[7])); __syncthreads(); } }
        if (!(p2skip & 1)) { pg8::Gemm g{WSP(bf16_t, WS_CC), WSP(bf16_t, WS_WC), NCU_UNITS * 256, 512, 2048, 2048, 2048}; CmpOrder S{F.G, F.bid, NEARLY, NCMP2}; EpiFS E{WSP(float, WS_FS)};
          pg8::gemm_phase<EpiFS, CmpOrder, PG_ALIGN, PG_SP2>(ldsl, g, S, E); }
        if (!(p2skip & 2)) for (int u = F.bid; u < 256; u += F.G) rglru_prompt_unit(F, u, lds);
        if (!(p2skip & 4)) for (int u = 256 + (F.G - 1 - F.bid); u < 384; u += F.G) rglru_unit(F, u, lds);
        __syncthreads(); if (!(p2skip & 8)) tr_deferred(F, lds, TR_A1, TR_A2 + TR_GDEF, NCMP2, F.G); } SEAM(2);
    if (IN(3)) {
        unsigned* qhead = (unsigned*)(F.ws + WS_CTL) + CW_QUEUE;
        for (;;) {
            if (F.tid == 0) MISC[16] = __hip_atomic_fetch_add(qhead, 1u, __ATOMIC_RELAXED, __HIP_MEMORY_SCOPE_AGENT);
            __syncthreads(); const int u = args.qlo + (int)MISC[16]; __syncthreads();
            if (u >= args.qhi) break;
            if (u < 512 && (u & 1)) att::attn_unit<true>(F, u >> 1, lds);
            else { const int gg = u < 512 ? 1 : 0, pp = u < 512 ? (u >> 1) : u - 512, qb = 31 - (pp >> 3), bb = pp & 7; att::attn_unit<false>(F, (31 - qb) * 16 + bb * 2 + gg, lds); } } } SEAM(3);
    if (IN(4)) { pg8::StaticOrder S; S.init(MP, DM, F.G, F.bid);
#ifdef PROJ_MERGED
        { pg8::Gemm g{WSP(bf16_t, WS_Y), WSP(bf16_t, WS_WPR), MP, DM, 2048, 1024, 1024, WSP(bf16_t, WS_OB), WSP(bf16_t, WS_WPA)}; EpiProjM E{WSP(bf16_t, WS_SGM), WSP(bf16_t, WS_MB)}; pg8::gemm_phase<EpiProjM, pg8::StaticOrder, PG_ALIGN, PG_SP2>(ldsl, g, S, E); }
#else
        { pg8::Gemm g{WSP(bf16_t, WS_Y), WSP(bf16_t, WS_WPR), MP, DM, 1024, 1024, 1024}; EpiProj<0> E{WSP(bf16_t, WS_SGM), WSP(bf16_t, WS_T1), WSP(bf16_t, WS_MB)}; pg8::gemm_phase<EpiProj<0>, pg8::StaticOrder, PG_ALIGN, PG_SP2>(ldsl, g, S, E); }
        { pg8::Gemm g{WSP(bf16_t, WS_OB), WSP(bf16_t, WS_WPA), MP, DM, 1024, 1024, 1024}; EpiProj<1> E{WSP(bf16_t, WS_SGM), WSP(bf16_t, WS_T1), WSP(bf16_t, WS_MB)}; pg8::gemm_phase<EpiProj<1>, pg8::StaticOrder, PG_ALIGN, PG_SP2>(ldsl, g, S, E); }
#endif
        { pg8::Gemm g{WSP(bf16_t, WS_Y), WSP(bf16_t, WS_WPR), 2 * M, DM, 256, 1024, 1024}; SplitOrder T{F.G, F.bid, 8, 256, 1}; EpiSlab<1> E{WSP(float, WS_SLAB2), 256, WSP(bf16_t, WS_SGM)};
          pg8::gemm_phase<EpiSlab<1>, SplitOrder, PG_ALIGN, PG_SP2>(ldsl, g, T, E); } } SEAM(4);
    if (IN(5)) {
        const int gt = F.bid * 512 + F.tid, NT = F.G * 512; const float* sl = WSP(float, WS_SLAB2); bf16_t* MB = WSP(bf16_t, WS_MB);
        for (int i = gt; i < MS * 256; i += NT) { const size_t o = (size_t)i * 8; f32x4 a = *(const f32x4*)(sl + o), b4 = *(const f32x4*)(sl + o + 4);
#pragma unroll
            for (int s = 1; s < 8; ++s) { a += *(const f32x4*)(sl + (size_t)s * MS * DM + o); b4 += *(const f32x4*)(sl + (size_t)s * MS * DM + o + 4); }
            *(u32x4*)(MB + (size_t)MP * DM + o) = pack8u(a, b4); } } SEAM(5);
    if (IN(6)) { { pg8::Gemm g{WSP(bf16_t, WS_MB), WSP(bf16_t, WS_WO), MP, DM, DM, DM, DM}; pg8::StaticOrder S; S.init(MP, DM, F.G, F.bid);
          EpiOut E{WSP(bf16_t, WS_XB), WSP(bf16_t, WS_XB2), WSP(float, WS_SS2)}; pg8::gemm_phase<EpiOut, pg8::StaticOrder, PG_ALIGN, PG_SP2>(ldsl, g, S, E); }
        { pg8::Gemm g{WSP(bf16_t, WS_MB), WSP(bf16_t, WS_WO), M, DM, 256, DM, DM}; SplitOrder T{F.G, F.bid, 8, 256, 0}; EpiSlab<0> E{WSP(float, WS_SLAB2), 256, nullptr};
          pg8::gemm_phase<EpiSlab<0>, SplitOrder, PG_ALIGN, PG_SP2>(ldsl, g, T, E); } } SEAM(6);
    if (IN(7)) {
        const int gw = F.bid * 8 + F.wave, NGW = F.G * 8, lane = F.lane; const float* sl = WSP(float, WS_SLAB2); const bf16_t* XB = WSP(bf16_t, WS_XB); bf16_t* XB2 = WSP(bf16_t, WS_XB2); float* SS = WSP(float, WS_SS2);
        for (int it = gw; it < MS * 4; it += NGW) { const int r = it >> 2, q = it & 3; const size_t o = (size_t)r * DM + q * 512 + lane * 8; const u32x4 xw = *(const u32x4*)(XB + (size_t)MP * DM + o);
            f32x4 a = {bflo(xw.x), bfhi(xw.x), bflo(xw.y), bfhi(xw.y)}, b4 = {bflo(xw.z), bfhi(xw.z), bflo(xw.w), bfhi(xw.w)};
#pragma unroll
            for (int s = 0; s < 8; ++s) { a += *(const f32x4*)(sl + (size_t)s * MS * DM + o); b4 += *(const f32x4*)(sl + (size_t)s * MS * DM + o + 4); }
            *(u32x4*)(XB2 + (size_t)MP * DM + o) = pack8u(a, b4);
            float ss = (a.x * a.x + a.y * a.y) + (a.z * a.z + a.w * a.w) + (b4.x * b4.x + b4.y * b4.y) + (b4.z * b4.z + b4.w * b4.w); ss = wave_sum(ss);
            if (lane < 8) SS[(size_t)(MP + r) * 32 + q * 8 + lane] = lane == 0 ? ss : 0.f; } } SEAM(7);
    if (IN(8)) { pg8::Gemm g{WSP(bf16_t, WS_XB2), WSP(bf16_t, WS_WG), M, 2 * DFF, DM, DM, DM}; pg8::StaticOrder S; S.init(M, 2 * DFF, F.G, F.bid);
        EpiFFN E{WSP(float, WS_SS2), F.fconv_w, F.fconv_b, F.st_ffn, WSP(bf16_t, WS_ACT), F.out, WSP(float, WS_GE), WSP(float, WS_G0), WSP(float, WS_U0), (LAS float*)(ldsl + XL_OFF), args.qhi < 0};
        pg8::gemm_phase<EpiFFN, pg8::StaticOrder, PG_ALIGN, PG_SP2>(ldsl, g, S, E);
        tr_deferred(F, lds, TR_A3, TR_A4, S.nwg % F.G, F.G); } SEAM(8);

    if (IN(9)) { const int gt = F.bid * 512 + F.tid, NT = F.G * 512; const float* GE = WSP(float, WS_GE); const float* G0 = WSP(float, WS_G0); const float* U0 = WSP(float, WS_U0); bf16_t* ACT = WSP(bf16_t, WS_ACT);
        for (int i = gt; i < 64 * 2 * 768; i += NT) { const int f = (i % 768) * 8, rr = (i / 768) & 1, pm = i / (2 * 768); if ((pm & 7) == 0) continue;
            const float* a0 = GE + ((size_t)(pm - 1) * 2 + 0) * DFF + f; const float* a1 = a0 + DFF; const float* b0 = G0 + ((size_t)pm * 2 + 0) * DFF + f; const float* b1 = b0 + DFF; const float* up = U0 + ((size_t)pm * 2 + rr) * DFF + f;
            float ov[8];
#pragma unroll
            for (int h = 0; h < 2; ++h) { const f32x4 gm2 = *(const f32x4*)(a0 + 4 * h), gm1 = *(const f32x4*)(a1 + 4 * h), g0 = *(const f32x4*)(b0 + 4 * h), g1 = *(const f32x4*)(b1 + 4 * h), uv = *(const f32x4*)(up + 4 * h);
                const f32x4 w0 = *(const f32x4*)(F.fconv_w + f + 4 * h), w1 = *(const f32x4*)(F.fconv_w + DFF + f + 4 * h), w2 = *(const f32x4*)(F.fconv_w + 2 * DFF + f + 4 * h), bb = *(const f32x4*)(F.fconv_b + f + 4 * h);
                const f32x4 pre = rr == 0 ? bb + w0 * gm2 + w1 * gm1 + w2 * g0 : bb + w0 * gm1 + w1 * g0 + w2 * g1;
#pragma unroll
                for (int j = 0; j < 4; ++j) ov[4 * h + j] = gelu_tanh(pre[j]) * uv[j]; }
            u32x4 o; o.x = pk2(ov[0], ov[1]); o.y = pk2(ov[2], ov[3]); o.z = pk2(ov[4], ov[5]); o.w = pk2(ov[6], ov[7]);
            *(u32x4*)(ACT + (size_t)(pm * 256 + rr) * DFF + f) = o; } } SEAM(9);
    if (IN(10)) { { pg8::Gemm g{WSP(bf16_t, WS_ACT), WSP(bf16_t, WS_WD), MP, DM, DFF, DFF, DFF}; pg8::StaticOrder S; S.init(MP, DM, F.G, F.bid);
          EpiDown E{WSP(bf16_t, WS_XB2), F.out, WSP(float, WS_SS3), args.qhi < 0}; pg8::gemm_phase<EpiDown, pg8::StaticOrder, PG_ALIGN, PG_SP2>(ldsl, g, S, E); }
        { pg8::Gemm g{WSP(bf16_t, WS_ACT), WSP(bf16_t, WS_WD), M, DM, 384, DFF, DFF}; SplitOrder S{F.G, F.bid, 16, 384, 0}; EpiSlab<0> E{WSP(float, WS_SLAB), 384, nullptr};
          pg8::gemm_phase<EpiSlab<0>, SplitOrder, PG_ALIGN, PG_SP2>(ldsl, g, S, E); } } SEAM(10);
    if (IN(11)) { p9_final(F); }
#ifdef ATT_CHECK
    if (lo <= 12 && 12 < hi) att_check(F, lds);
#endif
#ifdef PROBE
    if (lo <= 12 && 12 < hi) {
        const int gt = F.bid * 512 + F.tid, NT = F.G * 512;
        const bf16_t* P1 = WSP(bf16_t, PROBE_A); const bf16_t* P2 = WSP(bf16_t, PROBE_B);
        for (size_t i = gt; i < (size_t)M * 1024; i += NT) { const size_t r = i >> 10, c = i & 1023; F.out[r * DM + c] = bf2f(P1[(size_t)r * PROBE_LDA + c]); F.out[r * DM + 1024 + c] = bf2f(P2[(size_t)r * PROBE_LDB + c]); }
        for (size_t i = gt; i < (size_t)NBATCH * 2 * DFF; i += NT) F.out[O_PFC + i] = 0.f;
        for (size_t i = gt; i < (size_t)DBATCH * 2 * DFF; i += NT) F.out[O_SFC + i] = 0.f;
    }
#endif
#undef IN
#undef SEAM
}

extern "C" void kernel_launch(void* const* d_in, const int* in_sizes, int n_in, void* d_out, int out_size, void* d_ws, size_t ws_size, hipStream_t stream) {
    static int grid = 0;
    if (grid == 0) {
        if (n_in != 30 || (size_t)out_size != O_END || ws_size < WS_END) { fprintf(stderr, "kernel_launch: unexpected shapes: n_in %d out %d (want %zu) ws %zu (want %zu)\n", n_in, out_size, (size_t)O_END, ws_size, (size_t)WS_END); grid = -1; return; }
        int dev = 0, cus = 0, per_cu = 0;
        if (hipGetDevice(&dev) != hipSuccess || hipDeviceGetAttribute(&cus, hipDeviceAttributeMultiprocessorCount, dev) != hipSuccess) { grid = -1; return; }
        if (hipFuncSetAttribute((const void*)fwd, hipFuncAttributeMaxDynamicSharedMemorySize, LDS_BYTES) != hipSuccess) { fprintf(stderr, "kernel_launch: hipFuncSetAttribute failed\n"); grid = -1; return; }
        if (hipOccupancyMaxActiveBlocksPerMultiprocessor(&per_cu, (const void*)fwd, 512, LDS_BYTES) != hipSuccess || per_cu < 1) fprintf(stderr, "kernel_launch: occupancy query reports %d\n", per_cu);
        (void)hipGetLastError();
        grid = cus;
    }
    if (grid < 0) return;
    if (hipMemsetAsync((char*)d_ws + WS_CTL, 0, CTL_ZERO_BYTES, stream) != hipSuccess) return;
    Args a{};
    for (int i = 0; i < 30; ++i) a.in[i] = d_in[i];
    a.out = (float*)d_out; a.ws = (unsigned char*)d_ws; a.qlo = 0; a.qhi = 768;
#if MK_ONE_LAUNCH
    a.ph_lo = 0; a.ph_hi = NPHASE;
    hipLaunchKernelGGL(fwd, dim3(grid), dim3(512), LDS_BYTES, stream, a);
#else
#if defined(ATT_CHECK)
    for (int q = 0; q < NPHASE + 1; ++q) { const int p = q < 4 ? q : (q == 4 ? 12 : q - 1); a.ph_lo = p; a.ph_hi = p + 1; hipLaunchKernelGGL(fwd, dim3(grid), dim3(512), LDS_BYTES, stream, a); }
#elif defined(PROBE)
    for (int p = 0; p < NPHASE + 1; ++p) { a.ph_lo = p; a.ph_hi = p + 1; hipLaunchKernelGGL(fwd, dim3(grid), dim3(512), LDS_BYTES, stream, a); }
#else
    for (int p = 0; p < NPHASE; ++p) { a.ph_lo = p; a.ph_hi = p + 1; hipLaunchKernelGGL(fwd, dim3(grid), dim3(512), LDS_BYTES, stream, a);
#ifdef REPEAT_PH
#ifndef REPEAT_SKIP
#define REPEAT_SKIP 0
#endif
#ifndef REPEAT_QLO
#define REPEAT_QLO 0
#define REPEAT_QHI 768
#endif
        if (p == REPEAT_PH) { if (p == 1 || p == 8 || p == 10) a.qhi = REPEAT_SKIP ? -1 : 768;
#ifdef REPEAT_LD
            if (p == 1) a.qlo = REPEAT_LD;
#endif
#ifdef REPEAT_P0SKIP
            if (p == 0) { a.qhi = -1; a.qlo = REPEAT_P0SKIP; }
#endif
#ifdef REPEAT_P2SKIP
            if (p == 2) { a.qhi = -1; a.qlo = REPEAT_P2SKIP; }
#endif
 if (p == 3) { (void)hipMemsetAsync((char*)d_ws + WS_CTL + CW_QUEUE * 4, 0, 4, stream); a.qlo = REPEAT_QLO; a.qhi = REPEAT_QHI; } hipLaunchKernelGGL(fwd, dim3(grid), dim3(512), LDS_BYTES, stream, a); a.qlo = 0; a.qhi = 768; }
#endif
    }
#endif
#endif
}
```

```cpp
#include <hip/hip_runtime.h>
#include <cstdio>
#include <cstdint>
#define MK_ONE_LAUNCH 1
#define PROJ_MERGED 1
namespace pg8 {
#define PG8_LAS __attribute__((address_space(3)))
typedef unsigned short bf16_t;
typedef short bf16x8 __attribute__((ext_vector_type(8)));
typedef float f32x4 __attribute__((ext_vector_type(4)));
typedef unsigned u32x4 __attribute__((ext_vector_type(4)));
constexpr int BM = 256, BK = 64, HALF = 128, HTB = HALF * BK * 2  , STAGE_BYTES = 8 * HTB, NXCD = 8, WGM = 8;

__host__ __device__ __forceinline__ int lds_byte(int r, int c) { const int st = (r >> 4) * 2 + (c >> 5), rr = r & 15, cc = c & 31, ob = rr * 64 + cc * 2; return st * 1024 + (ob ^ (((ob >> 9) & 1) << 5)); }
__host__ __device__ __forceinline__ void stage_rc(int b, int& R, int& C) { const int st = b / 1024, sb = b % 1024, swz = sb ^ (((sb >> 9) & 1) << 5); R = (st >> 1) * 16 + swz / 64; C = (st & 1) * 32 + (swz % 64) / 2; }
__host__ __device__ __forceinline__ int perm32(int rho) { const int n = rho >> 4, i = rho & 15; return 8 * (i >> 2) + 4 * n + (i & 3); }

struct Unit { int pm, pn, ko; };
struct Gemm { const bf16_t* A; const bf16_t* Bt; int M, N, K, lda, ldb; const bf16_t* A2 = nullptr; const bf16_t* Bt2 = nullptr; };

struct StaticOrder {
    int nM, nN, nwg, G, c, wgm;
    __host__ __device__ void init(int M, int N, int G_, int c_, int wgm_ = WGM) { nM = M / BM; nN = N / BM; nwg = nM * nN; G = G_; c = c_; wgm = wgm_; }
    __host__ __device__ bool next(int i, Unit& u) const {
        const long L = (long)i * G + c; if (L >= nwg) return false;
        int wgid = (int)L; { const int q = nwg / NXCD, r = nwg % NXCD, xcd = wgid % NXCD, off = wgid / NXCD; wgid = (xcd < r ? xcd * (q + 1) : r * (q + 1) + (xcd - r) * q) + off; }
        const int nig = wgm * nN, gid = wgid / nig, fm = gid * wgm, gsz = (nM - fm) < wgm ? (nM - fm) : wgm;
        u.pm = fm + ((wgid % nig) % gsz); u.pn = (wgid % nig) / gsz; u.ko = 0; return true;
    }
    __device__ __forceinline__ void a_ready(const Unit&) const {}
    __device__ __forceinline__ void done(const Unit&) const {}
};
typedef __bf16 bf16x2n_t __attribute__((ext_vector_type(2)));
typedef float f32x2n_t __attribute__((ext_vector_type(2)));
__device__ __forceinline__ unsigned cvt_pk_bf16(float lo, float hi) { const f32x2n_t f = {lo, hi}; return __builtin_bit_cast(unsigned, __builtin_convertvector(f, bf16x2n_t)); }
template <class Epi, class Sched, bool ALIGN_EPI = false, bool SP2 = false>
__device__ __forceinline__ void gemm_phase(PG8_LAS unsigned char* lds, const Gemm g, const Sched& S, const Epi& E) {
    const int tid = threadIdx.x, wid = __builtin_amdgcn_readfirstlane(tid >> 6), lane = tid & 63, wr = wid >> 2, wc = wid & 3, fr = lane & 15, fq = lane >> 4;
    const int K = g.K, nt = K / BK;
    unsigned voffA[2], voffB[2];
#pragma unroll
    for (int i = 0; i < 2; ++i) { int R, C; stage_rc(tid * 16 + i * 8192, R, C); const int Rb = Epi::PERM ? ((R & ~31) + perm32(R & 31)) : R;
        voffA[i] = (unsigned)(R * g.lda + C) * 2u; voffB[i] = (unsigned)(Rb * g.ldb + C) * 2u; }
    const size_t kstep = (size_t)(BK * 2);
    const size_t hstepA = (size_t)HALF * g.lda * 2, hstepB = (size_t)HALF * g.ldb * 2;
    const size_t tstepA = 2 * hstepA, tstepB = 2 * hstepB;
    const unsigned ldsw = (unsigned)wid * 1024u;
    const int aoff = lds_byte(wr * 64 + fr, fq * 8), boff = lds_byte(wc * 32 + fr, fq * 8);
#define PG8_SA(b, h) (((b) * 2 + (h)) * HTB)
#define PG8_SB(b, h) ((4 + (b) * 2 + (h)) * HTB)
#define PG8_STAGE(bufoff, gbase, voff) do { _Pragma("unroll") for (int _i = 0; _i < 2; ++_i) \
        __builtin_amdgcn_global_load_lds((const unsigned*)((const char*)(gbase) + (voff)[_i]), (PG8_LAS unsigned*)(lds + (bufoff) + ldsw + _i * 8192), 16, 0, 0); } while (0)
#define PG8_LDA(dst, b, h) do { _Pragma("unroll") for (int m = 0; m < 4; ++m) _Pragma("unroll") for (int k = 0; k < 2; ++k) dst[m][k] = *(const PG8_LAS bf16x8*)(lds + PG8_SA(b, h) + aoff + m * 2048 + k * 1024); } while (0)
#define PG8_LDB(dst, b, h) do { _Pragma("unroll") for (int n = 0; n < 2; ++n) _Pragma("unroll") for (int k = 0; k < 2; ++k) dst[n][k] = *(const PG8_LAS bf16x8*)(lds + PG8_SB(b, h) + boff + n * 2048 + k * 1024); } while (0)
#define PG8_MMA(ai, bj, At, Bt) do { __builtin_amdgcn_s_setprio(1); _Pragma("unroll") for (int m = 0; m < 4; ++m) _Pragma("unroll") for (int n = 0; n < 2; ++n) _Pragma("unroll") for (int k = 0; k < 2; ++k) \
        acc[ai][bj][m][n] = __builtin_amdgcn_mfma_f32_16x16x32_bf16(Bt[n][k], At[m][k], acc[ai][bj][m][n], 0, 0, 0); __builtin_amdgcn_s_setprio(0); } while (0)
#define PG8_WAIT_V(n) asm volatile("s_waitcnt vmcnt(" #n ")" ::: "memory")
#define PG8_WAIT_L(n) asm volatile("s_waitcnt lgkmcnt(" #n ")" ::: "memory")
#define PG8_BAR __builtin_amdgcn_s_barrier()
#define PG8_SCHED __builtin_amdgcn_sched_barrier(0)
    Unit cur, nxt; int ui = 0;
    if (!S.next(0, cur)) return;
    f32x4 acc[2][2][4][2];
#pragma unroll
    for (int a = 0; a < 2; ++a)
#pragma unroll
        for (int b = 0; b < 2; ++b)
#pragma unroll
            for (int m = 0; m < 4; ++m)
#pragma unroll
                for (int n = 0; n < 2; ++n) acc[a][b][m][n] = (f32x4){0.f, 0.f, 0.f, 0.f};
    bf16x8 At[4][2], B0[2][2], B1[2][2];
    const char* cA = (const char*)g.A + (size_t)cur.pm * tstepA + (size_t)cur.ko * 2; const char* cB = (const char*)g.Bt + (size_t)cur.pn * tstepB + (size_t)cur.ko * 2;
    const int ks = nt / 2;
    const char* cA2 = nullptr; const char* cB2 = nullptr;
    if constexpr (Epi::MIDK) { cA2 = (const char*)g.A2 + (size_t)cur.pm * tstepA - (size_t)ks * kstep; cB2 = (const char*)g.Bt2 + (size_t)cur.pn * tstepB - (size_t)ks * kstep; }
    S.a_ready(cur);
    if constexpr (SP2) {
        PG8_STAGE(PG8_SB(0, 0), cB, voffB); PG8_STAGE(PG8_SB(0, 1), cB + hstepB, voffB); PG8_STAGE(PG8_SA(0, 0), cA, voffA); PG8_STAGE(PG8_SA(0, 1), cA + hstepA, voffA);
        if (wr == 1) PG8_BAR;
        PG8_WAIT_V(2); PG8_BAR;
        PG8_STAGE(PG8_SB(1, 0), cB + kstep, voffB); PG8_STAGE(PG8_SA(1, 0), cA + kstep, voffA); PG8_STAGE(PG8_SB(1, 1), cB + hstepB + kstep, voffB);
        PG8_WAIT_V(6); PG8_BAR;
    } else {
        PG8_STAGE(PG8_SB(0, 0), cB, voffB); PG8_STAGE(PG8_SA(0, 0), cA, voffA); PG8_STAGE(PG8_SB(0, 1), cB + hstepB, voffB); PG8_STAGE(PG8_SA(0, 1), cA + hstepA, voffA);
        if (wr == 1) PG8_BAR;
        PG8_WAIT_V(4); PG8_BAR;
        PG8_STAGE(PG8_SB(1, 0), cB + kstep, voffB); PG8_STAGE(PG8_SA(1, 0), cA + kstep, voffA); PG8_STAGE(PG8_SB(1, 1), cB + hstepB + kstep, voffB);
        PG8_WAIT_V(6); PG8_BAR;
    }
    for (;;) {
        const bool has_next = S.next(ui + 1, nxt);
        const char* nA = has_next ? (const char*)g.A + (size_t)nxt.pm * tstepA + (size_t)nxt.ko * 2 : cA; const char* nB = has_next ? (const char*)g.Bt + (size_t)nxt.pn * tstepB + (size_t)nxt.ko * 2 : cB;
#pragma unroll
        for (int seg = 0; seg < (Epi::MIDK ? 2 : 1); ++seg) {
        if constexpr (Epi::MIDK) { if (seg == 1) E.mid(acc, cur, wr, wc, fr, fq); }
        for (int t = (seg == 0 ? 0 : ks); t < ((Epi::MIDK && seg == 0) ? ks : nt); t += 2) {
            const bool last = (t == nt - 2);
            const char* pA1 = cA; const char* pA2 = cA; const char* pB2 = cB;
            if constexpr (Epi::MIDK) { if (t >= ks) pA1 = cA2; if (t + 2 >= ks) { pA2 = cA2; pB2 = cB2; } }
            const char* a1 = pA1 + (size_t)(t + 1) * kstep;
            const char* a2 = last ? nA : pA2 + (size_t)(t + 2) * kstep; const char* b2 = last ? nB : pB2 + (size_t)(t + 2) * kstep;
            const char* a3 = a2 + kstep; const char* b3 = b2 + kstep;
            if (last && has_next) S.a_ready(nxt);
            if constexpr (Epi::PRE) { if (last) E.pre(cur, wid, lane); }
            if constexpr (SP2) {
            PG8_LDB(B0, 0, 0); PG8_LDB(B1, 0, 1); PG8_SCHED; PG8_LDA(At, 0, 0); PG8_STAGE(PG8_SA(1, 1), a1 + hstepA, voffA);
            PG8_WAIT_V(8); PG8_WAIT_L(0); PG8_BAR; PG8_MMA(0, 0, At, B0); PG8_MMA(0, 1, At, B1); PG8_BAR; PG8_SCHED;
            PG8_LDA(At, 0, 1); PG8_STAGE(PG8_SB(0, 0), b2, voffB); PG8_STAGE(PG8_SB(0, 1), b2 + hstepB, voffB); PG8_STAGE(PG8_SA(0, 0), a2, voffA);
            PG8_WAIT_V(8); PG8_WAIT_L(0); PG8_BAR; PG8_MMA(1, 0, At, B0); PG8_MMA(1, 1, At, B1); PG8_BAR; PG8_SCHED;
            PG8_LDB(B0, 1, 0); PG8_LDB(B1, 1, 1); PG8_SCHED; PG8_LDA(At, 1, 0); PG8_STAGE(PG8_SA(0, 1), a2 + hstepA, voffA);
            PG8_WAIT_V(8); PG8_WAIT_L(0); PG8_BAR; PG8_MMA(0, 0, At, B0); PG8_MMA(0, 1, At, B1); PG8_BAR; PG8_SCHED;
            PG8_LDA(At, 1, 1); PG8_STAGE(PG8_SB(1, 0), b3, voffB); PG8_STAGE(PG8_SB(1, 1), b3 + hstepB, voffB); PG8_STAGE(PG8_SA(1, 0), a3, voffA);
            PG8_WAIT_V(8); PG8_WAIT_L(0); PG8_BAR; PG8_MMA(1, 0, At, B0); PG8_MMA(1, 1, At, B1); PG8_BAR; PG8_SCHED;
            } else {
            PG8_LDB(B0, 0, 0); PG8_SCHED; PG8_LDA(At, 0, 0); PG8_STAGE(PG8_SA(1, 1), a1 + hstepA, voffA);
            PG8_WAIT_L(8); PG8_BAR; PG8_WAIT_L(0); PG8_MMA(0, 0, At, B0); PG8_BAR; PG8_SCHED;
            PG8_LDB(B1, 0, 1); PG8_STAGE(PG8_SB(0, 0), b2, voffB);
            PG8_BAR; PG8_WAIT_L(0); PG8_MMA(0, 1, At, B1); PG8_BAR;
            PG8_LDA(At, 0, 1); PG8_STAGE(PG8_SA(0, 0), a2, voffA);
            PG8_BAR; PG8_WAIT_L(0); PG8_MMA(1, 0, At, B0); PG8_BAR; PG8_SCHED;
            PG8_STAGE(PG8_SB(0, 1), b2 + hstepB, voffB);
            PG8_WAIT_V(6); PG8_BAR; PG8_MMA(1, 1, At, B1); PG8_BAR;
            PG8_LDB(B0, 1, 0); PG8_SCHED; PG8_LDA(At, 1, 0); PG8_STAGE(PG8_SA(0, 1), a2 + hstepA, voffA);
            PG8_WAIT_L(8); PG8_BAR; PG8_WAIT_L(0); PG8_MMA(0, 0, At, B0); PG8_BAR; PG8_SCHED;
            PG8_LDB(B1, 1, 1); PG8_STAGE(PG8_SB(1, 0), b3, voffB);
            PG8_BAR; PG8_WAIT_L(0); PG8_MMA(0, 1, At, B1); PG8_BAR;
            PG8_LDA(At, 1, 1); PG8_STAGE(PG8_SA(1, 0), a3, voffA);
            PG8_BAR; PG8_WAIT_L(0); PG8_MMA(1, 0, At, B0); PG8_BAR; PG8_SCHED;
            PG8_STAGE(PG8_SB(1, 1), b3 + hstepB, voffB);
            PG8_WAIT_V(6); PG8_BAR; PG8_MMA(1, 1, At, B1); PG8_BAR;
            }
        }
        }
        if constexpr (ALIGN_EPI) { if (wr == 0) PG8_BAR; }
        if constexpr (!Epi::AFTER_DRAIN) { E(acc, cur, wr, wc, fr, fq); S.done(cur); }
        if (!has_next) break;
#pragma unroll
        for (int a = 0; a < 2; ++a)
#pragma unroll
            for (int b = 0; b < 2; ++b)
#pragma unroll
                for (int m = 0; m < 4; ++m)
#pragma unroll
                    for (int n = 0; n < 2; ++n) acc[a][b][m][n] = (f32x4){0.f, 0.f, 0.f, 0.f};
        cur = nxt; cA = nA; cB = nB; ++ui;
        if constexpr (Epi::MIDK) { cA2 = (const char*)g.A2 + (size_t)cur.pm * tstepA - (size_t)ks * kstep; cB2 = (const char*)g.Bt2 + (size_t)cur.pn * tstepB - (size_t)ks * kstep; }
        if constexpr (ALIGN_EPI) { if (wr == 1) PG8_BAR; }
    }
    PG8_WAIT_V(0);
    if constexpr (!ALIGN_EPI) { if (wr == 0) PG8_BAR; }
    PG8_BAR;
    if constexpr (Epi::AFTER_DRAIN) { E.fused(acc, cur, wr, wc, fr, fq, lds, wid, lane); S.done(cur); }
#undef PG8_SA
#undef PG8_SB
#undef PG8_STAGE
#undef PG8_LDA
#undef PG8_LDB
#undef PG8_MMA
#undef PG8_WAIT_V
#undef PG8_WAIT_L
#undef PG8_BAR
#undef PG8_SCHED
}
}

#define LAS __attribute__((address_space(3)))
using pg8::bf16_t; using pg8::bf16x8; using pg8::f32x4; using pg8::u32x4; using pg8::Unit;
typedef float f32x16 __attribute__((ext_vector_type(16)));
typedef short s16x4 __attribute__((ext_vector_type(4)));
typedef unsigned u32x2 __attribute__((ext_vector_type(2)));

#ifndef MK_ONE_LAUNCH
#define MK_ONE_LAUNCH 0
#endif
constexpr int NPHASE = 12;
#ifndef SC_YP
#define SC_YP 1.0f
#endif
#ifndef SC_YS
#define SC_YS 1.0f
#endif
#ifndef SC_PFC
#define SC_PFC 1.0f
#endif
#ifndef SC_SFC
#define SC_SFC 1.0f
#endif
#ifndef SC_PRH
#define SC_PRH 1.0f
#endif
#ifndef SC_SRH
#define SC_SRH 1.0f
#endif
constexpr int DM = 2048, NBATCH = 8, SEQ = 2048, DBATCH = 128, DSEQ = 4;
constexpr int MP = NBATCH * SEQ, MS = DBATCH * DSEQ, M = MP + MS;
constexpr int DFF = 6144, N1 = 8704;
constexpr float EPS = 1e-6f;
constexpr int NCU_UNITS = 272;

constexpr size_t O_YP = 0, O_YS = O_YP + (size_t)MP * DM, O_PKC = O_YS + (size_t)MS * DM, O_PKS = O_PKC + (size_t)MP * 512, O_PKW = O_PKS + (size_t)MP * 512,
    O_PRH = O_PKW + (size_t)NBATCH * 512 * 512, O_PRC = O_PRH + NBATCH * 1024, O_PFC = O_PRC + NBATCH * 3 * 1024, O_SKC = O_PFC + (size_t)NBATCH * 2 * DFF,
    O_SKS = O_SKC + (size_t)MS * 512, O_SKW = O_SKS + (size_t)MS * 512, O_SRH = O_SKW + (size_t)DBATCH * 512 * 512, O_SRC = O_SRH + DBATCH * 1024,
    O_SFC = O_SRC + DBATCH * 3 * 1024, O_END = O_SFC + (size_t)DBATCH * 2 * DFF;

constexpr size_t MiB = 1u << 20;
constexpr size_t WS_CTL = 0, CTL_ZERO_BYTES = 1 * MiB;
constexpr size_t WS_SS2 = 1265 * MiB, WS_SS3 = 1268 * MiB;
constexpr size_t WS_RSTD2 = 1 * MiB + 768 * 1024;
constexpr size_t WS_RSTD1 = 1 * MiB, WS_POSB = 1 * MiB + 128 * 1024, WS_POSP = 1 * MiB + 256 * 1024;
constexpr size_t WS_W1T = 2 * MiB, WS_WPR = 37 * MiB, WS_WPA = 41 * MiB, WS_WO = 45 * MiB, WS_WG = 53 * MiB, WS_WU = 77 * MiB, WS_WD = 101 * MiB, WS_WC = 125 * MiB;
constexpr size_t WS_XB = 128 * MiB, WS_XR = 194 * MiB, WS_GG = 227 * MiB, WS_Q = 260 * MiB, WS_KVS = 293 * MiB, WS_KVW = 310 * MiB, WS_CC = 327 * MiB, WS_FS = 600 * MiB,
    WS_SGM = 668 * MiB, WS_GNSA = 800 * MiB, WS_Y = 803 * MiB, WS_OB = 836 * MiB, WS_OMIX = 869 * MiB, WS_T1 = 935 * MiB, WS_MB = 1001 * MiB, WS_XP1 = 1067 * MiB, WS_XB2 = 1199 * MiB,
    WS_END = 1271 * MiB;
constexpr size_t WS_GE = WS_MB, WS_G0 = WS_MB + 4 * MiB, WS_U0 = WS_MB + 8 * MiB;
constexpr size_t WS_SLAB = WS_T1, WS_SLAB2 = WS_OMIX;
constexpr size_t WS_GB = 128 * MiB, WS_UB = 326 * MiB, WS_ACT = 524 * MiB;
static_assert(WS_W1T + (size_t)N1 * 2048 * 2 <= WS_WPR && WS_WD + (size_t)2048 * 6144 * 2 <= WS_WC && WS_WC + (size_t)512 * 2048 * 2 <= WS_XB, "ws map weights");
static_assert(WS_XB + (size_t)M * 2048 * 2 <= WS_XR && WS_XR + (size_t)M * 1024 * 2 <= WS_GG && WS_Q + (size_t)M * 1024 * 2 <= WS_KVS && WS_KVS + (size_t)M * 512 * 2 <= WS_KVW && WS_KVW + (size_t)M * 512 * 2 <= WS_CC, "ws map act");
static_assert(WS_CC + (size_t)(NCU_UNITS * 256 + 8) * 2048 * 2 <= WS_FS && WS_FS + (size_t)NCU_UNITS * 65536 * 4 <= WS_SGM && WS_SGM + (size_t)M * 4096 * 2 <= WS_GNSA && WS_GNSA + (size_t)M * 32 * 4 <= WS_Y, "ws map 2");
static_assert(WS_Y + (size_t)M * 1024 * 2 <= WS_OB && WS_OB + (size_t)M * 1024 * 2 <= WS_OMIX && WS_OMIX + (size_t)M * 1024 * 4 <= WS_T1 && WS_T1 + (size_t)M * 2048 * 2 <= WS_MB && WS_MB + (size_t)M * 2048 * 2 <= WS_XP1, "ws map 3");
static_assert(WS_XP1 + (size_t)M * 2048 * 4 <= WS_XB2 && WS_XB2 + (size_t)M * 2048 * 2 <= WS_SS2 && WS_SS2 + (size_t)M * 128 <= WS_SS3 && WS_SS3 + (size_t)M * 128 <= WS_END && WS_ACT + (size_t)M * DFF * 2 <= WS_GNSA && WS_GB + (size_t)M * DFF * 2 <= WS_UB && WS_UB + (size_t)M * DFF * 2 <= WS_ACT, "ws map 4");
constexpr int CW_BAR = 4096, CW_QUEUE = 64;

constexpr int RING_BYTES = 131072, MISC_OFF = RING_BYTES + 320, XL_OFF = RING_BYTES + 1024, LDS_BYTES = 147456;

__device__ __forceinline__ unsigned pk2(float lo, float hi) { return pg8::cvt_pk_bf16(lo, hi); }
__device__ __forceinline__ float bf2f(unsigned short b) { return __uint_as_float(((unsigned)b) << 16); }
__device__ __forceinline__ float bflo(unsigned w) { return __uint_as_float(w << 16); }
__device__ __forceinline__ float bfhi(unsigned w) { return __uint_as_float(w & 0xffff0000u); }
__device__ __forceinline__ float sigmoidf_(float v) { return __builtin_amdgcn_rcpf(1.0f + __builtin_amdgcn_exp2f(-1.4426950409f * v)); }
__device__ __forceinline__ float gelu_tanh(float x) { const float u = x * (1.0f + 0.044715f * x * x); return x * __builtin_amdgcn_rcpf(1.0f + __builtin_amdgcn_exp2f(-2.302208198f * u)); }
__device__ __forceinline__ float wave_sum(float v) {
    v += __int_as_float(__builtin_amdgcn_update_dpp(0, __float_as_int(v), 0xB1, 0xf, 0xf, true));
    v += __int_as_float(__builtin_amdgcn_update_dpp(0, __float_as_int(v), 0x4E, 0xf, 0xf, true));
    v += __int_as_float(__builtin_amdgcn_update_dpp(0, __float_as_int(v), 0x141, 0xf, 0xf, true));
    v += __int_as_float(__builtin_amdgcn_update_dpp(0, __float_as_int(v), 0x140, 0xf, 0xf, true));
    v += __shfl_xor(v, 16); v += __shfl_xor(v, 32);
    return v;
}
__device__ __forceinline__ u32x4 pack8u(f32x4 a, f32x4 b) { u32x4 w = {pk2(a[0], a[1]), pk2(a[2], a[3]), pk2(b[0], b[1]), pk2(b[2], b[3])}; return w; }

#define XB_TMO      128
#define XB_XCNT(j)  (256  + 64 * (j))
#define XB_XSUB(j)  (1280 + 64 * (j))
#define XB_XGEN(j)  (2304 + 64 * (j))
#define XB_TOP      3328
#define XB_TOPGEN   3392
#define XCD_BAR_WORDS 3456
#define XB_SPIN_CAP (1u << 18)
__device__ __forceinline__ unsigned xb_ld(unsigned* p)              { return __hip_atomic_load(p, __ATOMIC_RELAXED, __HIP_MEMORY_SCOPE_AGENT); }
__device__ __forceinline__ unsigned xb_add(unsigned* p, unsigned v) { return __hip_atomic_fetch_add(p, v, __ATOMIC_RELAXED, __HIP_MEMORY_SCOPE_AGENT); }
__device__ __forceinline__ unsigned xb_xcc_id() { return (unsigned)__builtin_amdgcn_s_getreg((3 << 11) | 20) & 0xFu; }
#define XB_SPIN(cond, bar) do { unsigned _sp = 0; while (cond) { __builtin_amdgcn_s_sleep(1); \
    if ((++_sp & 255u) == 0u) { if (xb_ld(&(bar)[XB_TMO])) break; if (_sp > XB_SPIN_CAP) { atomicAdd(&(bar)[XB_TMO], 1u); break; } } } } while (0)
struct XcdBarrier { unsigned* bar; unsigned x; volatile LAS unsigned* st; };
__device__ __forceinline__ XcdBarrier xcd_barrier_post(unsigned* bar, volatile LAS unsigned* st) {
    XcdBarrier b; b.bar = bar; b.x = xb_xcc_id(); b.st = st;
    if (threadIdx.x == 0) (void)xb_add(&bar[XB_XCNT(b.x)], 1u);
    return b;
}
__device__ __forceinline__ void xcd_barrier_complete(unsigned* bar, unsigned x, unsigned& nloc, unsigned& nx) {
    const unsigned G = gridDim.x * gridDim.y * gridDim.z;
    unsigned sum, cnt, mine, sp = 0u;
    for (;;) {
        sum = 0u; cnt = 0u; mine = 0u;
#pragma unroll
        for (unsigned j = 0; j < 16; ++j) { const unsigned c = xb_ld(&bar[XB_XCNT(j)]); sum += c; cnt += (c > 0u) ? 1u : 0u; mine = (j == x) ? c : mine; }
        if (sum == G) break;
        __builtin_amdgcn_s_sleep(1);
        if ((++sp & 255u) == 0u) { if (xb_ld(&bar[XB_TMO])) break; if (sp > XB_SPIN_CAP) { atomicAdd(&bar[XB_TMO], 1u); break; } }
    }
    nloc = mine > 0u ? mine : 1u; nx = cnt > 0u ? cnt : 1u;
}
__device__ __forceinline__ void xcd_barrier(const XcdBarrier& b) {
    asm volatile("s_waitcnt vmcnt(0)" ::: "memory");
    __syncthreads();
    if (threadIdx.x == 0) {
        unsigned* bar = b.bar;
        __builtin_amdgcn_s_waitcnt(0);
        unsigned nloc = b.st[0], nx = b.st[1];
        if (nloc == 0u) { xcd_barrier_complete(bar, b.x, nloc, nx); b.st[0] = nloc; b.st[1] = nx; }
        const unsigned old = xb_add(&bar[XB_XSUB(b.x)], 1u);
        const unsigned gen = old / nloc;
        if (old + 1u == (gen + 1u) * nloc) {
            __builtin_amdgcn_fence(__ATOMIC_RELEASE, "agent");
            asm volatile("s_waitcnt vmcnt(0)" ::: "memory");
            const unsigned og = xb_add(&bar[XB_TOP], 1u);
            const unsigned tg = og / nx;
            if (og + 1u == (tg + 1u) * nx) xb_add(&bar[XB_TOPGEN], 1u);
            else XB_SPIN(xb_ld(&bar[XB_TOPGEN]) == tg, bar);
            __builtin_amdgcn_fence(__ATOMIC_ACQUIRE, "agent");
            xb_add(&bar[XB_XGEN(b.x)], 1u);
            asm volatile("s_waitcnt vmcnt(0)" ::: "memory");
        } else {
            XB_SPIN(xb_ld(&bar[XB_XGEN(b.x)]) == gen, bar);
            __builtin_amdgcn_fence(__ATOMIC_ACQUIRE, "agent");
            asm volatile("s_waitcnt vmcnt(0)" ::: "memory");
        }
    }
    __syncthreads();
}

struct Args { const void* in[30]; float* out; unsigned char* ws; int ph_lo, ph_hi, qlo, qhi; };
struct Frame {
    int tid, lane, wave, G, bid;
    const float *x_p, *x_s, *c_cmp, *c_slc, *c_win, *st_h, *st_conv, *st_ffn; const int* pt;
    const float *norm_mix, *w_in, *rconv_w, *rconv_b, *rwa, *rba, *rwx, *rbx, *rlam, *cmp_w, *cmp_pos, *w_pr, *w_pa, *w_out, *norm_ffn, *w_gate, *w_up, *fconv_w, *fconv_b, *w_down, *norm_final;
    float* out; unsigned char* ws;
};
#define WSP(T, off) ((T*)(F.ws + (off)))

struct TrDesc { const float* src; const float* ks; bf16_t* dst; int ldw, ldk; };
__device__ __forceinline__ TrDesc tr_mk(const float* W, int ldw, int k0, int c0, const float* kscale, bf16_t* WT, int ldk, int dst_row0, int dst_k0) {
    TrDesc d; d.src = W + (size_t)k0 * ldw + c0; d.ks = kscale ? kscale + k0 : nullptr; d.dst = WT + (size_t)dst_row0 * ldk + dst_k0; d.ldw = ldw; d.ldk = ldk; return d; }
constexpr int TR_IN = 32 * (N1 / 32), TR_PR = 16 * 64, TR_O = 32 * 64, TR_G = 32 * 192, TR_D = 96 * 64, TR_C = 2 * 64 * 4;
constexpr int TR_A1 = TR_IN, TR_A2 = TR_A1 + 2 * TR_PR + TR_O, TR_A3 = TR_A2 + 2 * TR_G, TR_A4 = TR_A3 + TR_D, TR_A5 = TR_A4 + TR_C;
constexpr int TR_GDEF = 2048;
__device__ __forceinline__ TrDesc tr_desc(const Frame& F, int r) {
    if (r < TR_IN) { const int nblk = N1 / 32, kb = r / nblk, nb = r % nblk, n0 = nb * 32; const int src = n0 < 4608 ? n0 : n0 + 24;
        return tr_mk(F.w_in, 8728, kb * 64, src, F.norm_mix, WSP(bf16_t, WS_W1T), 2048, n0, kb * 64); } r -= TR_IN;
    if (r < TR_PR) { const int kb = r / 64, nb = r % 64; return tr_mk(F.w_pr, 2048, kb * 64, nb * 32, nullptr, WSP(bf16_t, WS_WPR), 1024, nb * 32, kb * 64); } r -= TR_PR;
    if (r < TR_PR) { const int kb = r / 64, nb = r % 64; return tr_mk(F.w_pa, 2048, kb * 64, nb * 32, nullptr, WSP(bf16_t, WS_WPA), 1024, nb * 32, kb * 64); } r -= TR_PR;
    if (r < TR_O) { const int kb = r / 64, nb = r % 64; return tr_mk(F.w_out, 2048, kb * 64, nb * 32, nullptr, WSP(bf16_t, WS_WO), 2048, nb * 32, kb * 64); } r -= TR_O;
    if (r < TR_G) { const int kb = r / 192, nb = r % 192; return tr_mk(F.w_gate, DFF, kb * 64, nb * 32, F.norm_ffn, WSP(bf16_t, WS_WG), 2048, (nb >> 2) * 256 + (nb & 3) * 32, kb * 64); } r -= TR_G;
    if (r < TR_G) { const int kb = r / 192, nb = r % 192; return tr_mk(F.w_up, DFF, kb * 64, nb * 32, F.norm_ffn, WSP(bf16_t, WS_WG), 2048, (nb >> 2) * 256 + 128 + (nb & 3) * 32, kb * 64); } r -= TR_G;
    if (r < TR_D) { const int kb = r / 64, nb = r % 64; return tr_mk(F.w_down, 2048, kb * 64, nb * 32, nullptr, WSP(bf16_t, WS_WD), DFF, nb * 32, kb * 64); } r -= TR_D;
    { const int c = r / 256, rr = r % 256, kb = rr / 4, nb = rr % 4, k0 = kb * 64, lw = k0 >> 7;
      return tr_mk(F.cmp_w + (size_t)c * 4096 * 128, 128, k0, nb * 32, nullptr, WSP(bf16_t, WS_WC), 2048, c * 256 + (lw >> 4) * 128 + nb * 32, (lw & 15) * 128 + (k0 & 127)); }
}
__device__ __forceinline__ void tr_load(const TrDesc& d, float (&tv)[32], f32x4 (&ks)[2], int lane) {
    const float* p = d.src + (size_t)(lane >> 5) * d.ldw + (lane & 31);
#pragma unroll
    for (int i = 0; i < 32; ++i) tv[i] = p[(size_t)(2 * i) * d.ldw];
    if (d.ks) { ks[0] = *(const f32x4*)(d.ks + 8 * (lane & 7)); ks[1] = *(const f32x4*)(d.ks + 8 * (lane & 7) + 4); } else { ks[0] = (f32x4){1.f, 1.f, 1.f, 1.f}; ks[1] = ks[0]; }
}
__device__ __forceinline__ void tr_store(const TrDesc& d, const float (&tv)[32], const f32x4 (&ks)[2], LAS float* scr, int lane) {
#pragma unroll
    for (int i = 0; i < 32; ++i) scr[(2 * i + (lane >> 5)) * 33 + (lane & 31)] = tv[i];
    asm volatile("s_waitcnt lgkmcnt(0)" ::: "memory");
    const int c = lane & 7;
#pragma unroll
    for (int j4 = 0; j4 < 4; ++j4) { const int n = (lane >> 3) + 8 * j4; const LAS float* s = scr + (8 * c) * 33 + n;
        u32x4 o; o.x = pk2(s[0 * 33] * ks[0].x, s[1 * 33] * ks[0].y); o.y = pk2(s[2 * 33] * ks[0].z, s[3 * 33] * ks[0].w); o.z = pk2(s[4 * 33] * ks[1].x, s[5 * 33] * ks[1].y); o.w = pk2(s[6 * 33] * ks[1].z, s[7 * 33] * ks[1].w);
        *(u32x4*)(d.dst + (size_t)n * d.ldk + 8 * c) = o; }
    asm volatile("s_waitcnt lgkmcnt(0)" ::: "memory");
}
__device__ __forceinline__ int tr_map(int v, int mode) { return mode == 0 ? v : v < TR_IN ? v : v < TR_IN + (2 * TR_G - TR_GDEF) ? v - TR_IN + TR_A2 + TR_GDEF : v - (TR_IN + 2 * TR_G - TR_GDEF) + TR_A4; }
__device__ __forceinline__ void tr_run(const Frame& F, LAS float* scr, int lane, int first, int step, int end, int mode) {
    int v = first; if (v >= end) return;
    TrDesc d = tr_desc(F, tr_map(v, mode)); float tv[32]; f32x4 ks[2]; tr_load(d, tv, ks, lane);
#pragma unroll 1
    for (;;) { const int vn = v + step; const bool more = vn < end;
        const TrDesc dn = tr_desc(F, tr_map(more ? vn : v, mode)); float tn[32]; f32x4 kn[2]; tr_load(dn, tn, kn, lane);
        tr_store(d, tv, ks, scr, lane);
        if (!more) break;
        d = dn; v = vn; ks[0] = kn[0]; ks[1] = kn[1];
#pragma unroll
        for (int i = 0; i < 32; ++i) tv[i] = tn[i]; }
}
__device__ __forceinline__ void tr_deferred(const Frame& F, unsigned char* ldsg, int lo, int hi, int wg_lo, int wg_hi) {
    if (wg_lo >= wg_hi) { wg_lo = 0; wg_hi = F.G; }
    if (F.bid < wg_lo || F.bid >= wg_hi) return;
    LAS float* scr = (LAS float*)((LAS unsigned char*)ldsg + F.wave * 16384);
    tr_run(F, scr, F.lane, lo + (F.bid - wg_lo) * 8 + F.wave, (wg_hi - wg_lo) * 8, hi, 0);
}
constexpr int CC_EARLY = 24;
__device__ __forceinline__ void cc_item(const Frame& F, int it, int lane) { bf16_t* CC = WSP(bf16_t, WS_CC);
    const int db = it >> 7, n = it & 127; const int phys = F.pt[db * 16 + (n >> 3)];
    const float* src = F.c_cmp + ((size_t)phys * 128 + (n & 7) * 16) * 512 + lane * 4; const int g = lane >> 5, d = (lane & 31) * 4;
#pragma unroll 1
    for (int l0 = 0; l0 < 16; l0 += 8) { f32x4 t[16];
#pragma unroll
        for (int u = 0; u < 16; ++u) t[u] = *(const f32x4*)(src + (l0 + (u >> 1)) * 512 + (u & 1) * 256);
#pragma unroll
        for (int u = 0; u < 16; ++u) { u32x2 w; w.x = pk2(t[u].x, t[u].y); w.y = pk2(t[u].z, t[u].w);
            *(u32x2*)(CC + ((size_t)((db * 2 + (u & 1)) * 256 + g * 128 + n)) * 2048 + (l0 + (u >> 1)) * 128 + d) = w; } }
}
__device__ __forceinline__ void p0_prologue(const Frame& F, unsigned char* ldsg, const int skipmask) {
    LAS float* scr = (LAS float*)((LAS unsigned char*)ldsg + F.wave * 16384);
    const int gw = F.bid * 8 + F.wave, NGW = F.G * 8, lane = F.lane;
    if (!(skipmask & 1)) { LAS bf16_t* WL = (LAS bf16_t*)ldsg; constexpr int WLS = 2056;
      { f32x4 wv[4][6];
#pragma unroll
        for (int r = 0; r < 4; ++r)
#pragma unroll
            for (int q = 0; q < 6; ++q) wv[r][q] = *(const f32x4*)(F.w_in + (size_t)(F.tid + 512 * r) * 8728 + 4608 + 4 * q);
#pragma unroll
        for (int r = 0; r < 4; ++r) { const int k = F.tid + 512 * r; const float nm = F.norm_mix[k];
#pragma unroll
            for (int q = 0; q < 6; ++q)
#pragma unroll
                for (int e = 0; e < 4; ++e) WL[(4 * q + e) * WLS + k] = (bf16_t)(pk2(wv[r][q][e] * nm, 0.f) & 0xffffu);
#pragma unroll
            for (int c = 24; c < 32; ++c) WL[c * WLS + k] = (bf16_t)0; } }
      __syncthreads();
      bf16_t* XB = WSP(bf16_t, WS_XB); float* RS = WSP(float, WS_RSTD1); float* GN = WSP(float, WS_GNSA);
      const int fr = lane & 15, fq = lane >> 4;
      if (F.wave >= 5 && !(skipmask & 4)) { const int ipw = (DBATCH * 128 + F.G - 1) / F.G, lo = F.bid * ipw, hi0 = (lo + ipw) < DBATCH * 128 ? (lo + ipw) : DBATCH * 128, hi = (lo + CC_EARLY) < hi0 ? (lo + CC_EARLY) : hi0;
          for (int it = lo + (F.wave - 5); it < hi; it += 3) cc_item(F, it, lane); }
      for (int grp = F.wave * F.G + F.bid; grp < M / 16; grp += NGW) { const int m0 = grp * 16, m = m0 + fr;
          const float* xrow = ((m < MP) ? F.x_p + (size_t)m * DM : F.x_s + (size_t)(m - MP) * DM) + 8 * fq;
          bf16_t* xb = XB + (size_t)m * DM + 8 * fq; const LAS bf16_t* w0 = WL + fr * WLS + 8 * fq; const LAS bf16_t* w1 = w0 + 16 * WLS;
          f32x4 a0 = {0.f, 0.f, 0.f, 0.f}, a1 = {0.f, 0.f, 0.f, 0.f}; float ss = 0.f;
          f32x4 cur[16], nxt[16];
#pragma unroll
          for (int j = 0; j < 8; ++j) { cur[2 * j] = *(const f32x4*)(xrow + 32 * j); cur[2 * j + 1] = *(const f32x4*)(xrow + 32 * j + 4); }
#pragma unroll 1
          for (int b = 0; b < 8; ++b) { const int bn = b < 7 ? b + 1 : 7;
#pragma unroll
              for (int j = 0; j < 8; ++j) { nxt[2 * j] = *(const f32x4*)(xrow + 256 * bn + 32 * j); nxt[2 * j + 1] = *(const f32x4*)(xrow + 256 * bn + 32 * j + 4); }
#pragma unroll
              for (int j = 0; j < 8; ++j) { const f32x4 p = cur[2 * j], q = cur[2 * j + 1];
                  ss += (p.x * p.x + p.y * p.y) + (p.z * p.z + p.w * p.w) + (q.x * q.x + q.y * q.y) + (q.z * q.z + q.w * q.w);
                  const u32x4 pk = pack8u(p, q); *(u32x4*)(xb + 256 * b + 32 * j) = pk; const bf16x8 af = __builtin_bit_cast(bf16x8, pk);
                  const bf16x8 b0 = *(const LAS bf16x8*)(w0 + 256 * b + 32 * j), b1 = *(const LAS bf16x8*)(w1 + 256 * b + 32 * j);
                  a0 = __builtin_amdgcn_mfma_f32_16x16x32_bf16(af, b0, a0, 0, 0, 0); a1 = __builtin_amdgcn_mfma_f32_16x16x32_bf16(af, b1, a1, 0, 0, 0); }
#pragma unroll
              for (int j = 0; j < 16; ++j) cur[j] = nxt[j]; }
          ss += __shfl_xor(ss, 16); ss += __shfl_xor(ss, 32);
          const float rstd = 1.0f / sqrtf(ss * (1.0f / DM) + EPS);
          if (fq == 0) RS[m] = rstd;
#pragma unroll
          for (int i = 0; i < 4; ++i) { const float rsr = __shfl(rstd, 4 * fq + i);
              GN[(size_t)(m0 + 4 * fq + i) * 32 + fr] = sigmoidf_(a0[i] * rsr); GN[(size_t)(m0 + 4 * fq + i) * 32 + 16 + fr] = sigmoidf_(fr < 8 ? a1[i] * rsr : 0.f); } }
      __syncthreads(); }
    if (!(skipmask & 2)) { constexpr int NV = TR_IN + (2 * TR_G - TR_GDEF) + TR_C; tr_run(F, scr, lane, gw, NGW, NV, 1); }
    if (!(skipmask & 4)) { const int ipw = (DBATCH * 128 + F.G - 1) / F.G, lo = F.bid * ipw, hi = (lo + ipw) < DBATCH * 128 ? (lo + ipw) : DBATCH * 128;
      for (int it = lo + CC_EARLY + F.wave; it < hi; it += 8) cc_item(F, it, lane); }
    if (F.tid < 256) { const int c = F.tid >> 7, e2 = F.tid & 127, kb = F.bid * (4096 / F.G), ke = kb + 4096 / F.G; float s = 0.f;
        const float* pw = F.cmp_w + (size_t)c * 4096 * 128 + e2; const float* pp = F.cmp_pos + c * 4096;
#pragma unroll 8
        for (int k = kb; k < ke; ++k) s += pp[k] * pw[(size_t)k * 128];
        WSP(float, WS_POSP)[F.bid * 256 + F.tid] = s; }
}

#define EPI_ROWS(r_) _Pragma("unroll") for (int ai = 0; ai < 2; ++ai) _Pragma("unroll") for (int m = 0; m < 4; ++m) { const int r_ = row0 + ai * 128 + m * 16;
#define EPI_COLS(c_) _Pragma("unroll") for (int bj = 0; bj < 2; ++bj) { const int c_ = col0 + bj * 128; f32x4 v0 = acc[ai][bj][m][0], v1 = acc[ai][bj][m][1];
#define EPI_END } }
#define EPI_PIN(x) asm volatile("" : "+v"(x))
__device__ __forceinline__ void st_bf8(bf16_t* p, f32x4 a, f32x4 b) { *(u32x4*)p = pack8u(a, b); }
__device__ __forceinline__ void st_f8(float* p, f32x4 a, f32x4 b) { *(f32x4*)p = a; *(f32x4*)(p + 4) = b; }

struct EpiIn {
    static constexpr bool PERM = true, AFTER_DRAIN = false, MIDK = false, PRE = true;
    const float* rstd; bf16_t *XR, *GG, *Q, *KVS, *KVW, *CC, *SGM; float* GNSA; float* out; int skip; LAS float* RSL;
    __device__ __forceinline__ void pre(const Unit& u, int wid, int lane) const {
        if (wid < 4) { unsigned lo = (unsigned)lane * 4u; asm volatile("" : "+v"(lo)); __builtin_amdgcn_global_load_lds((const unsigned*)((const char*)(rstd + u.pm * 256 + wid * 64) + lo), (LAS unsigned*)(RSL + wid * 64), 4, 0, 0); } }
    __device__ __forceinline__ void operator()(const f32x4 (&acc)[2][2][4][2], const Unit& u, int wr, int wc, int fr, int fq) const {
        if (skip) { if (acc[0][0][0][0].x == 123456.789f) out[0] = 1.f; return; }
        const int row0 = u.pm * 256 + wr * 64 + fr, col0 = u.pn * 256 + wc * 32 + 8 * fq, pn = u.pn; const bool samp = u.pm >= 64;
        float rsv[2][4];
#pragma unroll
        for (int ai = 0; ai < 2; ++ai)
#pragma unroll
            for (int m = 0; m < 4; ++m) rsv[ai][m] = RSL[wr * 64 + fr + ai * 128 + m * 16];
#pragma unroll
        for (int ai = 0; ai < 2; ++ai)
#pragma unroll
            for (int m = 0; m < 4; ++m) EPI_PIN(rsv[ai][m]);
        EPI_ROWS(r) const float rs = rsv[ai][m];
            EPI_COLS(c) v0 *= rs; v1 *= rs;
                if (pn < 4) { st_bf8(XR + (size_t)r * 1024 + c, v0, v1);
                    if (!samp) { const int t = r & 2047; if (t >= 2045) st_f8(out + O_PRC + (size_t)((r >> 11) * 3 + (t - 2045)) * 1024 + c, v0, v1); }
                    else { const int tq = r & 3; if (tq >= 1) st_f8(out + O_SRC + (size_t)(((r - MP) >> 2) * 3 + tq - 1) * 1024 + c, v0, v1); } }
                else if (pn < 8) { f32x4 a, b;
#pragma unroll
                    for (int j = 0; j < 4; ++j) { a[j] = gelu_tanh(v0[j]); b[j] = gelu_tanh(v1[j]); }
                    st_bf8(GG + (size_t)r * 1024 + (c - 1024), a, b); }
                else if (pn < 12) { st_bf8(Q + (size_t)r * 1024 + (c - 2048), v0, v1); }
                else if (pn < 14) { const int cc = c - 3072;
                    if (!samp) { st_f8(out + O_PKC + (size_t)r * 512 + cc, v0, v1); const int t = r & 2047, b = r >> 11;
                        st_bf8(CC + ((size_t)((256 + b * 2 + (cc >> 8)) * 256 + ((cc >> 7) & 1) * 128 + (t >> 4))) * 2048 + (t & 15) * 128 + (cc & 127), v0, v1); }
                    else st_f8(out + O_SKC + (size_t)(r - MP) * 512 + cc, v0, v1); }
                else if (pn < 16) { const int cc = c - 3584; st_bf8(KVS + (size_t)r * 512 + cc, v0, v1);
                    if (!samp) st_f8(out + O_PKS + (size_t)r * 512 + cc, v0, v1); else st_f8(out + O_SKS + (size_t)(r - MP) * 512 + cc, v0, v1); }
                else if (pn < 18) { const int cc = c - 4096; st_bf8(KVW + (size_t)r * 512 + cc, v0, v1);
                    if (!samp) { const int t = r & 2047; if (t >= 1536) st_f8(out + O_PKW + (size_t)((r >> 11) * 512 + t - 1536) * 512 + cc, v0, v1); }
                    else { const int q = r - MP; st_f8(out + O_SKW + (size_t)((q >> 2) * 512 + 508 + (q & 3)) * 512 + cc, v0, v1); } }
                else { f32x4 a, b;
#pragma unroll
                    for (int j = 0; j < 4; ++j) { a[j] = sigmoidf_(v0[j]); b[j] = sigmoidf_(v1[j]); }
                    st_bf8(SGM + (size_t)r * 4096 + (c - 4608), a, b); }
            EPI_END
    }
};
struct EpiFS {
    static constexpr bool PERM = false, AFTER_DRAIN = false, MIDK = false, PRE = false;
    float* FS;
    __device__ __forceinline__ void operator()(const f32x4 (&acc)[2][2][4][2], const Unit& u, int wr, int wc, int fr, int fq) const {
        float* base = FS + (size_t)u.pm * 65536 + (size_t)(wr * 64 + fr) * 256 + wc * 32 + 4 * fq;
#pragma unroll
        for (int ai = 0; ai < 2; ++ai)
#pragma unroll
            for (int m = 0; m < 4; ++m)
#pragma unroll
                for (int bj = 0; bj < 2; ++bj)
#pragma unroll
                    for (int n = 0; n < 2; ++n) *(f32x4*)(base + (size_t)(ai * 128 + m * 16) * 256 + bj * 128 + n * 16) = acc[ai][bj][m][n];
    }
};
template <int PASS> struct EpiProj {
    static constexpr bool PERM = true, AFTER_DRAIN = false, MIDK = false, PRE = false;
    const bf16_t* SGM; bf16_t* T1; bf16_t* MB;
    __device__ __forceinline__ void operator()(const f32x4 (&acc)[2][2][4][2], const Unit& u, int wr, int wc, int fr, int fq) const {
        const int row0 = u.pm * 256 + wr * 64 + fr, col0 = u.pn * 256 + wc * 32 + 8 * fq;
#pragma unroll
        for (int ai = 0; ai < 2; ++ai) { u32x4 gw[4][2], tw[4][2];
#pragma unroll
            for (int m = 0; m < 4; ++m)
#pragma unroll
                for (int bj = 0; bj < 2; ++bj) { const size_t r = (size_t)(row0 + ai * 128 + m * 16); const int c = col0 + bj * 128; gw[m][bj] = *(const u32x4*)(SGM + r * 4096 + PASS * 2048 + c);
                    if (PASS == 1) tw[m][bj] = *(const u32x4*)(T1 + r * 2048 + c); }
#pragma unroll
            for (int m = 0; m < 4; ++m)
#pragma unroll
                for (int bj = 0; bj < 2; ++bj) { EPI_PIN(gw[m][bj]); if (PASS == 1) EPI_PIN(tw[m][bj]); }
#pragma unroll
            for (int m = 0; m < 4; ++m)
#pragma unroll
                for (int bj = 0; bj < 2; ++bj) { const size_t r = (size_t)(row0 + ai * 128 + m * 16); const int c = col0 + bj * 128; const u32x4 g_ = gw[m][bj];
                    const f32x4 g0 = {bflo(g_.x), bfhi(g_.x), bflo(g_.y), bfhi(g_.y)}, g1 = {bflo(g_.z), bfhi(g_.z), bflo(g_.w), bfhi(g_.w)};
                    f32x4 v0 = acc[ai][bj][m][0] * g0, v1 = acc[ai][bj][m][1] * g1;
                    if (PASS == 0) st_bf8(T1 + r * 2048 + c, v0, v1);
                    else { const u32x4 t_ = tw[m][bj]; v0 += (f32x4){bflo(t_.x), bfhi(t_.x), bflo(t_.y), bfhi(t_.y)}; v1 += (f32x4){bflo(t_.z), bfhi(t_.z), bflo(t_.w), bfhi(t_.w)};
                        st_bf8(MB + r * 2048 + c, v0, v1); } } }
    }
};
struct EpiProjM {
    static constexpr bool PERM = true, AFTER_DRAIN = false, MIDK = true, PRE = false;
    const bf16_t* SGM; bf16_t* MB;
    __device__ __forceinline__ void mid(f32x4 (&acc)[2][2][4][2], const Unit& u, int wr, int wc, int fr, int fq) const {
        asm volatile("" : "+v"(fr), "+v"(fq));
        const int row0 = u.pm * 256 + wr * 64 + fr, col0 = u.pn * 256 + wc * 32 + 8 * fq;
#pragma unroll
        for (int ai = 0; ai < 2; ++ai) { u32x4 gr[4][2], ga[4][2];
#pragma unroll
            for (int m = 0; m < 4; ++m)
#pragma unroll
                for (int bj = 0; bj < 2; ++bj) { const bf16_t* p = SGM + (size_t)(row0 + ai * 128 + m * 16) * 4096 + col0 + bj * 128; gr[m][bj] = *(const u32x4*)p; ga[m][bj] = *(const u32x4*)(p + 2048); }
#pragma unroll
            for (int m = 0; m < 4; ++m)
#pragma unroll
                for (int bj = 0; bj < 2; ++bj) { EPI_PIN(gr[m][bj]); EPI_PIN(ga[m][bj]); }
#pragma unroll
            for (int m = 0; m < 4; ++m)
#pragma unroll
                for (int bj = 0; bj < 2; ++bj) { const u32x4 r_ = gr[m][bj], a_ = ga[m][bj];
                    const f32x4 r0 = {bflo(r_.x), bfhi(r_.x), bflo(r_.y), bfhi(r_.y)}, r1 = {bflo(r_.z), bfhi(r_.z), bflo(r_.w), bfhi(r_.w)};
                    f32x4 a0 = {bflo(a_.x), bfhi(a_.x), bflo(a_.y), bfhi(a_.y)}, a1 = {bflo(a_.z), bfhi(a_.z), bflo(a_.w), bfhi(a_.w)};
#pragma unroll
                    for (int j = 0; j < 4; ++j) { a0[j] = __builtin_amdgcn_rcpf(fmaxf(a0[j], 1e-20f)); a1[j] = __builtin_amdgcn_rcpf(fmaxf(a1[j], 1e-20f)); }
                    acc[ai][bj][m][0] *= r0 * a0; acc[ai][bj][m][1] *= r1 * a1; } }
    }
    __device__ __forceinline__ void operator()(const f32x4 (&acc)[2][2][4][2], const Unit& u, int wr, int wc, int fr, int fq) const {
        const int row0 = u.pm * 256 + wr * 64 + fr, col0 = u.pn * 256 + wc * 32 + 8 * fq;
#pragma unroll
        for (int ai = 0; ai < 2; ++ai) { u32x4 ga[4][2];
#pragma unroll
            for (int m = 0; m < 4; ++m)
#pragma unroll
                for (int bj = 0; bj < 2; ++bj) ga[m][bj] = *(const u32x4*)(SGM + (size_t)(row0 + ai * 128 + m * 16) * 4096 + 2048 + col0 + bj * 128);
#pragma unroll
            for (int m = 0; m < 4; ++m)
#pragma unroll
                for (int bj = 0; bj < 2; ++bj) EPI_PIN(ga[m][bj]);
#pragma unroll
            for (int m = 0; m < 4; ++m)
#pragma unroll
                for (int bj = 0; bj < 2; ++bj) { const u32x4 a_ = ga[m][bj]; f32x4 a0 = {bflo(a_.x), bfhi(a_.x), bflo(a_.y), bfhi(a_.y)}, a1 = {bflo(a_.z), bfhi(a_.z), bflo(a_.w), bfhi(a_.w)};
#pragma unroll
                    for (int j = 0; j < 4; ++j) { a0[j] = fmaxf(a0[j], 1e-20f); a1[j] = fmaxf(a1[j], 1e-20f); }
                    st_bf8(MB + (size_t)(row0 + ai * 128 + m * 16) * 2048 + col0 + bj * 128, acc[ai][bj][m][0] * a0, acc[ai][bj][m][1] * a1); } }
    }
};
struct EpiOut {
    static constexpr bool PERM = true, AFTER_DRAIN = false, MIDK = false, PRE = false;
    const bf16_t* XB; bf16_t* XB2; float* SS;
    __device__ __forceinline__ void operator()(const f32x4 (&acc)[2][2][4][2], const Unit& u, int wr, int wc, int fr, int fq) const {
        const int row0 = u.pm * 256 + wr * 64 + fr, col0 = u.pn * 256 + wc * 32 + 8 * fq;
#pragma unroll
        for (int ai = 0; ai < 2; ++ai) { u32x4 xw[4][2];
#pragma unroll
            for (int m = 0; m < 4; ++m)
#pragma unroll
                for (int bj = 0; bj < 2; ++bj) xw[m][bj] = *(const u32x4*)(XB + (size_t)(row0 + ai * 128 + m * 16) * DM + col0 + bj * 128);
#pragma unroll
            for (int m = 0; m < 4; ++m)
#pragma unroll
                for (int bj = 0; bj < 2; ++bj) EPI_PIN(xw[m][bj]);
#pragma unroll
            for (int m = 0; m < 4; ++m) { const int r = row0 + ai * 128 + m * 16; float ss = 0.f;
#pragma unroll
                for (int bj = 0; bj < 2; ++bj) { const int c = col0 + bj * 128; const u32x4 w = xw[m][bj];
                    const f32x4 v0 = acc[ai][bj][m][0] + (f32x4){bflo(w.x), bfhi(w.x), bflo(w.y), bfhi(w.y)}, v1 = acc[ai][bj][m][1] + (f32x4){bflo(w.z), bfhi(w.z), bflo(w.w), bfhi(w.w)};
                    st_bf8(XB2 + (size_t)r * DM + c, v0, v1);
                    ss += (v0.x * v0.x + v0.y * v0.y) + (v0.z * v0.z + v0.w * v0.w) + (v1.x * v1.x + v1.y * v1.y) + (v1.z * v1.z + v1.w * v1.w); }
                ss += __shfl_xor(ss, 16); ss += __shfl_xor(ss, 32);
                if (fq == 0) SS[(size_t)r * 32 + u.pn * 4 + wc] = ss; } }
    }
};
__device__ __forceinline__ float dppf(float x, int ctrl_sel) {
    const int v = __float_as_int(x);
    const int r = ctrl_sel == 0 ? __builtin_amdgcn_update_dpp(0, v, 0x111, 0xf, 0xf, true) : ctrl_sel == 1 ? __builtin_amdgcn_update_dpp(0, v, 0x112, 0xf, 0xf, true)
                : ctrl_sel == 2 ? __builtin_amdgcn_update_dpp(0, v, 0x121, 0xf, 0xf, true) : __builtin_amdgcn_update_dpp(0, v, 0x122, 0xf, 0xf, true);
    return __int_as_float(r);
}
struct EpiFFN {
    static constexpr bool PERM = true, AFTER_DRAIN = false, MIDK = false, PRE = true;
    const float* RS2; const float* cw; const float* cbias; const float* st_ffn; bf16_t* ACT; float* out; float* GE; float* G0; float* U0; LAS float* XL; int skip;
    __device__ __forceinline__ void pre(const Unit& u, int wid, int lane) const {
        if (wid < 4) { LAS float* RSL = XL + 1024; LAS float* CWL = XL + 1280;
            unsigned lo = (unsigned)lane * 4u; asm volatile("" : "+v"(lo));
            __builtin_amdgcn_global_load_lds((const unsigned*)((const char*)(RS2 + u.pm * 256 + wid * 64) + lo), (LAS unsigned*)(RSL + wid * 64), 4, 0, 0);
            const float* src = (wid < 3 ? cw + (size_t)wid * DFF : cbias) + u.pn * 128;
            __builtin_amdgcn_global_load_lds((const unsigned*)((const char*)src + lo), (LAS unsigned*)(CWL + wid * 128), 4, 0, 0);
            __builtin_amdgcn_global_load_lds((const unsigned*)((const char*)(src + 64) + lo), (LAS unsigned*)(CWL + wid * 128 + 64), 4, 0, 0); } }
    __device__ __forceinline__ void operator()(const f32x4 (&acc)[2][2][4][2], const Unit& u, int wr, int wc, int fr, int fq) const {
        if (skip) { if (acc[0][0][0][0].x == 123456.789f) out[0] = 1.f; return; }
        const int row0 = u.pm * 256 + wr * 64 + fr, f0 = u.pn * 128 + wc * 32 + 8 * fq; const bool samp = u.pm >= 64;
        LAS float* RSL = XL + 1024;
        const LAS float* CWL = XL + 1280;
        float w0[8], w1[8], w2[8], bb[8];
#pragma unroll
        for (int e = 0; e < 8; e += 4) { const int fl = wc * 32 + 8 * fq + e; const f32x4 a = *(const LAS f32x4*)(CWL + fl), b4 = *(const LAS f32x4*)(CWL + 128 + fl), c4 = *(const LAS f32x4*)(CWL + 256 + fl), d4 = *(const LAS f32x4*)(CWL + 384 + fl);
#pragma unroll
            for (int j = 0; j < 4; ++j) { w0[e + j] = a[j]; w1[e + j] = b4[j]; w2[e + j] = c4[j]; bb[e + j] = d4[j]; } }
        LAS float* xw = XL + ((wr * 4 + wc) * 2) * 32 + 8 * fq;
#pragma unroll
        for (int ai = 0; ai < 2; ++ai) if (fr >= 14) { LAS float* p = xw + ai * (2 * 4 * 2 * 32) + (fr - 14) * 32; *(LAS f32x4*)p = acc[ai][0][3][0]; *(LAS f32x4*)(p + 4) = acc[ai][0][3][1]; }
        asm volatile("s_waitcnt lgkmcnt(0)\n\ts_barrier" ::: "memory");
        float rs[2][4];
#pragma unroll
        for (int ai = 0; ai < 2; ++ai)
#pragma unroll
            for (int m = 0; m < 4; ++m) rs[ai][m] = RSL[ai * 128 + wr * 64 + m * 16 + fr];
#pragma unroll
        for (int ai = 0; ai < 2; ++ai) {
            float x0[8], x1[8]; const int pb = ai * 2 + wr;
            if (pb > 0) { const LAS float* p = XL + (((pb - 1) * 4 + wc) * 2) * 32 + 8 * fq; const f32x4 a = *(const LAS f32x4*)p, b4 = *(const LAS f32x4*)(p + 4), c4 = *(const LAS f32x4*)(p + 32), d4 = *(const LAS f32x4*)(p + 36);
                const float sa = RSL[(pb - 1) * 64 + 62], sb = RSL[(pb - 1) * 64 + 63];
#pragma unroll
                for (int j = 0; j < 4; ++j) { x0[j] = a[j] * sa; x0[4 + j] = b4[j] * sa; x1[j] = c4[j] * sb; x1[4 + j] = d4[j] * sb; } }
            else {
#pragma unroll
                for (int j = 0; j < 8; ++j) { x0[j] = 0.f; x1[j] = 0.f; } }
            float gp[8];
#pragma unroll
            for (int j = 0; j < 8; ++j) gp[j] = 0.f;
#pragma unroll
            for (int m = 0; m < 4; ++m) { const int r = row0 + ai * 128 + m * 16; const float s = rs[ai][m];
                float g[8], uu[8], q1[8], q2[8];
#pragma unroll
                for (int j = 0; j < 4; ++j) { g[j] = acc[ai][0][m][0][j] * s; g[4 + j] = acc[ai][0][m][1][j] * s; uu[j] = acc[ai][1][m][0][j] * s; uu[4 + j] = acc[ai][1][m][1][j] * s; }
#pragma unroll
                for (int j = 0; j < 8; ++j) {
                    if (m == 0) { const float s1 = dppf(g[j], 0), s2 = dppf(g[j], 1); q1[j] = (fr == 0) ? x1[j] : s1; q2[j] = (fr == 0) ? x0[j] : (fr == 1) ? x1[j] : s2; }
                    else { const float r1 = dppf(gp[j], 2), r2 = dppf(gp[j], 3);
                        q1[j] = __int_as_float(__builtin_amdgcn_update_dpp(__float_as_int(r1), __float_as_int(g[j]), 0x111, 0xf, 0xf, false));
                        q2[j] = __int_as_float(__builtin_amdgcn_update_dpp(__float_as_int(r2), __float_as_int(g[j]), 0x112, 0xf, 0xf, false)); } }
                if (samp) { const int qq = r - MP, tq = qq & 3;
                    if (tq < 2) { const float* sp = st_ffn + (size_t)(qq >> 2) * 2 * DFF + f0; const f32x4 a = *(const f32x4*)(sp + DFF), b4 = *(const f32x4*)(sp + DFF + 4);
                        if (tq == 0) { const f32x4 c4 = *(const f32x4*)sp, d4 = *(const f32x4*)(sp + 4);
#pragma unroll
                            for (int j = 0; j < 4; ++j) { q1[j] = a[j]; q1[4 + j] = b4[j]; q2[j] = c4[j]; q2[4 + j] = d4[j]; } }
                        else {
#pragma unroll
                            for (int j = 0; j < 4; ++j) { q2[j] = a[j]; q2[4 + j] = b4[j]; } } }
                    if (tq >= 2) { float* op = out + O_SFC + (size_t)((qq >> 2) * 2 + tq - 2) * DFF + f0; *(f32x4*)op = (f32x4){g[0] * SC_SFC, g[1] * SC_SFC, g[2] * SC_SFC, g[3] * SC_SFC}; *(f32x4*)(op + 4) = (f32x4){g[4] * SC_SFC, g[5] * SC_SFC, g[6] * SC_SFC, g[7] * SC_SFC}; } }
                else { const int t = r & 2047; if (t >= 2046) { float* op = out + O_PFC + (size_t)((r >> 11) * 2 + t - 2046) * DFF + f0; *(f32x4*)op = (f32x4){g[0] * SC_PFC, g[1] * SC_PFC, g[2] * SC_PFC, g[3] * SC_PFC}; *(f32x4*)(op + 4) = (f32x4){g[4] * SC_PFC, g[5] * SC_PFC, g[6] * SC_PFC, g[7] * SC_PFC}; } }
                float ov[8];
#pragma unroll
                for (int j = 0; j < 8; j += 2) {
                    typedef float f32x2 __attribute__((ext_vector_type(2)));
                    const f32x2 W0 = {w0[j], w0[j + 1]}, W1 = {w1[j], w1[j + 1]}, W2 = {w2[j], w2[j + 1]}, BB = {bb[j], bb[j + 1]}, Q2 = {q2[j], q2[j + 1]}, Q1 = {q1[j], q1[j + 1]}, GG2 = {g[j], g[j + 1]}, UU = {uu[j], uu[j + 1]};
                    const f32x2 x = W2 * GG2 + (W1 * Q1 + (W0 * Q2 + BB));
                    const f32x2 t = (x * x) * 0.044715f + 1.0f, a2 = (x * t) * (-2.302208198f);
                    f32x2 ex; ex.x = __builtin_amdgcn_exp2f(a2.x); ex.y = __builtin_amdgcn_exp2f(a2.y);
                    const f32x2 dn = ex + 1.0f; f32x2 rc; rc.x = __builtin_amdgcn_rcpf(dn.x); rc.y = __builtin_amdgcn_rcpf(dn.y);
                    const f32x2 r2 = (x * rc) * UU; ov[j] = r2.x; ov[j + 1] = r2.y; }
                u32x4 o; o.x = pk2(ov[0], ov[1]); o.y = pk2(ov[2], ov[3]); o.z = pk2(ov[4], ov[5]); o.w = pk2(ov[6], ov[7]);
                *(u32x4*)(ACT + (size_t)r * DFF + f0) = o;
                if (ai == 1 && m == 3 && wr == 1 && fr >= 14) { float* p = GE + ((size_t)u.pm * 2 + (fr - 14)) * DFF + f0; *(f32x4*)p = (f32x4){g[0], g[1], g[2], g[3]}; *(f32x4*)(p + 4) = (f32x4){g[4], g[5], g[6], g[7]}; }
                if (ai == 0 && m == 0 && wr == 0 && fr < 2) { float* p = G0 + ((size_t)u.pm * 2 + fr) * DFF + f0; *(f32x4*)p = (f32x4){g[0], g[1], g[2], g[3]}; *(f32x4*)(p + 4) = (f32x4){g[4], g[5], g[6], g[7]};
                    float* p2 = U0 + ((size_t)u.pm * 2 + fr) * DFF + f0; *(f32x4*)p2 = (f32x4){uu[0], uu[1], uu[2], uu[3]}; *(f32x4*)(p2 + 4) = (f32x4){uu[4], uu[5], uu[6], uu[7]}; }
#pragma unroll
                for (int j = 0; j < 8; ++j) gp[j] = g[j];
            }
        }
    }
};
struct EpiDown {
    static constexpr bool PERM = false, AFTER_DRAIN = false, MIDK = false, PRE = false;
    const bf16_t* XB2; float* out; float* SS; int skip;
    __device__ __forceinline__ void operator()(const f32x4 (&acc)[2][2][4][2], const Unit& u, int wr, int wc, int fr, int fq) const {
        if (skip) { if (acc[0][0][0][0].x == 123456.789f) out[0] = 1.f; return; }
        const int row0 = u.pm * 256 + wr * 64 + fr, col0 = u.pn * 256 + wc * 32 + 4 * fq;
#pragma unroll
        for (int ai = 0; ai < 2; ++ai) { u32x2 xw[4][2][2];
#pragma unroll
            for (int m = 0; m < 4; ++m)
#pragma unroll
                for (int bj = 0; bj < 2; ++bj)
#pragma unroll
                    for (int n = 0; n < 2; ++n) xw[m][bj][n] = *(const u32x2*)(XB2 + (size_t)(row0 + ai * 128 + m * 16) * DM + col0 + bj * 128 + n * 16);
#pragma unroll
            for (int m = 0; m < 4; ++m)
#pragma unroll
                for (int bj = 0; bj < 2; ++bj)
#pragma unroll
                    for (int n = 0; n < 2; ++n) EPI_PIN(xw[m][bj][n]);
#pragma unroll
            for (int m = 0; m < 4; ++m) { const int r = row0 + ai * 128 + m * 16; float ss = 0.f;
#pragma unroll
                for (int bj = 0; bj < 2; ++bj)
#pragma unroll
                    for (int n = 0; n < 2; ++n) { const size_t o = (size_t)r * DM + col0 + bj * 128 + n * 16; const u32x2 w = xw[m][bj][n]; const f32x4 v = acc[ai][bj][m][n] + (f32x4){bflo(w.x), bfhi(w.x), bflo(w.y), bfhi(w.y)};
                        *(f32x4*)(out + o) = v; ss += (v.x * v.x + v.y * v.y) + (v.z * v.z + v.w * v.w); }
                ss += __shfl_xor(ss, 16); ss += __shfl_xor(ss, 32);
                if (fq == 0) SS[(size_t)r * 32 + u.pn * 4 + wc] = ss; } }
    }
};
template <int MODE  > struct EpiSlab {
    static constexpr bool PERM = false, AFTER_DRAIN = false, MIDK = false, PRE = false;
    float* SLAB; int kslice; const bf16_t* SGM;
    __device__ __forceinline__ void operator()(const f32x4 (&acc)[2][2][4][2], const Unit& u, int wr, int wc, int fr, int fq) const {
        int pm = u.pm, pn = u.pn, s = u.ko / kslice, pass = 0;
        if (MODE == 1 && pm >= 130) { pass = 1; pm -= 66; pn -= 8; s += 4; }
        float* base = SLAB + ((size_t)s * MS + (size_t)(pm - 64) * 256 + wr * 64 + fr) * DM + pn * 256 + wc * 32 + 4 * fq;
        const bf16_t* gb = SGM + (size_t)(pm * 256 + wr * 64 + fr) * 4096 + pass * 2048 + pn * 256 + wc * 32 + 4 * fq;
#pragma unroll
        for (int ai = 0; ai < 2; ++ai)
#pragma unroll
            for (int m = 0; m < 4; ++m)
#pragma unroll
                for (int bj = 0; bj < 2; ++bj)
#pragma unroll
                    for (int n = 0; n < 2; ++n) { f32x4 v = acc[ai][bj][m][n];
                        if (MODE == 1) { const u32x2 gw = *(const u32x2*)(gb + (size_t)(ai * 128 + m * 16) * 4096 + bj * 128 + n * 16); v *= (f32x4){bflo(gw.x), bfhi(gw.x), bflo(gw.y), bfhi(gw.y)}; }
                        *(f32x4*)(base + (size_t)(ai * 128 + m * 16) * DM + bj * 128 + n * 16) = v; }
    }
};
struct SplitOrder {
    int G, c, NS, kslice, mode;
    __device__ __forceinline__ bool next(int i, Unit& u) const { const int L = i * G + c; if (L >= 16 * NS) return false; const int un = L / NS; int s = L - un * NS; u.pm = 64 + (un >> 3); u.pn = un & 7;
        if (mode == 1 && s >= NS / 2) { s -= NS / 2; u.pm += 66; u.pn += 8; } u.ko = s * kslice; return true; }
    __device__ __forceinline__ void a_ready(const Unit&) const {}
    __device__ __forceinline__ void done(const Unit&) const {}
};
struct CmpOrder {
    int G, c, base, count;
    __device__ __forceinline__ bool next(int i, Unit& u) const { const int L = i * G + c; if (L >= count) return false; u.pm = base + L; u.pn = (base + L) & 1; u.ko = 0; return true; }
    __device__ __forceinline__ void a_ready(const Unit&) const {}
    __device__ __forceinline__ void done(const Unit&) const {}
};

constexpr int RG_XC = 0, RG_WA = 34816, RG_WX = 43520, RG_A = 52224, RG_B = 68608, RG_U = 84992, RG_SA = 101376, RG_SH = 103424, RG_HC = 105472;
__device__ __forceinline__ void rglru_unit(const Frame& F, int unit, unsigned char* ldsg) {
    LAS unsigned char* lds = (LAS unsigned char*)ldsg;
    int tid = F.tid; asm volatile("" : "+v"(tid));
    const int lane = tid & 63, wid = F.wave, r32 = lane & 31, hi = lane >> 5;
    const bool samp = unit >= 256; int b = 0, n, q, grp = 0;
    if (!samp) { b = unit >> 5; n = (unit >> 2) & 7; q = unit & 3; } else { const int u2 = unit - 256; n = u2 >> 4; q = (u2 >> 2) & 3; grp = u2 & 3; }
    const int rowbase = samp ? MP + grp * 128 : b * SEQ, nchunks = samp ? 1 : 16;
    const bf16_t* XR = WSP(bf16_t, WS_XR); const bf16_t* GG = WSP(bf16_t, WS_GG); bf16_t* Y = WSP(bf16_t, WS_Y);
    LAS bf16_t* XC = (LAS bf16_t*)(lds + RG_XC); LAS bf16_t* WAT = (LAS bf16_t*)(lds + RG_WA); LAS bf16_t* WXT = (LAS bf16_t*)(lds + RG_WX);
    LAS float* As = (LAS float*)(lds + RG_A); LAS float* Bs = (LAS float*)(lds + RG_B); LAS float* Us = (LAS float*)(lds + RG_U);
    LAS float* SA = (LAS float*)(lds + RG_SA); LAS float* SH = (LAS float*)(lds + RG_SH); LAS float* HC = (LAS float*)(lds + RG_HC);
    __syncthreads();
    for (int idx = tid; idx < 4096; idx += 512) { const int c = idx >> 5, d = idx & 31; const size_t o = ((size_t)n * 128 + c) * 128 + q * 32 + d;
        WAT[d * 136 + c] = (bf16_t)(pk2(F.rwa[o], 0.f) & 0xffffu); WXT[d * 136 + c] = (bf16_t)(pk2(F.rwx[o], 0.f) & 0xffffu); }
    if (tid < 32) HC[tid] = 0.f;
    const int cg = tid & 15; float cw[4][8], cb[8];
#pragma unroll
    for (int e = 0; e < 8; ++e) { const int ch = n * 128 + cg * 8 + e; cb[e] = F.rconv_b[ch];
#pragma unroll
        for (int j = 0; j < 4; ++j) cw[j][e] = F.rconv_w[j * 1024 + ch]; }
    const int which = wid >> 2, rt = wid & 3, chd = n * 128 + q * 32 + r32;
    const float gbias = which ? F.rbx[chd] : F.rba[chd];
    const float sp8 = -8.0f * log1pf(expf(-F.rlam[chd]));
    const int sd = tid & 31, seg = tid >> 5, sch = n * 128 + q * 32 + sd;
    for (int ck = 0; ck < nchunks; ++ck) {
        const int r0 = rowbase + ck * 128;
        __syncthreads();
#pragma unroll
        for (int k = 0; k < 4; ++k) { const int item = tid + 512 * k, row = item >> 4; const int gr = r0 + row; float acc8[8];
#pragma unroll
            for (int e = 0; e < 8; ++e) acc8[e] = cb[e];
#pragma unroll
            for (int j = 0; j < 4; ++j) { float xv[8]; bool have = true;
                if (!samp) { const int t = ck * 128 + row - 3 + j; have = t >= 0;
                    if (have) { const u32x4 w = *(const u32x4*)(XR + (size_t)(gr - 3 + j) * 1024 + n * 128 + cg * 8);
                        xv[0] = bflo(w.x); xv[1] = bfhi(w.x); xv[2] = bflo(w.y); xv[3] = bfhi(w.y); xv[4] = bflo(w.z); xv[5] = bfhi(w.z); xv[6] = bflo(w.w); xv[7] = bfhi(w.w); } }
                else { const int qq = gr - MP, db = qq >> 2, tq = qq & 3, tt = tq - 3 + j;
                    if (tt >= 0) { const u32x4 w = *(const u32x4*)(XR + (size_t)(gr - 3 + j) * 1024 + n * 128 + cg * 8);
                        xv[0] = bflo(w.x); xv[1] = bfhi(w.x); xv[2] = bflo(w.y); xv[3] = bfhi(w.y); xv[4] = bflo(w.z); xv[5] = bfhi(w.z); xv[6] = bflo(w.w); xv[7] = bfhi(w.w); }
                    else { const float* sp = F.st_conv + ((size_t)db * 3 + (tq + j)) * 1024 + n * 128 + cg * 8; const f32x4 a = *(const f32x4*)sp, c4 = *(const f32x4*)(sp + 4);
                        xv[0] = a.x; xv[1] = a.y; xv[2] = a.z; xv[3] = a.w; xv[4] = c4.x; xv[5] = c4.y; xv[6] = c4.z; xv[7] = c4.w; } }
                if (have) {
#pragma unroll
                    for (int e = 0; e < 8; ++e) acc8[e] += cw[j][e] * xv[e]; } }
            u32x4 o; o.x = pk2(acc8[0], acc8[1]); o.y = pk2(acc8[2], acc8[3]); o.z = pk2(acc8[4], acc8[5]); o.w = pk2(acc8[6], acc8[7]);
            *(LAS u32x4*)(XC + row * 136 + cg * 8) = o; }
        __syncthreads();
        { f32x16 acc;
#pragma unroll
          for (int r = 0; r < 16; ++r) acc[r] = gbias;
          const LAS bf16_t* wt = which ? WXT : WAT;
#pragma unroll
          for (int ks = 0; ks < 8; ++ks) { const bf16x8 af = *(const LAS bf16x8*)(XC + (rt * 32 + r32) * 136 + ks * 16 + hi * 8); const bf16x8 bfr = *(const LAS bf16x8*)(wt + r32 * 136 + ks * 16 + hi * 8);
              acc = __builtin_amdgcn_mfma_f32_32x32x16_bf16(af, bfr, acc, 0, 0, 0); }
#pragma unroll
          for (int r = 0; r < 16; ++r) { const int row = rt * 32 + (r & 3) + 8 * (r >> 2) + 4 * hi; const float sg = sigmoidf_(acc[r]);
              if (which == 0) { const float la = sp8 * sg; As[row * 32 + r32] = expf(la); Bs[row * 32 + r32] = sqrtf(-expm1f(2.0f * la)); }
              else { Us[row * 32 + r32] = sg * bf2f(XC[row * 136 + q * 32 + r32]); } } }
        __syncthreads();
        if (!samp) { float hl[8], cl[8]; float h = 0.f, ca = 1.f;
#pragma unroll
            for (int i = 0; i < 8; ++i) { const int row = seg * 8 + i; const float a = As[row * 32 + sd], uu = Bs[row * 32 + sd] * Us[row * 32 + sd]; h = a * h + uu; ca *= a; hl[i] = h; cl[i] = ca; }
            SA[seg * 32 + sd] = ca; SH[seg * 32 + sd] = h;
            __syncthreads();
            float hin = HC[sd];
            for (int s = 0; s < seg; ++s) hin = SA[s * 32 + sd] * hin + SH[s * 32 + sd];
            float hh = 0.f;
#pragma unroll
            for (int i = 0; i < 8; ++i) { const int gr = r0 + seg * 8 + i; hh = hl[i] + cl[i] * hin; const float gg = bf2f(GG[(size_t)gr * 1024 + sch]);
                Y[(size_t)gr * 1024 + sch] = (bf16_t)(pk2(hh * gg, 0.f) & 0xffffu); }
            __syncthreads();
            if (seg == 15) { HC[sd] = hh; if (ck == nchunks - 1) F.out[O_PRH + (size_t)b * 1024 + sch] = hh * SC_PRH; }
        } else { float h = 0.f;
#pragma unroll
            for (int i = 0; i < 8; ++i) { const int row = seg * 8 + i, gr = r0 + row, qq = gr - MP, db = qq >> 2, tq = qq & 3;
                if (tq == 0) h = F.st_h[(size_t)db * 1024 + sch];
                const float a = As[row * 32 + sd], uu = Bs[row * 32 + sd] * Us[row * 32 + sd]; h = a * h + uu;
                const float gg = bf2f(GG[(size_t)gr * 1024 + sch]); Y[(size_t)gr * 1024 + sch] = (bf16_t)(pk2(h * gg, 0.f) & 0xffffu);
                if (tq == 3) F.out[O_SRH + (size_t)db * 1024 + sch] = h * SC_SRH; } }
    }
}

constexpr int RP_XRAW = 0, RP_XC = 33792, RP_WA = 68608, RP_WX = 77312, RP_A = 86016, RP_U = 102400, RP_SA = 118784, RP_SH = 120832, RP_HC = 122880;
__device__ __forceinline__ void rglru_prompt_unit(const Frame& F, int unit, unsigned char* ldsg) {
    LAS unsigned char* lds = (LAS unsigned char*)ldsg;
    int tid = F.tid; asm volatile("" : "+v"(tid));
    const int lane = tid & 63, wid = F.wave;
    const int b = unit >> 5, n = (unit >> 2) & 7, q = unit & 3, rowbase = b * SEQ;
    const bf16_t* XR = WSP(bf16_t, WS_XR); const bf16_t* GG = WSP(bf16_t, WS_GG); bf16_t* Y = WSP(bf16_t, WS_Y);
    LAS bf16_t* XRAW = (LAS bf16_t*)(lds + RP_XRAW); LAS bf16_t* XC = (LAS bf16_t*)(lds + RP_XC); LAS bf16_t* WAT = (LAS bf16_t*)(lds + RP_WA); LAS bf16_t* WXT = (LAS bf16_t*)(lds + RP_WX);
    LAS float* As = (LAS float*)(lds + RP_A); LAS float* Us = (LAS float*)(lds + RP_U);
    LAS float* SA = (LAS float*)(lds + RP_SA); LAS float* SH = (LAS float*)(lds + RP_SH); LAS float* HC = (LAS float*)(lds + RP_HC);
    __syncthreads();
    for (int idx = tid; idx < 4096; idx += 512) { const int c = idx >> 5, d = idx & 31; const size_t o = ((size_t)n * 128 + c) * 128 + q * 32 + d;
        WAT[d * 136 + c] = (bf16_t)(pk2(F.rwa[o], 0.f) & 0xffffu); WXT[d * 136 + c] = (bf16_t)(pk2(F.rwx[o], 0.f) & 0xffffu); }
    if (tid < 32) HC[tid] = 0.f;
    const int cg = tid & 15; float cw[4][8], cb[8];
#pragma unroll
    for (int e = 0; e < 8; ++e) { const int ch = n * 128 + cg * 8 + e; cb[e] = F.rconv_b[ch];
#pragma unroll
        for (int j = 0; j < 4; ++j) cw[j][e] = F.rconv_w[j * 1024 + ch]; }
    const int fr = lane & 15, fq = lane >> 4; float gba[2], gbx[2], sp8[2];
#pragma unroll
    for (int ct = 0; ct < 2; ++ct) { const int chd = n * 128 + q * 32 + ct * 16 + fr; gba[ct] = F.rba[chd]; gbx[ct] = F.rbx[chd]; sp8[ct] = -8.0f * 1.4426950409f * log1pf(expf(-F.rlam[chd])); }
    const int sd = tid & 31, seg = tid >> 5;
    const int orow = tid >> 2, ocg = tid & 3;
    u32x4 raw[5], ggp;
#pragma unroll
    for (int k = 0; k < 5; ++k) { const int p = tid + 512 * k, rr = (p >> 4) - 4; raw[k] = (u32x4){0u, 0u, 0u, 0u};
        if (p < 2112 && rr >= 0) raw[k] = *(const u32x4*)(XR + (size_t)(rowbase + rr) * 1024 + n * 128 + (p & 15) * 8); }
    ggp = *(const u32x4*)(GG + (size_t)(rowbase + orow) * 1024 + n * 128 + q * 32 + ocg * 8);
    for (int ck = 0; ck < 16; ++ck) {
        const int r0 = rowbase + ck * 128;
        __syncthreads();
#pragma unroll
        for (int k = 0; k < 5; ++k) { const int p = tid + 512 * k; if (p < 2112) *(LAS u32x4*)(XRAW + (p >> 4) * 128 + (p & 15) * 8) = raw[k]; }
        const u32x4 ggc = ggp;
        if (ck < 15) {
#pragma unroll
            for (int k = 0; k < 5; ++k) { const int p = tid + 512 * k; if (p < 2112) raw[k] = *(const u32x4*)(XR + (size_t)(r0 + 124 + (p >> 4)) * 1024 + n * 128 + (p & 15) * 8); }
            ggp = *(const u32x4*)(GG + (size_t)(r0 + 128 + orow) * 1024 + n * 128 + q * 32 + ocg * 8); }
        __syncthreads();
#pragma unroll
        for (int k = 0; k < 4; ++k) { const int row = (tid >> 4) + 32 * k; float acc8[8];
#pragma unroll
            for (int e = 0; e < 8; ++e) acc8[e] = cb[e];
#pragma unroll
            for (int j = 0; j < 4; ++j) { const u32x4 w = *(const LAS u32x4*)(XRAW + (row + 1 + j) * 128 + cg * 8);
                acc8[0] += cw[j][0] * bflo(w.x); acc8[1] += cw[j][1] * bfhi(w.x); acc8[2] += cw[j][2] * bflo(w.y); acc8[3] += cw[j][3] * bfhi(w.y);
                acc8[4] += cw[j][4] * bflo(w.z); acc8[5] += cw[j][5] * bfhi(w.z); acc8[6] += cw[j][6] * bflo(w.w); acc8[7] += cw[j][7] * bfhi(w.w); }
            u32x4 o; o.x = pk2(acc8[0], acc8[1]); o.y = pk2(acc8[2], acc8[3]); o.z = pk2(acc8[4], acc8[5]); o.w = pk2(acc8[6], acc8[7]);
            *(LAS u32x4*)(XC + row * 136 + cg * 8) = o; }
        __syncthreads();
        { f32x4 ar[2], ai[2];
#pragma unroll
          for (int ct = 0; ct < 2; ++ct) { ar[ct] = (f32x4){gba[ct], gba[ct], gba[ct], gba[ct]}; ai[ct] = (f32x4){gbx[ct], gbx[ct], gbx[ct], gbx[ct]}; }
#pragma unroll
          for (int ks = 0; ks < 4; ++ks) { const bf16x8 af = *(const LAS bf16x8*)(XC + (wid * 16 + fr) * 136 + ks * 32 + fq * 8);
#pragma unroll
              for (int ct = 0; ct < 2; ++ct) { const bf16x8 ba = *(const LAS bf16x8*)(WAT + (ct * 16 + fr) * 136 + ks * 32 + fq * 8), bx = *(const LAS bf16x8*)(WXT + (ct * 16 + fr) * 136 + ks * 32 + fq * 8);
                  ar[ct] = __builtin_amdgcn_mfma_f32_16x16x32_bf16(af, ba, ar[ct], 0, 0, 0); ai[ct] = __builtin_amdgcn_mfma_f32_16x16x32_bf16(af, bx, ai[ct], 0, 0, 0); } }
#pragma unroll
          for (int ct = 0; ct < 2; ++ct)
#pragma unroll
              for (int j = 0; j < 4; ++j) { const int row = wid * 16 + fq * 4 + j, d = ct * 16 + fr;
                  const float rg = sigmoidf_(ar[ct][j]), ig = sigmoidf_(ai[ct][j]); const float l2 = sp8[ct] * rg;
                  const float a = __builtin_amdgcn_exp2f(l2); const float x = 1.3862943611f * l2;
                  const float om = (x > -0.05f) ? -x * (1.0f + x * (0.5f + x * (0.16666667f + x * 0.041666668f))) : 1.0f - a * a;
                  As[row * 32 + d] = a; Us[row * 32 + d] = __builtin_amdgcn_sqrtf(om) * ig * bf2f(XC[row * 136 + q * 32 + d]); } }
        __syncthreads();
        float hl[8], cl[8]; float h = 0.f, ca = 1.f;
#pragma unroll
        for (int i = 0; i < 8; ++i) { const int row = seg * 8 + i; const float a = As[row * 32 + sd]; h = a * h + Us[row * 32 + sd]; ca *= a; hl[i] = h; cl[i] = ca; }
        SA[seg * 32 + sd] = ca; SH[seg * 32 + sd] = h;
        __syncthreads();
        float hin = HC[sd];
        for (int s = 0; s < seg; ++s) hin = SA[s * 32 + sd] * hin + SH[s * 32 + sd];
        float hh = 0.f;
#pragma unroll
        for (int i = 0; i < 8; ++i) { hh = hl[i] + cl[i] * hin; As[(seg * 8 + i) * 32 + sd] = hh; }
        __syncthreads();
        if (seg == 15) { HC[sd] = hh; if (ck == 15) F.out[O_PRH + (size_t)b * 1024 + n * 128 + q * 32 + sd] = hh * SC_PRH; }
        { const LAS f32x4* hp = (const LAS f32x4*)(As + orow * 32 + ocg * 8); const f32x4 h0 = hp[0], h1 = hp[1];
          u32x4 o; o.x = pk2(h0.x * bflo(ggc.x), h0.y * bfhi(ggc.x)); o.y = pk2(h0.z * bflo(ggc.y), h0.w * bfhi(ggc.y)); o.z = pk2(h1.x * bflo(ggc.z), h1.y * bfhi(ggc.z)); o.w = pk2(h1.z * bflo(ggc.w), h1.w * bfhi(ggc.w));
          *(u32x4*)(Y + (size_t)(r0 + orow) * 1024 + n * 128 + q * 32 + ocg * 8) = o; }
    }
}

#ifndef QB_OF
#define QB_OF(x) (31 - (x))
#endif
namespace att {
#ifndef ATT_THR
#define ATT_THR 8.f
#endif
constexpr float SCALE = 0.08838834764831845f, THR = ATT_THR;
constexpr int A_V = 0, A_K = 16384, A_WS = 32768, A_IMPA = 36864, A_IMPB = 70656, A_IMP = 104448, A_SEL = 112896, A_UNI = 113152, A_SC = 113408, A_Q = 115712;
#define KSWZ(row, colB) ((row) * 256 + ((colB) ^ (((row) & 7) << 4)))
#define SBAR() __builtin_amdgcn_sched_barrier(0)
__device__ __forceinline__ int v_st(int k, int c) { const int kk = (k & ~0xC) | ((k & 4) << 1) | ((k & 8) >> 1); return ((kk >> 3) * 4 + (c >> 5)) * 512 + ((kk & 7) * 32 + (c & 31)) * 2; }
__device__ __forceinline__ int v_rd_base(int lane) { return ((lane & 3) << 3) | (((lane >> 2) & 3) << 6) | (((lane >> 4) & 1) << 5) | (((lane >> 5) & 1) << 8); }
constexpr int v_rd_off(int d0, int ks, int half) { return d0 * 512 + ks * 4096 + half * 2048; }
__device__ __forceinline__ int crow(int r, int hi) { return (r & 3) + 8 * (r >> 2) + 4 * hi; }
__device__ __forceinline__ unsigned cvtpk(float lo, float hi) { return pg8::cvt_pk_bf16(lo, hi); }

__device__ __forceinline__ void mask_tile(f32x16& p0, f32x16& p1, int dq, int kstep, unsigned W, bool rowsel) {
    const float NEG = -__builtin_inff();
#pragma unroll
    for (int r = 0; r < 16; ++r) { const int c = (r & 3) + 8 * (r >> 2);
        const bool bad0 = (!rowsel) | ((unsigned)(dq - kstep * c) > W), bad1 = (!rowsel) | ((unsigned)(dq - kstep * (c + 32)) > W);
        p0[r] = bad0 ? NEG : p0[r]; p1[r] = bad1 ? NEG : p1[r]; }
}
__device__ __forceinline__ void partialSM(f32x16& p0, f32x16& p1, float& m_reg, float& mn, float& alpha) {
    float pmax = p0[0];
#pragma unroll
    for (int r = 1; r < 16; ++r) pmax = fmaxf(pmax, p0[r]);
#pragma unroll
    for (int r = 0; r < 16; ++r) pmax = fmaxf(pmax, p1[r]);
    { auto rr = __builtin_amdgcn_permlane32_swap(__float_as_uint(pmax), __float_as_uint(pmax), false, false);
      pmax = fmaxf(__uint_as_float(rr[0]), __uint_as_float(rr[1])); }
    constexpr float C2 = 1.4426950408889634f * SCALE;
    if (__builtin_expect(__all((pmax - m_reg) * SCALE <= THR), 1)) { mn = m_reg; alpha = 1.f; }
    else { mn = fmaxf(m_reg, pmax); alpha = __builtin_amdgcn_exp2f((m_reg - mn) * C2); m_reg = mn; }
    const float mnL = -mn * C2;
#pragma unroll
    for (int r = 0; r < 16; ++r) { p0[r] = __builtin_amdgcn_exp2f(fmaf(p0[r], C2, mnL)); p1[r] = __builtin_amdgcn_exp2f(fmaf(p1[r], C2, mnL)); }
}
__device__ __forceinline__ void finishSM(f32x16& p0, f32x16& p1, float alpha, float& l_reg, bf16x8& pa0, bf16x8& pa1, bf16x8& pa2, bf16x8& pa3) {
    float ps = 0;
#pragma unroll
    for (int r = 0; r < 16; ++r) ps += p0[r];
#pragma unroll
    for (int r = 0; r < 16; ++r) ps += p1[r];
    { auto rr = __builtin_amdgcn_permlane32_swap(__float_as_uint(ps), __float_as_uint(ps), false, false);
      ps = __uint_as_float(rr[0]) + __uint_as_float(rr[1]); }
    l_reg = l_reg * alpha + ps;
#define PK4(P, B_, OUT) do { unsigned a0 = cvtpk(P[B_+0], P[B_+1]), a1 = cvtpk(P[B_+2], P[B_+3]);                          \
        unsigned b0 = cvtpk(P[B_+4], P[B_+5]), b1 = cvtpk(P[B_+6], P[B_+7]);                                             \
        auto r0 = __builtin_amdgcn_permlane32_swap(a0, b0, false, false); auto r1 = __builtin_amdgcn_permlane32_swap(a1, b1, false, false); \
        u32x4 w = {r0[0], r1[0], r0[1], r1[1]}; OUT = *reinterpret_cast<bf16x8*>(&w); } while (0)
    PK4(p0, 0, pa0); PK4(p0, 8, pa1); PK4(p1, 0, pa2); PK4(p1, 8, pa3);
#undef PK4
}
template <bool QLDS>
__device__ __forceinline__ void qkt(f32x16& p0, f32x16& p1, const LAS char* K_lds, int r32, int hi, const bf16x8* qr, const LAS char* Q_lds, float bbase, float bstep) {
#pragma unroll
    for (int r = 0; r < 16; ++r) { const int c = (r & 3) + 8 * (r >> 2); p0[r] = fmaf(bstep, (float)c, bbase); p1[r] = fmaf(bstep, (float)(c + 32), bbase); }
    const LAS char* kb[4];
#pragma unroll
    for (int dd = 0; dd < 4; ++dd) kb[dd] = K_lds + KSWZ(r32, (dd * 16 + hi * 8) * 2);
#pragma unroll
    for (int d0 = 0; d0 < 8; ++d0) { const LAS char* a = kb[d0 & 3] + (d0 >> 2) * 128;
        const bf16x8 b0 = *reinterpret_cast<const LAS bf16x8*>(a);
        const bf16x8 b1 = *reinterpret_cast<const LAS bf16x8*>(a + 32 * 256);
        const bf16x8 qf = QLDS ? *reinterpret_cast<const LAS bf16x8*>(Q_lds + d0 * 1024) : qr[d0];
        p0 = __builtin_amdgcn_mfma_f32_32x32x16_bf16(b0, qf, p0, 0, 0, 0);
        p1 = __builtin_amdgcn_mfma_f32_32x32x16_bf16(b1, qf, p1, 0, 0, 0); }
}
__device__ __forceinline__ void pv_tile(f32x16* o, int vb0, bf16x8 pa0, bf16x8 pa1, bf16x8 pa2, bf16x8 pa3) {
#define TRRD(dst, off) asm volatile("ds_read_b64_tr_b16 %0, %1 offset:%2" : "=&v"(dst) : "v"(vb0), "i"(off) : "memory")
#define PV_D0(d0) do { s16x4 l0, l1, l2, l3, h0, h1, h2, h3; constexpr int b_ = v_rd_off(d0, 0, 0); \
        TRRD(l0, b_); TRRD(h0, b_ + 2048); TRRD(l1, b_ + 4096); TRRD(h1, b_ + 6144); TRRD(l2, b_ + 8192); TRRD(h2, b_ + 10240); TRRD(l3, b_ + 12288); TRRD(h3, b_ + 14336); \
        asm volatile("s_waitcnt lgkmcnt(0)" ::: "memory"); SBAR();   \
        o[d0] = __builtin_amdgcn_mfma_f32_32x32x16_bf16(pa0, (bf16x8){l0[0], l0[1], l0[2], l0[3], h0[0], h0[1], h0[2], h0[3]}, o[d0], 0, 0, 0);   \
        o[d0] = __builtin_amdgcn_mfma_f32_32x32x16_bf16(pa1, (bf16x8){l1[0], l1[1], l1[2], l1[3], h1[0], h1[1], h1[2], h1[3]}, o[d0], 0, 0, 0);   \
        o[d0] = __builtin_amdgcn_mfma_f32_32x32x16_bf16(pa2, (bf16x8){l2[0], l2[1], l2[2], l2[3], h2[0], h2[1], h2[2], h2[3]}, o[d0], 0, 0, 0);   \
        o[d0] = __builtin_amdgcn_mfma_f32_32x32x16_bf16(pa3, (bf16x8){l3[0], l3[1], l3[2], l3[3], h3[0], h3[1], h3[2], h3[3]}, o[d0], 0, 0, 0); } while (0)
    PV_D0(0); PV_D0(1); PV_D0(2); PV_D0(3);
#undef PV_D0
#undef TRRD
}
struct Tile { const void* K; const void* V; int stride; int mode  ; int nvalid; int kp0, kstep; unsigned W; int selbit; int n0; int wrow  ; };

template <bool SAMPLE>
__device__ __forceinline__ void attn_unit(const Frame& F, int uidx, unsigned char* ldsg) {
    LAS char* lds = (LAS char*)ldsg;
    int tid = F.tid; asm volatile("" : "+v"(tid));
    const int wid = F.wave, lane = tid & 63, r32 = lane & 31, hi = lane >> 5;
    int b = 0, g, qb = 32, db = 0;
    if (SAMPLE) { db = uidx >> 1; g = uidx & 1; } else { qb = QB_OF(uidx >> 4); b = (uidx & 15) >> 1; g = uidx & 1; }
    const bool active = SAMPLE ? (wid == 0) : true;
    const int hl = SAMPLE ? ((r32 & 15) >> 2) : (wid >> 1), tok = SAMPLE ? (r32 & 3) : ((wid & 1) * 32 + r32);
    const bool rowvalid = SAMPLE ? (r32 < 16) : true;
    const int t = SAMPLE ? SEQ + tok : qb * 64 + tok;
    const size_t grow = SAMPLE ? (size_t)MP + db * 4 + tok : (size_t)b * SEQ + t;
    const int head = g * 4 + hl;
    const float sl_raw = __builtin_amdgcn_exp2f(-(float)(head + 1)) * (1.0f / SCALE);
    const bf16_t* Qg = WSP(bf16_t, WS_Q); const bf16_t* KVS = WSP(bf16_t, WS_KVS); const bf16_t* KVWb = WSP(bf16_t, WS_KVW);
    const float* FS = WSP(float, WS_FS); const float* POSB = WSP(float, WS_POSB); const float* GNSA = WSP(float, WS_GNSA);
    float* OMIX = WSP(float, WS_OMIX); bf16_t* OB = WSP(bf16_t, WS_OB);
    bf16x8 qr[8]; const LAS char* Q_lds = lds + A_Q + lane * 16;
    if (SAMPLE) { __syncthreads();
        if (wid == 0) {
#pragma unroll
            for (int d0 = 0; d0 < 8; ++d0) { bf16x8 qv = *(const bf16x8*)(Qg + grow * 1024 + head * 128 + d0 * 16 + hi * 8);
#ifdef QDEGRADE
                for (int e = 0; e < 8; ++e) qv[e] &= (short)0xFFFC;
#endif
                *(LAS bf16x8*)(lds + A_Q + d0 * 1024 + lane * 16) = qv; } }
    } else {
#pragma unroll
        for (int d0 = 0; d0 < 8; ++d0) { qr[d0] = *(const bf16x8*)(Qg + grow * 1024 + head * 128 + d0 * 16 + hi * 8);
#ifdef QDEGRADE
            for (int e = 0; e < 8; ++e) qr[d0][e] &= (short)0xFFFC;
#endif
        } }
    LAS char* V_lds = lds + A_V; LAS char* K_lds = lds + A_K;
    LAS float* li_l = (LAS float*)(lds + A_WS) + wid * 64; LAS float* al_l = li_l + 32;
    LAS float* IMPA = (LAS float*)(lds + A_IMPA); LAS float* IMPB = (LAS float*)(lds + A_IMPB); LAS float* IMP = (LAS float*)(lds + A_IMP);
    LAS unsigned* SEL = (LAS unsigned*)(lds + A_SEL); LAS unsigned* UNI = (LAS unsigned*)(lds + A_UNI); LAS float* SC = (LAS float*)(lds + A_SC);
    const int vb0 = (int)(unsigned)(size_t)V_lds + v_rd_base(lane);
    const int sr = tid >> 4, sc = (tid & 15) * 8, vst0 = v_st(sr, sc), vst1 = v_st(32 + sr, sc), kws = KSWZ(sr, sc * 2);
    const int fsunit = SAMPLE ? db * 2 : 256 + b * 2;
#ifdef ATT_EQUIV
    const int ncmp = 2; const int wlo = 0;
#else
    const int ncmp = SAMPLE ? 2 : (qb >= 16 ? 2 : 1);
    const int wlo = SAMPLE ? 0 : (qb >= 8 ? qb - 8 : 0);
#endif

    float m_reg = -1e30f, l_reg = 0.f; f32x16 o[4];
#pragma unroll
    for (int d = 0; d < 4; ++d)
#pragma unroll
        for (int r = 0; r < 16; ++r) o[d][r] = 0.f;
    float sc0 = 1.f;
    unsigned sel = 0u, rem = 0u; bool own_done = false;
    int br = 0, step = 0;
    auto gen = [&](Tile& T) -> bool {
        bool have = false; T.K = nullptr; T.V = nullptr; T.stride = 0; T.mode = 0; T.nvalid = 64; T.kp0 = 0; T.kstep = 1; T.W = 0x7fffffffu; T.selbit = -1; T.n0 = 0; T.wrow = -1;
        if (br == 0) { if (step < ncmp) { have = true; T.mode = 2; T.n0 = step * 64; T.kp0 = 31 + 1024 * step; T.kstep = 16; } }
        else if (br == 1) {
            if (rem != 0u) { const int kb = __builtin_ctz(rem); rem &= rem - 1u; have = true; T.selbit = kb; T.kp0 = kb * 64;
                if (SAMPLE) { const int page = F.pt[db * 16 + (kb >> 1)]; const float* base = F.c_slc + ((size_t)page * 128 + (kb & 1) * 64) * 512 + g * 128;
                    T.K = base; T.V = base + 256; T.stride = 512; T.mode = 1; }
                else { const bf16_t* base = KVS + ((size_t)b * SEQ + kb * 64) * 512 + g * 128; T.K = base; T.V = base + 256; T.stride = 512; T.mode = 0; } }
            else if (!own_done) { own_done = true; have = true;
                if (SAMPLE) { const bf16_t* base = KVS + ((size_t)MP + db * 4) * 512 + g * 128; T.K = base; T.V = base + 256; T.stride = 512; T.nvalid = 4; T.kp0 = SEQ; }
                else { const bf16_t* base = KVS + ((size_t)b * SEQ + qb * 64) * 512 + g * 128; T.K = base; T.V = base + 256; T.stride = 512; T.kp0 = qb * 64; } } }
        else {
            if (SAMPLE) { if (step < 8) { have = true; const float* base = F.c_win + ((size_t)db * 512 + step * 64) * 512 + g * 128; T.K = base; T.V = base + 256; T.stride = 512; T.mode = 1; T.kp0 = SEQ - 512 + step * 64; T.W = 512u; T.wrow = step * 64; }
                else if (step == 8) { have = true; const bf16_t* base = KVWb + ((size_t)MP + db * 4) * 512 + g * 128; T.K = base; T.V = base + 256; T.stride = 512; T.nvalid = 4; T.kp0 = SEQ; T.W = 512u; } }
            else { const int kb = wlo + step; if (kb <= qb) { have = true; const bf16_t* base = KVWb + ((size_t)b * SEQ + kb * 64) * 512 + g * 128; T.K = base; T.V = base + 256; T.stride = 512; T.kp0 = kb * 64; T.W = 512u; } } }
        if (have) ++step;
        return have; };
    u32x4 pk0 = {0u, 0u, 0u, 0u}, pk1 = pk0, pv0 = pk0, pv1 = pk0; f32x4 fk[4], fv[4];
    auto issue = [&](const Tile& T) {
        if (T.mode == 0) { const bf16_t* Kp = (const bf16_t*)T.K; const bf16_t* Vp = (const bf16_t*)T.V; pk0 = (u32x4){0u, 0u, 0u, 0u}; pk1 = pk0; pv0 = pk0; pv1 = pk0;
            if (sr < T.nvalid) { pk0 = *(const u32x4*)(Kp + (size_t)sr * T.stride + sc); pv0 = *(const u32x4*)(Vp + (size_t)sr * T.stride + sc); }
            if (sr + 32 < T.nvalid) { pk1 = *(const u32x4*)(Kp + (size_t)(sr + 32) * T.stride + sc); pv1 = *(const u32x4*)(Vp + (size_t)(sr + 32) * T.stride + sc); } }
        else if (SAMPLE && T.mode == 1) { const float* Kp = (const float*)T.K + (size_t)sr * T.stride + sc; const float* Vp = (const float*)T.V + (size_t)sr * T.stride + sc;
            fk[0] = *(const f32x4*)Kp; fk[1] = *(const f32x4*)(Kp + 4); fk[2] = *(const f32x4*)(Kp + 32 * 512); fk[3] = *(const f32x4*)(Kp + 32 * 512 + 4);
            fv[0] = *(const f32x4*)Vp; fv[1] = *(const f32x4*)(Vp + 4); fv[2] = *(const f32x4*)(Vp + 32 * 512); fv[3] = *(const f32x4*)(Vp + 32 * 512 + 4); } };
    auto commit = [&](const Tile& T) {
        if (T.mode == 0) { *(LAS u32x4*)(K_lds + kws) = pk0; *(LAS u32x4*)(K_lds + kws + 32 * 256) = pk1; *(LAS u32x4*)(V_lds + vst0) = pv0; *(LAS u32x4*)(V_lds + vst1) = pv1; }
        else if (SAMPLE && T.mode == 1) { *(LAS u32x4*)(K_lds + kws) = pack8u(fk[0], fk[1]); *(LAS u32x4*)(K_lds + kws + 32 * 256) = pack8u(fk[2], fk[3]);
            *(LAS u32x4*)(V_lds + vst0) = pack8u(fv[0], fv[1]); *(LAS u32x4*)(V_lds + vst1) = pack8u(fv[2], fv[3]);
            if (T.wrow >= 0) {
                float* dst = F.out + O_SKW + ((size_t)db * 512) * 512 + g * 128 + sc; const int i0 = T.wrow + sr - 4;
                if (i0 >= 0) { float* p = dst + (size_t)i0 * 512; *(f32x4*)p = fk[0]; *(f32x4*)(p + 4) = fk[1]; *(f32x4*)(p + 256) = fv[0]; *(f32x4*)(p + 260) = fv[1]; }
                { float* p = dst + (size_t)(i0 + 32) * 512; *(f32x4*)p = fk[2]; *(f32x4*)(p + 4) = fk[3]; *(f32x4*)(p + 256) = fv[2]; *(f32x4*)(p + 260) = fv[3]; } } }
        else if (T.mode == 2) { const float* Fk = FS + (size_t)fsunit * 65536; const float* Fv = Fk + 65536;
#pragma unroll 1
            for (int hh = 0; hh < 2; ++hh) { const int n = T.n0 + sr + 32 * hh; u32x4 kk = {0u, 0u, 0u, 0u}, vv = kk;
                if (n <= 126) { const size_t o1 = (size_t)(g * 128 + n) * 256 + sc, o2 = (size_t)(g * 128 + n + 1) * 256 + 128 + sc;
                    { const f32x4 a0 = *(const f32x4*)(Fk + o1) + *(const f32x4*)(Fk + o2) + *(const f32x4*)(POSB + sc), a1 = *(const f32x4*)(Fk + o1 + 4) + *(const f32x4*)(Fk + o2 + 4) + *(const f32x4*)(POSB + sc + 4); kk = pack8u(a0, a1); }
                    { const f32x4 c0 = *(const f32x4*)(Fv + o1) + *(const f32x4*)(Fv + o2) + *(const f32x4*)(POSB + 128 + sc), c1 = *(const f32x4*)(Fv + o1 + 4) + *(const f32x4*)(Fv + o2 + 4) + *(const f32x4*)(POSB + 128 + sc + 4); vv = pack8u(c0, c1); } }
                *(LAS u32x4*)(K_lds + kws + hh * 32 * 256) = kk; *(LAS u32x4*)(V_lds + (hh ? vst1 : vst0)) = vv; } } };
    Tile T; bool have = gen(T);
    if (have) issue(T);
    for (;;) {
        if (!have) {
            if (active) {
                const float inv = 1.0f / fmaxf(l_reg, 1e-30f);
                if (hi == 0) li_l[r32] = rowvalid ? GNSA[grow * 32 + br * 8 + head] * inv : 0.f;
                asm volatile("s_waitcnt lgkmcnt(0)" ::: "memory");
                int r32e = r32, hie = hi; asm volatile("" : "+v"(r32e), "+v"(hie));
#pragma unroll
                for (int r = 0; r < (SAMPLE ? 8 : 16); ++r) { const int rr = crow(r, hie); const float fac = li_l[rr];
                    size_t orow; int ohead; bool ok = true;
                    if (SAMPLE) { ok = rr < 16; orow = (size_t)MP + db * 4 + (rr & 3); ohead = g * 4 + ((rr & 15) >> 2); } else { orow = (size_t)b * SEQ + qb * 64 + (wid & 1) * 32 + rr; ohead = head; }
                    if (ok) { float* pm = OMIX + orow * 1024 + ohead * 128 + r32e; bf16_t* pb = OB + orow * 1024 + ohead * 128 + r32e;
                        float v0 = o[0][r] * fac, v1 = o[1][r] * fac, v2 = o[2][r] * fac, v3 = o[3][r] * fac;
                        if (br > 0) { v0 += pm[0]; v1 += pm[32]; v2 += pm[64]; v3 += pm[96]; }
                        if (br < 2) { pm[0] = v0; pm[32] = v1; pm[64] = v2; pm[96] = v3; }
                        else { pb[0] = (bf16_t)(cvtpk(v0, 0.f) & 0xffffu); pb[32] = (bf16_t)(cvtpk(v1, 0.f) & 0xffffu); pb[64] = (bf16_t)(cvtpk(v2, 0.f) & 0xffffu); pb[96] = (bf16_t)(cvtpk(v3, 0.f) & 0xffffu); } }
                    if ((r & 7) == 7) asm volatile("" ::: "memory"); }
                if (br == 0 && rowvalid && hi == 0) { SC[(hl * 64 + tok) * 2] = sc0 * inv; SC[(hl * 64 + tok) * 2 + 1] = inv; }
            }
            if (br == 0) {
                __syncthreads();
                constexpr int NTOK = SAMPLE ? 4 : 64; const int cur = SAMPLE ? 32 : qb;
                if (tid < NTOK) {
#pragma unroll 1
                    for (int k = 0; k < 32; ++k) { float s = 0.f;
#pragma unroll
                        for (int h = 0; h < 4; ++h) { s += IMPA[(h * 64 + tid) * 33 + k] * SC[(h * 64 + tid) * 2 + (k >> 4)]; if (k > 0) s += IMPB[(h * 64 + tid) * 33 + k - 1] * SC[(h * 64 + tid) * 2 + ((k - 1) >> 4)]; }
                        IMP[tid * 33 + k] = s; }
                    unsigned mask = 0u;
                    if (cur >= 1) { if (cur <= 7) mask = (1u << (cur & 31)) - 1u;
                        else { mask = 1u;
#pragma unroll 1
                            for (int it = 0; it < 6; ++it) { float best = -1.f; int bi = 0;
#pragma unroll 1
                                for (int k = 1; k < cur; ++k) { const float v = IMP[tid * 33 + k]; if (!((mask >> k) & 1u) && v > best) { best = v; bi = k; } }
                                mask |= 1u << bi; } } }
                    SEL[tid] = mask;
#ifdef ATT_CHECK
                    if (!SAMPLE) ((unsigned*)(F.ws + (size_t)1272 * MiB))[(b * 2 + g) * 2048 + qb * 64 + tid] = mask;
#endif
                }
                __syncthreads();
                if (wid == 0) { unsigned v = (lane < NTOK) ? SEL[lane] : 0u;
#pragma unroll
                    for (int off = 1; off < 64; off <<= 1) v |= __shfl_xor(v, off);
                    if (lane == 0) UNI[0] = v; }
                __syncthreads();
                rem = UNI[0]; sel = SEL[tok];
            }
            ++br; step = 0; if (br == 3) break;
            m_reg = -1e30f; l_reg = 0.f;
#pragma unroll
            for (int d = 0; d < 4; ++d)
#pragma unroll
                for (int r = 0; r < 16; ++r) o[d][r] = 0.f;
            have = gen(T); if (have) issue(T);
            continue;
        }
        asm volatile("s_waitcnt lgkmcnt(0)\n\ts_barrier" ::: "memory");
        commit(T);
        Tile TN; const bool have_n = gen(TN);
        if (have_n) issue(TN);
        asm volatile("s_waitcnt lgkmcnt(0)\n\ts_barrier" ::: "memory");
        if (active) {
            f32x16 p0, p1; float mn, al; bf16x8 pa0, pa1, pa2, pa3;
            const bool rowsel = rowvalid && (T.selbit < 0 || ((sel >> T.selbit) & 1u));
            const float bstep = sl_raw * (float)T.kstep, bbase = rowsel ? sl_raw * (float)(T.kp0 + T.kstep * 4 * hi) : -__builtin_inff();
            qkt<SAMPLE>(p0, p1, K_lds, r32, hi, qr, Q_lds, bbase, bstep);
            { const int kpl = T.kp0 + 63 * T.kstep, tlo = SAMPLE ? SEQ : t - r32, thi = tlo + (SAMPLE ? 3 : 31);
              if (kpl > tlo || (T.W < 0x7fffffffu && thi - T.kp0 > (int)T.W)) mask_tile(p0, p1, t - T.kp0 - T.kstep * 4 * hi, T.kstep, T.W, true); }
            partialSM(p0, p1, m_reg, mn, al);
            if (__any(al < 1.f)) { if (hi == 0) al_l[r32] = al; asm volatile("s_waitcnt lgkmcnt(0)" ::: "memory");
#pragma unroll
                for (int d_ = 0; d_ < 4; ++d_)
#pragma unroll
                    for (int r = 0; r < 16; ++r) o[d_][r] *= al_l[crow(r, hi)];
                if (br == 0 && T.n0 > 0) sc0 *= al; }
            if (br == 0 && rowvalid) { const int rowi = (hl * 64 + tok) * 33 + (T.n0 >> 2) + hi;
#pragma unroll
                for (int j = 0; j < 4; ++j) { IMPA[rowi + 2 * j] = (p0[4 * j] + p0[4 * j + 1]) + (p0[4 * j + 2] + p0[4 * j + 3]); IMPB[rowi + 2 * j] = p0[4 * j + 3];
                    IMPA[rowi + 8 + 2 * j] = (p1[4 * j] + p1[4 * j + 1]) + (p1[4 * j + 2] + p1[4 * j + 3]); IMPB[rowi + 8 + 2 * j] = p1[4 * j + 3]; } }
            finishSM(p0, p1, al, l_reg, pa0, pa1, pa2, pa3);
            pv_tile(o, vb0, pa0, pa1, pa2, pa3);
        }
        T = TN; have = have_n;
    }
}
}

#ifdef ATT_CHECK
__device__ __forceinline__ float bfr(float x) { return __uint_as_float(pk2(x, 0.f) << 16); }
__device__ __forceinline__ void att_check(const Frame& F, unsigned char* ldsg) {
    LAS float* L = (LAS float*)ldsg;
    LAS float* Qs = L;
    LAS float* Ss = L + 512;
    LAS float* Oc = L + 512 + 2560;
    LAS float* IMPs = Oc + 1536;
    LAS int* KP = (LAS int*)(IMPs + 32);
    LAS float* RED = (LAS float*)(KP + 640);
    LAS unsigned* MSK = (LAS unsigned*)(RED + 1024);
    const int tid = F.tid, bid = F.bid;
    const int b = bid & 7, g = (bid >> 3) & 1, t = (bid * CHK_MUL + CHK_ADD) & 2047;
    const size_t row = (size_t)b * SEQ + t;
    const bf16_t* Qg = WSP(bf16_t, WS_Q); const bf16_t* KVS = WSP(bf16_t, WS_KVS); const bf16_t* KVWb = WSP(bf16_t, WS_KVW);
    const float* FS = WSP(float, WS_FS); const float* POSB = WSP(float, WS_POSB); const float* GNSA = WSP(float, WS_GNSA); const bf16_t* OB = WSP(bf16_t, WS_OB);
    const float SCL = 0.08838834764831845f;
    __syncthreads();
    { const int h = tid >> 7, d = tid & 127; float qv = bf2f(Qg[row * 1024 + (g * 4 + h) * 128 + d]);
#ifdef CHK_QNOISE
      { unsigned hsh = (unsigned)(row * 1024 + (g * 4 + h) * 128 + d) * 2654435761u; hsh ^= hsh >> 15; hsh *= 2246822519u; hsh ^= hsh >> 13; qv *= 1.0f + CHK_QNOISE * ((float)(hsh & 0xffff) * (1.0f / 32768.0f) - 1.0f); }
#endif
      Qs[h * 128 + d] = qv; }
    __syncthreads();
    const int hh = tid >> 7, dd = tid & 127; const float slope = exp2f(-(float)(g * 4 + hh + 1));
    const float* Fk = FS + (size_t)(256 + b * 2) * 65536; const float* Fv = Fk + 65536;
    const int ncv = t >= 31 ? (t - 31) / 16 + 1 : 0;
    { const int n = dd; float s = -INFINITY;
      if (n < ncv && n <= 126) { float acc = 0.f; for (int d = 0; d < 128; ++d) { const float kc = bfr(Fk[(size_t)(g * 128 + n) * 256 + d] + Fk[(size_t)(g * 128 + n + 1) * 256 + 128 + d] + POSB[d]); acc += Qs[hh * 128 + d] * kc; }
          s = acc * SCL + slope * (float)(16 * n + 31); }
      Ss[hh * 640 + n] = s; }
    __syncthreads();
    if (tid < 4) { float mx = -INFINITY; for (int n = 0; n < 128; ++n) mx = fmaxf(mx, Ss[tid * 640 + n]); float sum = 0.f;
        for (int n = 0; n < 128; ++n) { const float e = (Ss[tid * 640 + n] == -INFINITY) ? 0.f : expf(Ss[tid * 640 + n] - mx); Ss[tid * 640 + n] = e; sum += e; }
        const float inv = 1.0f / fmaxf(sum, 1e-30f); for (int n = 0; n < 128; ++n) Ss[tid * 640 + n] *= inv; }
    __syncthreads();
    { float acc = 0.f; for (int n = 0; n < ncv && n <= 126; ++n) { const float kv = bfr(Fv[(size_t)(g * 128 + n) * 256 + dd] + Fv[(size_t)(g * 128 + n + 1) * 256 + 128 + dd] + POSB[128 + dd]); acc += Ss[hh * 640 + n] * kv; }
      Oc[(0 * 4 + hh) * 128 + dd] = acc; }
    if (tid < 32) { float s = 0.f; for (int h = 0; h < 4; ++h) for (int n = 4 * tid - 1; n <= 4 * tid + 3; ++n) if (n >= 0 && n < 127) s += Ss[h * 640 + n]; IMPs[tid] = s; }
    __syncthreads();
    const int cur = t >> 6;
    if (tid == 0) { unsigned mask = 0u;
        if (cur >= 1) { if (cur <= 7) mask = (1u << cur) - 1u; else { mask = 1u;
            for (int it = 0; it < 6; ++it) { float best = -1.f; int bi = 0; for (int k = 1; k < cur; ++k) { const float v = IMPs[k]; if (!((mask >> k) & 1u) && v > best) { best = v; bi = k; } } mask |= 1u << bi; } } }
        const unsigned kmask = ((const unsigned*)(F.ws + (size_t)1272 * MiB))[(b * 2 + g) * 2048 + t];
        MSK[2] = (kmask != mask) ? 1u : 0u;
#if CHK_USE_KMASK
        mask = kmask;
#endif
        int nk = 0; for (int k = 0; k < 32; ++k) if ((mask >> k) & 1u) for (int i = 0; i < 64; ++i) KP[nk++] = k * 64 + i;
        for (int s = cur * 64; s <= t; ++s) KP[nk++] = s;
        MSK[0] = mask; MSK[1] = (unsigned)nk; }
    __syncthreads();
    for (int br = 1; br <= 2; ++br) {
        const bf16_t* KV = (br == 1) ? KVS : KVWb; const int wl = t - 512 > 0 ? t - 512 : 0; const int nk = (br == 1) ? (int)MSK[1] : t - wl + 1;
        __syncthreads();
        for (int j = dd; j < 640; j += 128) { float s = -INFINITY;
            if (j < nk) { const int kp = (br == 1) ? KP[j] : wl + j; const bf16_t* kr = KV + ((size_t)b * SEQ + kp) * 512 + g * 128; float acc = 0.f; for (int d = 0; d < 128; ++d) acc += Qs[hh * 128 + d] * bf2f(kr[d]);
                s = acc * SCL + slope * (float)kp; }
            Ss[hh * 640 + j] = s; }
        __syncthreads();
        if (tid < 4) { float mx = -INFINITY; for (int n = 0; n < 640; ++n) mx = fmaxf(mx, Ss[tid * 640 + n]); float sum = 0.f;
            for (int n = 0; n < 640; ++n) { const float e = (Ss[tid * 640 + n] == -INFINITY) ? 0.f : expf(Ss[tid * 640 + n] - mx); Ss[tid * 640 + n] = e; sum += e; }
            const float inv = 1.0f / fmaxf(sum, 1e-30f); for (int n = 0; n < 640; ++n) Ss[tid * 640 + n] *= inv; }
        __syncthreads();
        { float acc = 0.f; for (int j = 0; j < nk; ++j) { const int kp = (br == 1) ? KP[j] : wl + j; acc += Ss[hh * 640 + j] * bf2f(KV[((size_t)b * SEQ + kp) * 512 + 256 + g * 128 + dd]); }
          Oc[(br * 4 + hh) * 128 + dd] = acc; }
    }
    __syncthreads();
    { const int head = g * 4 + hh; float ref = 0.f; for (int br = 0; br < 3; ++br) ref += GNSA[row * 32 + br * 8 + head] * Oc[(br * 4 + hh) * 128 + dd];
      const float mine = bf2f(OB[row * 1024 + head * 128 + dd]); RED[tid] = (mine - ref) * (mine - ref); RED[512 + tid] = ref * ref; }
    __syncthreads();
    if (tid == 0) { float e2 = 0.f, r2 = 0.f; for (int i = 0; i < 512; ++i) { e2 += RED[i]; r2 += RED[512 + i]; }
#if CHK_SELONLY
        if (MSK[2]) {
#else
        if (e2 > CHK_TOL * r2) {
#endif
          const float v = CHK_VEXPR;
            F.out[O_PRH + bid] = v; } }
}
#endif

#ifndef P7_ROWS
#define P7_ROWS 16
#endif
__device__ __forceinline__ void p7_act(const Frame& F) {
    const bf16_t* GB = WSP(bf16_t, WS_GB); const bf16_t* UB = WSP(bf16_t, WS_UB); bf16_t* ACT = WSP(bf16_t, WS_ACT);
    const int gt = F.bid * 512 + F.tid, NT = F.G * 512;
    for (int idx = gt; idx < (M / P7_ROWS) * 768; idx += NT) { const int cgp = idx % 768, r0 = (idx / 768) * P7_ROWS, c = cgp * 8; const bool samp = r0 >= MP;
        float w0[8], w1[8], w2[8], bb[8], g2[8], g1[8];
#pragma unroll
        for (int e = 0; e < 8; e += 4) { const f32x4 a = *(const f32x4*)(F.fconv_w + c + e), b4 = *(const f32x4*)(F.fconv_w + DFF + c + e), c4 = *(const f32x4*)(F.fconv_w + 2 * DFF + c + e), d4 = *(const f32x4*)(F.fconv_b + c + e);
#pragma unroll
            for (int j = 0; j < 4; ++j) { w0[e + j] = a[j]; w1[e + j] = b4[j]; w2[e + j] = c4[j]; bb[e + j] = d4[j]; } }
        if (!samp && (r0 & 2047) != 0) { const u32x4 a = *(const u32x4*)(GB + (size_t)(r0 - 2) * DFF + c), b4 = *(const u32x4*)(GB + (size_t)(r0 - 1) * DFF + c);
            g2[0] = bflo(a.x); g2[1] = bfhi(a.x); g2[2] = bflo(a.y); g2[3] = bfhi(a.y); g2[4] = bflo(a.z); g2[5] = bfhi(a.z); g2[6] = bflo(a.w); g2[7] = bfhi(a.w);
            g1[0] = bflo(b4.x); g1[1] = bfhi(b4.x); g1[2] = bflo(b4.y); g1[3] = bfhi(b4.y); g1[4] = bflo(b4.z); g1[5] = bfhi(b4.z); g1[6] = bflo(b4.w); g1[7] = bfhi(b4.w); }
        else {
#pragma unroll
            for (int e = 0; e < 8; ++e) { g2[e] = 0.f; g1[e] = 0.f; } }
#pragma unroll 4
        for (int i = 0; i < P7_ROWS; ++i) { const int r = r0 + i;
            if (samp && (i & 3) == 0) { const int db = (r - MP) >> 2; const float* sp = F.st_ffn + (size_t)db * 2 * DFF + c;
                const f32x4 a = *(const f32x4*)sp, a2 = *(const f32x4*)(sp + 4), b4 = *(const f32x4*)(sp + DFF), b5 = *(const f32x4*)(sp + DFF + 4);
#pragma unroll
                for (int j = 0; j < 4; ++j) { g2[j] = a[j]; g2[4 + j] = a2[j]; g1[j] = b4[j]; g1[4 + j] = b5[j]; } }
            const u32x4 gw = *(const u32x4*)(GB + (size_t)r * DFF + c), uw = *(const u32x4*)(UB + (size_t)r * DFF + c);
            float g0[8], uu[8], ov[8];
            g0[0] = bflo(gw.x); g0[1] = bfhi(gw.x); g0[2] = bflo(gw.y); g0[3] = bfhi(gw.y); g0[4] = bflo(gw.z); g0[5] = bfhi(gw.z); g0[6] = bflo(gw.w); g0[7] = bfhi(gw.w);
            uu[0] = bflo(uw.x); uu[1] = bfhi(uw.x); uu[2] = bflo(uw.y); uu[3] = bfhi(uw.y); uu[4] = bflo(uw.z); uu[5] = bfhi(uw.z); uu[6] = bflo(uw.w); uu[7] = bfhi(uw.w);
#pragma unroll
            for (int e = 0; e < 8; ++e) { const float pre = bb[e] + w0[e] * g2[e] + w1[e] * g1[e] + w2[e] * g0[e]; ov[e] = gelu_tanh(pre) * uu[e]; g2[e] = g1[e]; g1[e] = g0[e]; }
            u32x4 o; o.x = pk2(ov[0], ov[1]); o.y = pk2(ov[2], ov[3]); o.z = pk2(ov[4], ov[5]); o.w = pk2(ov[6], ov[7]);
            *(u32x4*)(ACT + (size_t)r * DFF + c) = o; } }
}
#ifndef ROWSC
#define ROWSC(m) 1.0f
#endif
__device__ __forceinline__ void p9_final(const Frame& F) {
    const int gw = F.bid * 8 + F.wave, NGW = F.G * 8, lane = F.lane; const float* SS = WSP(float, WS_SS3);
    f32x4 gv[8];
#pragma unroll
    for (int j = 0; j < 8; ++j) gv[j] = ((const f32x4*)F.norm_final)[lane + 64 * j];
    if (F.wave < 2) for (int s = F.wave * F.G + F.bid; s < MS; s += 2 * F.G) { const int m = MP + s; f32x4* row = (f32x4*)(F.out + (size_t)m * DM);
            const bf16_t* xb = WSP(bf16_t, WS_XB2) + (size_t)m * DM; const float* sl = WSP(float, WS_SLAB) + (size_t)(m - MP) * DM; f32x4 v[8]; float ss = 0.f;
#pragma unroll
            for (int j = 0; j < 8; ++j) { const u32x2 xw = *((const u32x2*)xb + lane + 64 * j); f32x4 a = {bflo(xw.x), bfhi(xw.x), bflo(xw.y), bfhi(xw.y)};
#pragma unroll 4
                for (int ks = 0; ks < 16; ++ks) a += *((const f32x4*)(sl + (size_t)ks * MS * DM) + lane + 64 * j);
                v[j] = a; ss += (a.x * a.x + a.y * a.y) + (a.z * a.z + a.w * a.w); }
            const float rs = 1.0f / sqrtf(wave_sum(ss) * (1.0f / DM) + EPS);
#pragma unroll
            for (int j = 0; j < 8; ++j) row[lane + 64 * j] = v[j] * (rs * SC_YS) * gv[j]; }
    { int m = gw; f32x4 cur[8]; float cs = 0.f;
      if (m < MP) { const f32x4* row = (const f32x4*)(F.out + (size_t)m * DM);
#pragma unroll
          for (int j = 0; j < 8; ++j) cur[j] = row[lane + 64 * j];
          cs = lane < 32 ? SS[(size_t)m * 32 + lane] : 0.f; }
#pragma unroll 1
      for (; m < MP; m += NGW) { const int mn = (m + NGW) < MP ? (m + NGW) : m; const f32x4* rown = (const f32x4*)(F.out + (size_t)mn * DM); f32x4 nx[8];
#pragma unroll
          for (int j = 0; j < 8; ++j) nx[j] = rown[lane + 64 * j];
          const float ns = lane < 32 ? SS[(size_t)mn * 32 + lane] : 0.f;
          const float rs = 1.0f / sqrtf(wave_sum(cs) * (1.0f / DM) + EPS); f32x4* row = (f32x4*)(F.out + (size_t)m * DM);
#pragma unroll
          for (int j = 0; j < 8; ++j) row[lane + 64 * j] = cur[j] * (rs * SC_YP * ROWSC(m)) * gv[j];
#pragma unroll
          for (int j = 0; j < 8; ++j) cur[j] = nx[j];
          cs = ns; } }
}

#ifndef PG_SP2
#define PG_SP2 true
#endif
#ifndef PG_ALIGN
#define PG_ALIGN true
#endif
__global__ void __launch_bounds__(512, 2) fwd(Args args) {
    extern __shared__ __attribute__((aligned(16))) unsigned char lds[];
    Frame F;
    F.tid = threadIdx.x; F.lane = F.tid & 63; F.wave = __builtin_amdgcn_readfirstlane(F.tid >> 6); F.G = gridDim.x; F.bid = blockIdx.x;
    F.x_p = (const float*)args.in[0]; F.x_s = (const float*)args.in[1]; F.c_cmp = (const float*)args.in[2]; F.c_slc = (const float*)args.in[3]; F.c_win = (const float*)args.in[4];
    F.st_h = (const float*)args.in[5]; F.st_conv = (const float*)args.in[6]; F.st_ffn = (const float*)args.in[7]; F.pt = (const int*)args.in[8];
    F.norm_mix = (const float*)args.in[9]; F.w_in = (const float*)args.in[10]; F.rconv_w = (const float*)args.in[11]; F.rconv_b = (const float*)args.in[12];
    F.rwa = (const float*)args.in[13]; F.rba = (const float*)args.in[14]; F.rwx = (const float*)args.in[15]; F.rbx = (const float*)args.in[16]; F.rlam = (const float*)args.in[17];
    F.cmp_w = (const float*)args.in[18]; F.cmp_pos = (const float*)args.in[19]; F.w_pr = (const float*)args.in[20]; F.w_pa = (const float*)args.in[21]; F.w_out = (const float*)args.in[22];
    F.norm_ffn = (const float*)args.in[23]; F.w_gate = (const float*)args.in[24]; F.w_up = (const float*)args.in[25]; F.fconv_w = (const float*)args.in[26]; F.fconv_b = (const float*)args.in[27];
    F.w_down = (const float*)args.in[28]; F.norm_final = (const float*)args.in[29];
    F.out = args.out; F.ws = args.ws;
    LAS unsigned char* ldsl = (LAS unsigned char*)lds;
    volatile LAS unsigned* MISC = (volatile LAS unsigned*)(ldsl + MISC_OFF);
    if (F.tid < 32) MISC[F.tid] = 0u;
    __syncthreads();
    const int lo = args.ph_lo, hi = args.ph_hi;
    const bool multi = (hi - lo) > 1;
    XcdBarrier bar; bar.bar = (unsigned*)(F.ws + WS_CTL) + CW_BAR; bar.x = 0; bar.st = nullptr;
    if (multi) bar = xcd_barrier_post((unsigned*)(F.ws + WS_CTL) + CW_BAR, MISC + 8);
#ifndef PH_MASK
#define PH_MASK 0xfff
#endif
#define IN(k) (((PH_MASK >> (k)) & 1) && lo <= (k) && (k) < hi)
#ifndef SEAM_REP
#define SEAM_REP 1
#endif
#define SEAM(k) do { if (IN(k) && IN((k) + 1)) { for (int rep_ = 0; rep_ < SEAM_REP; ++rep_) xcd_barrier(bar); } } while (0)

    #ifdef REPEAT_P0SKIP
    if (IN(0)) { p0_prologue(F, lds, args.qhi < 0 ? args.qlo : 0); } SEAM(0);
#else
    if (IN(0)) { p0_prologue(F, lds, 0); } SEAM(0);
#endif
        const int P1_BUSY = ((M / 256) * (N1 / 256)) % F.G;
    const int NEARLY = P1_BUSY > 0 ? ((F.G - P1_BUSY) < 256 ? (F.G - P1_BUSY) : 256) : 0;
    const int NCMP2 = NCU_UNITS - NEARLY;
#ifdef REPEAT_LD
    const int ld1 = (args.qhi < 0 && args.qlo > 0) ? args.qlo : DM;
#else
    constexpr int ld1 = DM;
#endif
    if (IN(1)) { pg8::Gemm g{WSP(bf16_t, WS_XB), WSP(bf16_t, WS_W1T), M, N1, DM, ld1, ld1};
#ifdef REPEAT_SWAPBUF
        if (args.qhi < 0) { g.A = WSP(bf16_t, WS_XB2); g.Bt = WSP(bf16_t, WS_WG); }
#endif
 pg8::StaticOrder S; S.init(M, N1, F.G, F.bid);
#ifdef REPEAT_WGM
        if (args.qhi < 0) S.wgm = REPEAT_WGM;
#endif

        EpiIn E{WSP(float, WS_RSTD1), WSP(bf16_t, WS_XR), WSP(bf16_t, WS_GG), WSP(bf16_t, WS_Q), WSP(bf16_t, WS_KVS), WSP(bf16_t, WS_KVW), WSP(bf16_t, WS_CC), WSP(bf16_t, WS_SGM), WSP(float, WS_GNSA), F.out, args.qhi < 0, (LAS float*)(ldsl + XL_OFF) + 1024};
        pg8::gemm_phase<EpiIn, pg8::StaticOrder, PG_ALIGN, PG_SP2>(ldsl, g, S, E);
        if (F.bid >= P1_BUSY && NEARLY > 0) {
            pg8::Gemm gc{WSP(bf16_t, WS_CC), WSP(bf16_t, WS_WC), NCU_UNITS * 256, 512, 2048, 2048, 2048}; CmpOrder Sc{NEARLY, F.bid - P1_BUSY, 0, NEARLY}; EpiFS Ec{WSP(float, WS_FS)};
            pg8::gemm_phase<EpiFS, CmpOrder, PG_ALIGN, PG_SP2>(ldsl, gc, Sc, Ec); } } SEAM(1);

#ifdef REPEAT_P2SKIP
    const int p2skip = args.qhi < 0 ? args.qlo : 0;
#else
    constexpr int p2skip = 0;
#endif
    if (IN(2)) {
        { LAS float* red = (LAS float*)(ldsl + XL_OFF);
          for (int e = F.bid; e < 256; e += F.G) { float s = 0.f; for (int w = F.tid; w < F.G; w += 512) s += WSP(float, WS_POSP)[w * 256 + e];
              s = wave_sum(s); if (F.lane == 0) red[F.wave] = s; __syncthreads();
              if (F.tid == 0) WSP(float, WS_POSB)[e] = ((red[0] + red[1]) + (red[2] + red[3])) + ((red[4] + red[5]) + (red[6] + red[7])); __syncthreads(); } }
        if (!(p2skip & 1)) { pg8::Gemm g{WSP(bf16_t, WS_CC), WSP(bf16_t, WS_WC), NCU_UNITS * 256, 512, 2048, 2048, 2048}; CmpOrder S{F.G, F.bid, NEARLY, NCMP2}; EpiFS E{WSP(float, WS_FS)};
          pg8::gemm_phase<EpiFS, CmpOrder, PG_ALIGN, PG_SP2>(ldsl, g, S, E); }
        if (!(p2skip & 2)) for (int u = F.bid; u < 256; u += F.G) rglru_prompt_unit(F, u, lds);
        if (!(p2skip & 4)) for (int u = 256 + (F.G - 1 - F.bid); u < 384; u += F.G) rglru_unit(F, u, lds);
        __syncthreads(); if (!(p2skip & 8)) tr_deferred(F, lds, TR_A1, TR_A2 + TR_GDEF, NCMP2, F.G); } SEAM(2);
    if (IN(3)) {
        unsigned* qhead = (unsigned*)(F.ws + WS_CTL) + CW_QUEUE;
        for (;;) {
            if (F.tid == 0) MISC[16] = __hip_atomic_fetch_add(qhead, 1u, __ATOMIC_RELAXED, __HIP_MEMORY_SCOPE_AGENT);
            __syncthreads(); const int u = args.qlo + (int)MISC[16]; __syncthreads();
            if (u >= args.qhi) break;
            if (u < 512 && (u & 1)) att::attn_unit<true>(F, u >> 1, lds);
            else { const int gg = u < 512 ? 1 : 0, pp = u < 512 ? (u >> 1) : u - 512, qb = 31 - (pp >> 3), bb = pp & 7; att::attn_unit<false>(F, (31 - qb) * 16 + bb * 2 + gg, lds); } } } SEAM(3);
    if (IN(4)) { pg8::StaticOrder S; S.init(MP, DM, F.G, F.bid);
#ifdef PROJ_MERGED
        { pg8::Gemm g{WSP(bf16_t, WS_Y), WSP(bf16_t, WS_WPR), MP, DM, 2048, 1024, 1024, WSP(bf16_t, WS_OB), WSP(bf16_t, WS_WPA)}; EpiProjM E{WSP(bf16_t, WS_SGM), WSP(bf16_t, WS_MB)}; pg8::gemm_phase<EpiProjM, pg8::StaticOrder, PG_ALIGN, PG_SP2>(ldsl, g, S, E); }
#else
        { pg8::Gemm g{WSP(bf16_t, WS_Y), WSP(bf16_t, WS_WPR), MP, DM, 1024, 1024, 1024}; EpiProj<0> E{WSP(bf16_t, WS_SGM), WSP(bf16_t, WS_T1), WSP(bf16_t, WS_MB)}; pg8::gemm_phase<EpiProj<0>, pg8::StaticOrder, PG_ALIGN, PG_SP2>(ldsl, g, S, E); }
        { pg8::Gemm g{WSP(bf16_t, WS_OB), WSP(bf16_t, WS_WPA), MP, DM, 1024, 1024, 1024}; EpiProj<1> E{WSP(bf16_t, WS_SGM), WSP(bf16_t, WS_T1), WSP(bf16_t, WS_MB)}; pg8::gemm_phase<EpiProj<1>, pg8::StaticOrder, PG_ALIGN, PG_SP2>(ldsl, g, S, E); }
#endif
        { pg8::Gemm g{WSP(bf16_t, WS_Y), WSP(bf16_t, WS_WPR), 2 * M, DM, 256, 1024, 1024}; SplitOrder T{F.G, F.bid, 8, 256, 1}; EpiSlab<1> E{WSP(float, WS_SLAB2), 256, WSP(bf16_t, WS_SGM)};
          pg8::gemm_phase<EpiSlab<1>, SplitOrder, PG_ALIGN, PG_SP2>(ldsl, g, T, E); } } SEAM(4);
    if (IN(5)) {
        const int gt = F.bid * 512 + F.tid, NT = F.G * 512; const float* sl = WSP(float, WS_SLAB2); bf16_t* MB = WSP(bf16_t, WS_MB);
        for (int i = gt; i < MS * 256; i += NT) { const size_t o = (size_t)i * 8; f32x4 a = *(const f32x4*)(sl + o), b4 = *(const f32x4*)(sl + o + 4);
#pragma unroll
            for (int s = 1; s < 8; ++s) { a += *(const f32x4*)(sl + (size_t)s * MS * DM + o); b4 += *(const f32x4*)(sl + (size_t)s * MS * DM + o + 4); }
            *(u32x4*)(MB + (size_t)MP * DM + o) = pack8u(a, b4); } } SEAM(5);
    if (IN(6)) { { pg8::Gemm g{WSP(bf16_t, WS_MB), WSP(bf16_t, WS_WO), MP, DM, DM, DM, DM}; pg8::StaticOrder S; S.init(MP, DM, F.G, F.bid);
          EpiOut E{WSP(bf16_t, WS_XB), WSP(bf16_t, WS_XB2), WSP(float, WS_SS2)}; pg8::gemm_phase<EpiOut, pg8::StaticOrder, PG_ALIGN, PG_SP2>(ldsl, g, S, E); }
        { pg8::Gemm g{WSP(bf16_t, WS_MB), WSP(bf16_t, WS_WO), M, DM, 256, DM, DM}; SplitOrder T{F.G, F.bid, 8, 256, 0}; EpiSlab<0> E{WSP(float, WS_SLAB2), 256, nullptr};
          pg8::gemm_phase<EpiSlab<0>, SplitOrder, PG_ALIGN, PG_SP2>(ldsl, g, T, E); } } SEAM(6);
    if (IN(7)) {
        const int NGW = F.G * 8, lane = F.lane; const float* sl = WSP(float, WS_SLAB2); const bf16_t* XB = WSP(bf16_t, WS_XB); bf16_t* XB2 = WSP(bf16_t, WS_XB2); float* SS = WSP(float, WS_SS2); float* RS2 = WSP(float, WS_RSTD2);
        LAS float* red = (LAS float*)(ldsl + XL_OFF);
        for (int it0 = F.bid * 8; it0 < MS * 4; it0 += NGW) { const int it = it0 + F.wave, r = it >> 2, q = it & 3; const size_t o = (size_t)r * DM + q * 512 + lane * 8; const u32x4 xw = *(const u32x4*)(XB + (size_t)MP * DM + o);
            f32x4 a = {bflo(xw.x), bfhi(xw.x), bflo(xw.y), bfhi(xw.y)}, b4 = {bflo(xw.z), bfhi(xw.z), bflo(xw.w), bfhi(xw.w)};
#pragma unroll
            for (int s = 0; s < 8; ++s) { a += *(const f32x4*)(sl + (size_t)s * MS * DM + o); b4 += *(const f32x4*)(sl + (size_t)s * MS * DM + o + 4); }
            *(u32x4*)(XB2 + (size_t)MP * DM + o) = pack8u(a, b4);
            float ss = (a.x * a.x + a.y * a.y) + (a.z * a.z + a.w * a.w) + (b4.x * b4.x + b4.y * b4.y) + (b4.z * b4.z + b4.w * b4.w); ss = wave_sum(ss);
            if (lane == 0) red[F.wave] = ss; __syncthreads();
            if ((F.wave & 3) == 0 && lane == 0) RS2[MP + r] = 1.0f / sqrtf(((red[F.wave] + red[F.wave + 1]) + (red[F.wave + 2] + red[F.wave + 3])) * (1.0f / DM) + EPS);
            __syncthreads(); }
        if (F.tid < 64) for (int row = F.tid * F.G + F.bid; row < MP; row += 64 * F.G) { const f32x4* sp = (const f32x4*)(SS + (size_t)row * 32); f32x4 t = sp[0];
#pragma unroll
            for (int j = 1; j < 8; ++j) t += sp[j];
            RS2[row] = 1.0f / sqrtf(((t.x + t.y) + (t.z + t.w)) * (1.0f / DM) + EPS); } } SEAM(7);
    if (IN(8)) { pg8::Gemm g{WSP(bf16_t, WS_XB2), WSP(bf16_t, WS_WG), M, 2 * DFF, DM, DM, DM}; pg8::StaticOrder S; S.init(M, 2 * DFF, F.G, F.bid);
        EpiFFN E{WSP(float, WS_RSTD2), F.fconv_w, F.fconv_b, F.st_ffn, WSP(bf16_t, WS_ACT), F.out, WSP(float, WS_GE), WSP(float, WS_G0), WSP(float, WS_U0), (LAS float*)(ldsl + XL_OFF), args.qhi < 0};
        pg8::gemm_phase<EpiFFN, pg8::StaticOrder, PG_ALIGN, PG_SP2>(ldsl, g, S, E);
        tr_deferred(F, lds, TR_A3, TR_A4, S.nwg % F.G, F.G); } SEAM(8);

    if (IN(9)) { const int gt = F.bid * 512 + F.tid, NT = F.G * 512; const float* GE = WSP(float, WS_GE); const float* G0 = WSP(float, WS_G0); const float* U0 = WSP(float, WS_U0); bf16_t* ACT = WSP(bf16_t, WS_ACT);
        for (int i = gt; i < 64 * 2 * 768; i += NT) { const int f = (i % 768) * 8, rr = (i / 768) & 1, pm = i / (2 * 768); if ((pm & 7) == 0) continue;
            const float* a0 = GE + ((size_t)(pm - 1) * 2 + 0) * DFF + f; const float* a1 = a0 + DFF; const float* b0 = G0 + ((size_t)pm * 2 + 0) * DFF + f; const float* b1 = b0 + DFF; const float* up = U0 + ((size_t)pm * 2 + rr) * DFF + f;
            float ov[8];
#pragma unroll
            for (int h = 0; h < 2; ++h) { const f32x4 gm2 = *(const f32x4*)(a0 + 4 * h), gm1 = *(const f32x4*)(a1 + 4 * h), g0 = *(const f32x4*)(b0 + 4 * h), g1 = *(const f32x4*)(b1 + 4 * h), uv = *(const f32x4*)(up + 4 * h);
                const f32x4 w0 = *(const f32x4*)(F.fconv_w + f + 4 * h), w1 = *(const f32x4*)(F.fconv_w + DFF + f + 4 * h), w2 = *(const f32x4*)(F.fconv_w + 2 * DFF + f + 4 * h), bb = *(const f32x4*)(F.fconv_b + f + 4 * h);
                const f32x4 pre = rr == 0 ? bb + w0 * gm2 + w1 * gm1 + w2 * g0 : bb + w0 * gm1 + w1 * g0 + w2 * g1;
#pragma unroll
                for (int j = 0; j < 4; ++j) ov[4 * h + j] = gelu_tanh(pre[j]) * uv[j]; }
            u32x4 o; o.x = pk2(ov[0], ov[1]); o.y = pk2(ov[2], ov[3]); o.z = pk2(ov[4], ov[5]); o.w = pk2(ov[6], ov[7]);
            *(u32x4*)(ACT + (size_t)(pm * 256 + rr) * DFF + f) = o; } } SEAM(9);
    if (IN(10)) { { pg8::Gemm g{WSP(bf16_t, WS_ACT), WSP(bf16_t, WS_WD), MP, DM, DFF, DFF, DFF}; pg8::StaticOrder S; S.init(MP, DM, F.G, F.bid);
          EpiDown E{WSP(bf16_t, WS_XB2), F.out, WSP(float, WS_SS3), args.qhi < 0}; pg8::gemm_phase<EpiDown, pg8::StaticOrder, PG_ALIGN, PG_SP2>(ldsl, g, S, E); }
        { pg8::Gemm g{WSP(bf16_t, WS_ACT), WSP(bf16_t, WS_WD), M, DM, 384, DFF, DFF}; SplitOrder S{F.G, F.bid, 16, 384, 0}; EpiSlab<0> E{WSP(float, WS_SLAB), 384, nullptr};
          pg8::gemm_phase<EpiSlab<0>, SplitOrder, PG_ALIGN, PG_SP2>(ldsl, g, S, E); } } SEAM(10);
    if (IN(11)) { p9_final(F); }
#ifdef ATT_CHECK
    if (lo <= 12 && 12 < hi) att_check(F, lds);
#endif
#ifdef PROBE
    if (lo <= 12 && 12 < hi) {
        const int gt = F.bid * 512 + F.tid, NT = F.G * 512;
        const bf16_t* P1 = WSP(bf16_t, PROBE_A); const bf16_t* P2 = WSP(bf16_t, PROBE_B);
        for (size_t i = gt; i < (size_t)M * 1024; i += NT) { const size_t r = i >> 10, c = i & 1023; F.out[r * DM + c] = bf2f(P1[(size_t)r * PROBE_LDA + c]); F.out[r * DM + 1024 + c] = bf2f(P2[(size_t)r * PROBE_LDB + c]); }
        for (size_t i = gt; i < (size_t)NBATCH * 2 * DFF; i += NT) F.out[O_PFC + i] = 0.f;
        for (size_t i = gt; i < (size_t)DBATCH * 2 * DFF; i += NT) F.out[O_SFC + i] = 0.f;
    }
#endif
#undef IN
#undef SEAM
}

extern "C" void kernel_launch(void* const* d_in, const int* in_sizes, int n_in, void* d_out, int out_size, void* d_ws, size_t ws_size, hipStream_t stream) {
    static int grid = 0;
    if (grid == 0) {
        if (n_in != 30 || (size_t)out_size != O_END || ws_size < WS_END) { fprintf(stderr, "kernel_launch: unexpected shapes: n_in %d out %d (want %zu) ws %zu (want %zu)\n", n_in, out_size, (size_t)O_END, ws_size, (size_t)WS_END); grid = -1; return; }
        int dev = 0, cus = 0, per_cu = 0;
        if (hipGetDevice(&dev) != hipSuccess || hipDeviceGetAttribute(&cus, hipDeviceAttributeMultiprocessorCount, dev) != hipSuccess) { grid = -1; return; }
        if (hipFuncSetAttribute((const void*)fwd, hipFuncAttributeMaxDynamicSharedMemorySize, LDS_BYTES) != hipSuccess) { fprintf(stderr, "kernel_launch: hipFuncSetAttribute failed\n"); grid = -1; return; }
        if (hipOccupancyMaxActiveBlocksPerMultiprocessor(&per_cu, (const void*)fwd, 512, LDS_BYTES) != hipSuccess || per_cu < 1) fprintf(stderr, "kernel_launch: occupancy query reports %d\n", per_cu);
        (void)hipGetLastError();
        grid = cus;
    }
    if (grid < 0) return;
    if (hipMemsetAsync((char*)d_ws + WS_CTL, 0, CTL_ZERO_BYTES, stream) != hipSuccess) return;
    Args a{};
    for (int i = 0; i < 30; ++i) a.in[i] = d_in[i];
    a.out = (float*)d_out; a.ws = (unsigned char*)d_ws; a.qlo = 0; a.qhi = 768;
#if MK_ONE_LAUNCH
    a.ph_lo = 0; a.ph_hi = NPHASE;
    hipLaunchKernelGGL(fwd, dim3(grid), dim3(512), LDS_BYTES, stream, a);
#else
#if defined(ATT_CHECK)
    for (int q = 0; q < NPHASE + 1; ++q) { const int p = q < 4 ? q : (q == 4 ? 12 : q - 1); a.ph_lo = p; a.ph_hi = p + 1; hipLaunchKernelGGL(fwd, dim3(grid), dim3(512), LDS_BYTES, stream, a); }
#elif defined(PROBE)
    for (int p = 0; p < NPHASE + 1; ++p) { a.ph_lo = p; a.ph_hi = p + 1; hipLaunchKernelGGL(fwd, dim3(grid), dim3(512), LDS_BYTES, stream, a); }
#else
    for (int p = 0; p < NPHASE; ++p) { a.ph_lo = p; a.ph_hi = p + 1; hipLaunchKernelGGL(fwd, dim3(grid), dim3(512), LDS_BYTES, stream, a);
#ifdef REPEAT_PH
#ifndef REPEAT_SKIP
#define REPEAT_SKIP 0
#endif
#ifndef REPEAT_QLO
#define REPEAT_QLO 0
#define REPEAT_QHI 768
#endif
        if (p == REPEAT_PH) { if (p == 1 || p == 8 || p == 10) a.qhi = REPEAT_SKIP ? -1 : 768;
#ifdef REPEAT_LD
            if (p == 1) a.qlo = REPEAT_LD;
#endif
#ifdef REPEAT_P0SKIP
            if (p == 0) { a.qhi = -1; a.qlo = REPEAT_P0SKIP; }
#endif
#ifdef REPEAT_P2SKIP
            if (p == 2) { a.qhi = -1; a.qlo = REPEAT_P2SKIP; }
#endif
 if (p == 3) { (void)hipMemsetAsync((char*)d_ws + WS_CTL + CW_QUEUE * 4, 0, 4, stream); a.qlo = REPEAT_QLO; a.qhi = REPEAT_QHI; } hipLaunchKernelGGL(fwd, dim3(grid), dim3(512), LDS_BYTES, stream, a); a.qlo = 0; a.qhi = 768; }
#endif
    }
#endif
#endif
}
```

```cpp
#include <hip/hip_runtime.h>
#include <cstdio>
#include <cstdint>
#define MK_ONE_LAUNCH 1
#define PROJ_MERGED 1
namespace pg8 {
#define PG8_LAS __attribute__((address_space(3)))
typedef unsigned short bf16_t;
typedef short bf16x8 __attribute__((ext_vector_type(8)));
typedef float f32x4 __attribute__((ext_vector_type(4)));
typedef unsigned u32x4 __attribute__((ext_vector_type(4)));
constexpr int BM = 256, BK = 64, HALF = 128, HTB = HALF * BK * 2  , STAGE_BYTES = 8 * HTB, NXCD = 8, WGM = 8;

__host__ __device__ __forceinline__ int lds_byte(int r, int c) { const int st = (r >> 4) * 2 + (c >> 5), rr = r & 15, cc = c & 31, ob = rr * 64 + cc * 2; return st * 1024 + (ob ^ (((ob >> 9) & 1) << 5)); }
__host__ __device__ __forceinline__ void stage_rc(int b, int& R, int& C) { const int st = b / 1024, sb = b % 1024, swz = sb ^ (((sb >> 9) & 1) << 5); R = (st >> 1) * 16 + swz / 64; C = (st & 1) * 32 + (swz % 64) / 2; }
__host__ __device__ __forceinline__ int perm32(int rho) { const int n = rho >> 4, i = rho & 15; return 8 * (i >> 2) + 4 * n + (i & 3); }

struct Unit { int pm, pn, ko; };
struct Gemm { const bf16_t* A; const bf16_t* Bt; int M, N, K, lda, ldb; const bf16_t* A2 = nullptr; const bf16_t* Bt2 = nullptr; };

struct StaticOrder {
    int nM, nN, nwg, G, c, wgm, light;
    __host__ __device__ void init(int M, int N, int G_, int c_, int wgm_ = WGM) { nM = M / BM; nN = N / BM; nwg = nM * nN; G = G_; c = c_; wgm = wgm_; light = 0; }
    __host__ __device__ bool next(int i, Unit& u) const {
        const long L = (long)i * G + c; int wgid;
        if (light == 0) { if (L >= nwg) return false;
            wgid = (int)L; { const int q = nwg / NXCD, r = nwg % NXCD, xcd = wgid % NXCD, off = wgid / NXCD; wgid = (xcd < r ? xcd * (q + 1) : r * (q + 1) + (xcd - r) * q) + off; } }
        else { const int xcd = (int)(L % NXCD), off = (int)(L / NXCD), q = nwg / NXCD, sh = light / (NXCD - 1), size = (xcd == NXCD - 1) ? q - light : q + sh;
            if (off >= size) return false; wgid = xcd * (q + sh) + off; }
        const int nig = wgm * nN, gid = wgid / nig, fm = gid * wgm, gsz = (nM - fm) < wgm ? (nM - fm) : wgm;
        u.pm = fm + ((wgid % nig) % gsz); u.pn = (wgid % nig) / gsz; u.ko = 0; return true;
    }
    __device__ __forceinline__ void a_ready(const Unit&) const {}
    __device__ __forceinline__ void done(const Unit&) const {}
};
typedef __bf16 bf16x2n_t __attribute__((ext_vector_type(2)));
typedef float f32x2n_t __attribute__((ext_vector_type(2)));
__device__ __forceinline__ unsigned cvt_pk_bf16(float lo, float hi) { const f32x2n_t f = {lo, hi}; return __builtin_bit_cast(unsigned, __builtin_convertvector(f, bf16x2n_t)); }
template <class Epi, class Sched, bool ALIGN_EPI = false, bool SP2 = false>
__device__ __forceinline__ void gemm_phase(PG8_LAS unsigned char* lds, const Gemm g, const Sched& S, const Epi& E) {
    const int tid = threadIdx.x, wid = __builtin_amdgcn_readfirstlane(tid >> 6), lane = tid & 63, wr = wid >> 2, wc = wid & 3, fr = lane & 15, fq = lane >> 4;
    const int K = g.K, nt = K / BK;
    unsigned voffA[2], voffB[2];
#pragma unroll
    for (int i = 0; i < 2; ++i) { int R, C; stage_rc(tid * 16 + i * 8192, R, C); const int Rb = Epi::PERM ? ((R & ~31) + perm32(R & 31)) : R;
        voffA[i] = (unsigned)(R * g.lda + C) * 2u; voffB[i] = (unsigned)(Rb * g.ldb + C) * 2u; }
    const size_t kstep = (size_t)(BK * 2);
    const size_t hstepA = (size_t)HALF * g.lda * 2, hstepB = (size_t)HALF * g.ldb * 2;
    const size_t tstepA = 2 * hstepA, tstepB = 2 * hstepB;
    const unsigned ldsw = (unsigned)wid * 1024u;
    const int aoff = lds_byte(wr * 64 + fr, fq * 8), boff = lds_byte(wc * 32 + fr, fq * 8);
#define PG8_SA(b, h) (((b) * 2 + (h)) * HTB)
#define PG8_SB(b, h) ((4 + (b) * 2 + (h)) * HTB)
#define PG8_STAGE(bufoff, gbase, voff) do { _Pragma("unroll") for (int _i = 0; _i < 2; ++_i) \
        __builtin_amdgcn_global_load_lds((const unsigned*)((const char*)(gbase) + (voff)[_i]), (PG8_LAS unsigned*)(lds + (bufoff) + ldsw + _i * 8192), 16, 0, 0); } while (0)
#define PG8_LDA(dst, b, h) do { _Pragma("unroll") for (int m = 0; m < 4; ++m) _Pragma("unroll") for (int k = 0; k < 2; ++k) dst[m][k] = *(const PG8_LAS bf16x8*)(lds + PG8_SA(b, h) + aoff + m * 2048 + k * 1024); } while (0)
#define PG8_LDB(dst, b, h) do { _Pragma("unroll") for (int n = 0; n < 2; ++n) _Pragma("unroll") for (int k = 0; k < 2; ++k) dst[n][k] = *(const PG8_LAS bf16x8*)(lds + PG8_SB(b, h) + boff + n * 2048 + k * 1024); } while (0)
#define PG8_MMA(ai, bj, At, Bt) do { __builtin_amdgcn_s_setprio(1); _Pragma("unroll") for (int m = 0; m < 4; ++m) _Pragma("unroll") for (int n = 0; n < 2; ++n) _Pragma("unroll") for (int k = 0; k < 2; ++k) \
        acc[ai][bj][m][n] = __builtin_amdgcn_mfma_f32_16x16x32_bf16(Bt[n][k], At[m][k], acc[ai][bj][m][n], 0, 0, 0); __builtin_amdgcn_s_setprio(0); } while (0)
#define PG8_WAIT_V(n) asm volatile("s_waitcnt vmcnt(" #n ")" ::: "memory")
#define PG8_WAIT_L(n) asm volatile("s_waitcnt lgkmcnt(" #n ")" ::: "memory")
#define PG8_BAR __builtin_amdgcn_s_barrier()
#define PG8_SCHED __builtin_amdgcn_sched_barrier(0)
    Unit cur, nxt; int ui = 0;
    if (!S.next(0, cur)) return;
    f32x4 acc[2][2][4][2];
#pragma unroll
    for (int a = 0; a < 2; ++a)
#pragma unroll
        for (int b = 0; b < 2; ++b)
#pragma unroll
            for (int m = 0; m < 4; ++m)
#pragma unroll
                for (int n = 0; n < 2; ++n) acc[a][b][m][n] = (f32x4){0.f, 0.f, 0.f, 0.f};
    bf16x8 At[4][2], B0[2][2], B1[2][2];
    const char* cA = (const char*)g.A + (size_t)cur.pm * tstepA + (size_t)cur.ko * 2; const char* cB = (const char*)g.Bt + (size_t)cur.pn * tstepB + (size_t)cur.ko * 2;
    const int ks = nt / 2;
    const char* cA2 = nullptr; const char* cB2 = nullptr;
    if constexpr (Epi::MIDK) { cA2 = (const char*)g.A2 + (size_t)cur.pm * tstepA - (size_t)ks * kstep; cB2 = (const char*)g.Bt2 + (size_t)cur.pn * tstepB - (size_t)ks * kstep; }
    S.a_ready(cur);
    if constexpr (SP2) {
        PG8_STAGE(PG8_SB(0, 0), cB, voffB); PG8_STAGE(PG8_SB(0, 1), cB + hstepB, voffB); PG8_STAGE(PG8_SA(0, 0), cA, voffA); PG8_STAGE(PG8_SA(0, 1), cA + hstepA, voffA);
        if (wr == 1) PG8_BAR;
        PG8_WAIT_V(2); PG8_BAR;
        PG8_STAGE(PG8_SB(1, 0), cB + kstep, voffB); PG8_STAGE(PG8_SA(1, 0), cA + kstep, voffA); PG8_STAGE(PG8_SB(1, 1), cB + hstepB + kstep, voffB);
        PG8_WAIT_V(6); PG8_BAR;
    } else {
        PG8_STAGE(PG8_SB(0, 0), cB, voffB); PG8_STAGE(PG8_SA(0, 0), cA, voffA); PG8_STAGE(PG8_SB(0, 1), cB + hstepB, voffB); PG8_STAGE(PG8_SA(0, 1), cA + hstepA, voffA);
        if (wr == 1) PG8_BAR;
        PG8_WAIT_V(4); PG8_BAR;
        PG8_STAGE(PG8_SB(1, 0), cB + kstep, voffB); PG8_STAGE(PG8_SA(1, 0), cA + kstep, voffA); PG8_STAGE(PG8_SB(1, 1), cB + hstepB + kstep, voffB);
        PG8_WAIT_V(6); PG8_BAR;
    }
    for (;;) {
        const bool has_next = S.next(ui + 1, nxt);
        const char* nA = has_next ? (const char*)g.A + (size_t)nxt.pm * tstepA + (size_t)nxt.ko * 2 : cA; const char* nB = has_next ? (const char*)g.Bt + (size_t)nxt.pn * tstepB + (size_t)nxt.ko * 2 : cB;
#pragma unroll
        for (int seg = 0; seg < (Epi::MIDK ? 2 : 1); ++seg) {
        if constexpr (Epi::MIDK) { if (seg == 1) E.mid(acc, cur, wr, wc, fr, fq); }
        for (int t = (seg == 0 ? 0 : ks); t < ((Epi::MIDK && seg == 0) ? ks : nt); t += 2) {
            const bool last = (t == nt - 2);
            const char* pA1 = cA; const char* pA2 = cA; const char* pB2 = cB;
            if constexpr (Epi::MIDK) { if (t >= ks) pA1 = cA2; if (t + 2 >= ks) { pA2 = cA2; pB2 = cB2; } }
            const char* a1 = pA1 + (size_t)(t + 1) * kstep;
            const char* a2 = last ? nA : pA2 + (size_t)(t + 2) * kstep; const char* b2 = last ? nB : pB2 + (size_t)(t + 2) * kstep;
            const char* a3 = a2 + kstep; const char* b3 = b2 + kstep;
            if (last && has_next) S.a_ready(nxt);
            if constexpr (Epi::PRE) { if (last) E.pre(cur, wid, lane); }
            if constexpr (SP2) {
            PG8_LDB(B0, 0, 0); PG8_LDB(B1, 0, 1); PG8_SCHED; PG8_LDA(At, 0, 0); PG8_STAGE(PG8_SA(1, 1), a1 + hstepA, voffA);
            PG8_WAIT_V(8); PG8_WAIT_L(0); PG8_BAR; PG8_MMA(0, 0, At, B0); PG8_MMA(0, 1, At, B1); PG8_BAR; PG8_SCHED;
            PG8_LDA(At, 0, 1); PG8_STAGE(PG8_SB(0, 0), b2, voffB); PG8_STAGE(PG8_SB(0, 1), b2 + hstepB, voffB); PG8_STAGE(PG8_SA(0, 0), a2, voffA);
            PG8_WAIT_V(8); PG8_WAIT_L(0); PG8_BAR; PG8_MMA(1, 0, At, B0); PG8_MMA(1, 1, At, B1); PG8_BAR; PG8_SCHED;
            PG8_LDB(B0, 1, 0); PG8_LDB(B1, 1, 1); PG8_SCHED; PG8_LDA(At, 1, 0); PG8_STAGE(PG8_SA(0, 1), a2 + hstepA, voffA);
            PG8_WAIT_V(8); PG8_WAIT_L(0); PG8_BAR; PG8_MMA(0, 0, At, B0); PG8_MMA(0, 1, At, B1); PG8_BAR; PG8_SCHED;
            PG8_LDA(At, 1, 1); PG8_STAGE(PG8_SB(1, 0), b3, voffB); PG8_STAGE(PG8_SB(1, 1), b3 + hstepB, voffB); PG8_STAGE(PG8_SA(1, 0), a3, voffA);
            PG8_WAIT_V(8); PG8_WAIT_L(0); PG8_BAR; PG8_MMA(1, 0, At, B0); PG8_MMA(1, 1, At, B1); PG8_BAR; PG8_SCHED;
            } else {
            PG8_LDB(B0, 0, 0); PG8_SCHED; PG8_LDA(At, 0, 0); PG8_STAGE(PG8_SA(1, 1), a1 + hstepA, voffA);
            PG8_WAIT_L(8); PG8_BAR; PG8_WAIT_L(0); PG8_MMA(0, 0, At, B0); PG8_BAR; PG8_SCHED;
            PG8_LDB(B1, 0, 1); PG8_STAGE(PG8_SB(0, 0), b2, voffB);
            PG8_BAR; PG8_WAIT_L(0); PG8_MMA(0, 1, At, B1); PG8_BAR;
            PG8_LDA(At, 0, 1); PG8_STAGE(PG8_SA(0, 0), a2, voffA);
            PG8_BAR; PG8_WAIT_L(0); PG8_MMA(1, 0, At, B0); PG8_BAR; PG8_SCHED;
            PG8_STAGE(PG8_SB(0, 1), b2 + hstepB, voffB);
            PG8_WAIT_V(6); PG8_BAR; PG8_MMA(1, 1, At, B1); PG8_BAR;
            PG8_LDB(B0, 1, 0); PG8_SCHED; PG8_LDA(At, 1, 0); PG8_STAGE(PG8_SA(0, 1), a2 + hstepA, voffA);
            PG8_WAIT_L(8); PG8_BAR; PG8_WAIT_L(0); PG8_MMA(0, 0, At, B0); PG8_BAR; PG8_SCHED;
            PG8_LDB(B1, 1, 1); PG8_STAGE(PG8_SB(1, 0), b3, voffB);
            PG8_BAR; PG8_WAIT_L(0); PG8_MMA(0, 1, At, B1); PG8_BAR;
            PG8_LDA(At, 1, 1); PG8_STAGE(PG8_SA(1, 0), a3, voffA);
            PG8_BAR; PG8_WAIT_L(0); PG8_MMA(1, 0, At, B0); PG8_BAR; PG8_SCHED;
            PG8_STAGE(PG8_SB(1, 1), b3 + hstepB, voffB);
            PG8_WAIT_V(6); PG8_BAR; PG8_MMA(1, 1, At, B1); PG8_BAR;
            }
        }
        }
        if constexpr (ALIGN_EPI) { if (wr == 0) PG8_BAR; }
        if constexpr (!Epi::AFTER_DRAIN) { E(acc, cur, wr, wc, fr, fq); S.done(cur); }
        if (!has_next) break;
#pragma unroll
        for (int a = 0; a < 2; ++a)
#pragma unroll
            for (int b = 0; b < 2; ++b)
#pragma unroll
                for (int m = 0; m < 4; ++m)
#pragma unroll
                    for (int n = 0; n < 2; ++n) acc[a][b][m][n] = (f32x4){0.f, 0.f, 0.f, 0.f};
        cur = nxt; cA = nA; cB = nB; ++ui;
        if constexpr (Epi::MIDK) { cA2 = (const char*)g.A2 + (size_t)cur.pm * tstepA - (size_t)ks * kstep; cB2 = (const char*)g.Bt2 + (size_t)cur.pn * tstepB - (size_t)ks * kstep; }
        if constexpr (ALIGN_EPI) { if (wr == 1) PG8_BAR; }
    }
    PG8_WAIT_V(0);
    if constexpr (!ALIGN_EPI) { if (wr == 0) PG8_BAR; }
    PG8_BAR;
    if constexpr (Epi::AFTER_DRAIN) { E.fused(acc, cur, wr, wc, fr, fq, lds, wid, lane); S.done(cur); }
#undef PG8_SA
#undef PG8_SB
#undef PG8_STAGE
#undef PG8_LDA
#undef PG8_LDB
#undef PG8_MMA
#undef PG8_WAIT_V
#undef PG8_WAIT_L
#undef PG8_BAR
#undef PG8_SCHED
}
}

#define LAS __attribute__((address_space(3)))
using pg8::bf16_t; using pg8::bf16x8; using pg8::f32x4; using pg8::u32x4; using pg8::Unit;
typedef float f32x16 __attribute__((ext_vector_type(16)));
typedef short s16x4 __attribute__((ext_vector_type(4)));
typedef unsigned u32x2 __attribute__((ext_vector_type(2)));

#ifndef MK_ONE_LAUNCH
#define MK_ONE_LAUNCH 0
#endif
constexpr int NPHASE = 12;
#ifndef SC_YP
#define SC_YP 1.0f
#endif
#ifndef SC_YS
#define SC_YS 1.0f
#endif
#ifndef SC_PFC
#define SC_PFC 1.0f
#endif
#ifndef SC_SFC
#define SC_SFC 1.0f
#endif
#ifndef SC_PRH
#define SC_PRH 1.0f
#endif
#ifndef SC_SRH
#define SC_SRH 1.0f
#endif
constexpr int DM = 2048, NBATCH = 8, SEQ = 2048, DBATCH = 128, DSEQ = 4;
constexpr int MP = NBATCH * SEQ, MS = DBATCH * DSEQ, M = MP + MS;
constexpr int DFF = 6144, N1 = 8704;
constexpr float EPS = 1e-6f;
constexpr int NCU_UNITS = 272;

constexpr size_t O_YP = 0, O_YS = O_YP + (size_t)MP * DM, O_PKC = O_YS + (size_t)MS * DM, O_PKS = O_PKC + (size_t)MP * 512, O_PKW = O_PKS + (size_t)MP * 512,
    O_PRH = O_PKW + (size_t)NBATCH * 512 * 512, O_PRC = O_PRH + NBATCH * 1024, O_PFC = O_PRC + NBATCH * 3 * 1024, O_SKC = O_PFC + (size_t)NBATCH * 2 * DFF,
    O_SKS = O_SKC + (size_t)MS * 512, O_SKW = O_SKS + (size_t)MS * 512, O_SRH = O_SKW + (size_t)DBATCH * 512 * 512, O_SRC = O_SRH + DBATCH * 1024,
    O_SFC = O_SRC + DBATCH * 3 * 1024, O_END = O_SFC + (size_t)DBATCH * 2 * DFF;

constexpr size_t MiB = 1u << 20;
constexpr size_t WS_CTL = 0, CTL_ZERO_BYTES = 1 * MiB;
constexpr size_t WS_SS2 = 1265 * MiB, WS_SS3 = 1268 * MiB;
constexpr size_t WS_RSTD2 = 1 * MiB + 768 * 1024;
constexpr size_t WS_RSTD1 = 1 * MiB, WS_POSB = 1 * MiB + 128 * 1024, WS_POSP = 1 * MiB + 256 * 1024;
constexpr size_t WS_W1T = 2 * MiB, WS_WPR = 37 * MiB, WS_WPA = 41 * MiB, WS_WO = 45 * MiB, WS_WG = 53 * MiB, WS_WU = 77 * MiB, WS_WD = 101 * MiB, WS_WC = 125 * MiB;
constexpr size_t WS_XB = 128 * MiB, WS_XR = 194 * MiB, WS_GG = 227 * MiB, WS_Q = 260 * MiB, WS_KVS = 293 * MiB, WS_KVW = 310 * MiB, WS_CC = 327 * MiB, WS_FS = 600 * MiB,
    WS_SGM = 668 * MiB, WS_GNSA = 800 * MiB, WS_Y = 803 * MiB, WS_OB = 836 * MiB, WS_OMIX = 869 * MiB, WS_T1 = 935 * MiB, WS_MB = 1001 * MiB, WS_XP1 = 1067 * MiB, WS_XB2 = 1199 * MiB,
    WS_END = 1271 * MiB;
constexpr size_t WS_GE = WS_MB, WS_G0 = WS_MB + 4 * MiB, WS_U0 = WS_MB + 8 * MiB;
constexpr size_t WS_SLAB = WS_T1, WS_SLAB2 = WS_OMIX;
constexpr size_t WS_GB = 128 * MiB, WS_UB = 326 * MiB, WS_ACT = 524 * MiB;
static_assert(WS_W1T + (size_t)N1 * 2048 * 2 <= WS_WPR && WS_WD + (size_t)2048 * 6144 * 2 <= WS_WC && WS_WC + (size_t)512 * 2048 * 2 <= WS_XB, "ws map weights");
static_assert(WS_XB + (size_t)M * 2048 * 2 <= WS_XR && WS_XR + (size_t)M * 1024 * 2 <= WS_GG && WS_Q + (size_t)M * 1024 * 2 <= WS_KVS && WS_KVS + (size_t)M * 512 * 2 <= WS_KVW && WS_KVW + (size_t)M * 512 * 2 <= WS_CC, "ws map act");
static_assert(WS_CC + (size_t)(NCU_UNITS * 256 + 8) * 2048 * 2 <= WS_FS && WS_FS + (size_t)NCU_UNITS * 65536 * 4 <= WS_SGM && WS_SGM + (size_t)M * 4096 * 2 <= WS_GNSA && WS_GNSA + (size_t)M * 32 * 4 <= WS_Y, "ws map 2");
static_assert(WS_Y + (size_t)M * 1024 * 2 <= WS_OB && WS_OB + (size_t)M * 1024 * 2 <= WS_OMIX && WS_OMIX + (size_t)M * 1024 * 4 <= WS_T1 && WS_T1 + (size_t)M * 2048 * 2 <= WS_MB && WS_MB + (size_t)M * 2048 * 2 <= WS_XP1, "ws map 3");
static_assert(WS_XP1 + (size_t)M * 2048 * 4 <= WS_XB2 && WS_XB2 + (size_t)M * 2048 * 2 <= WS_SS2 && WS_SS2 + (size_t)M * 128 <= WS_SS3 && WS_SS3 + (size_t)M * 128 <= WS_END && WS_ACT + (size_t)M * DFF * 2 <= WS_GNSA && WS_GB + (size_t)M * DFF * 2 <= WS_UB && WS_UB + (size_t)M * DFF * 2 <= WS_ACT, "ws map 4");
constexpr int CW_BAR = 4096, CW_QUEUE = 64;

constexpr int RING_BYTES = 131072, MISC_OFF = RING_BYTES + 320, XL_OFF = RING_BYTES + 1024, LDS_BYTES = 147456;

__device__ __forceinline__ unsigned pk2(float lo, float hi) { return pg8::cvt_pk_bf16(lo, hi); }
__device__ __forceinline__ float bf2f(unsigned short b) { return __uint_as_float(((unsigned)b) << 16); }
__device__ __forceinline__ float bflo(unsigned w) { return __uint_as_float(w << 16); }
__device__ __forceinline__ float bfhi(unsigned w) { return __uint_as_float(w & 0xffff0000u); }
__device__ __forceinline__ float sigmoidf_(float v) { return __builtin_amdgcn_rcpf(1.0f + __builtin_amdgcn_exp2f(-1.4426950409f * v)); }
__device__ __forceinline__ float gelu_tanh(float x) { const float u = x * (1.0f + 0.044715f * x * x); return x * __builtin_amdgcn_rcpf(1.0f + __builtin_amdgcn_exp2f(-2.302208198f * u)); }
__device__ __forceinline__ float wave_sum(float v) {
    v += __int_as_float(__builtin_amdgcn_update_dpp(0, __float_as_int(v), 0xB1, 0xf, 0xf, true));
    v += __int_as_float(__builtin_amdgcn_update_dpp(0, __float_as_int(v), 0x4E, 0xf, 0xf, true));
    v += __int_as_float(__builtin_amdgcn_update_dpp(0, __float_as_int(v), 0x141, 0xf, 0xf, true));
    v += __int_as_float(__builtin_amdgcn_update_dpp(0, __float_as_int(v), 0x140, 0xf, 0xf, true));
    v += __shfl_xor(v, 16); v += __shfl_xor(v, 32);
    return v;
}
__device__ __forceinline__ u32x4 pack8u(f32x4 a, f32x4 b) { u32x4 w = {pk2(a[0], a[1]), pk2(a[2], a[3]), pk2(b[0], b[1]), pk2(b[2], b[3])}; return w; }

#define XB_TMO      128
#define XB_XCNT(j)  (256  + 64 * (j))
#define XB_XSUB(j)  (1280 + 64 * (j))
#define XB_XGEN(j)  (2304 + 64 * (j))
#define XB_TOP      3328
#define XB_TOPGEN   3392
#define XCD_BAR_WORDS 3456
#define XB_SPIN_CAP (1u << 18)
__device__ __forceinline__ unsigned xb_ld(unsigned* p)              { return __hip_atomic_load(p, __ATOMIC_RELAXED, __HIP_MEMORY_SCOPE_AGENT); }
__device__ __forceinline__ unsigned xb_add(unsigned* p, unsigned v) { return __hip_atomic_fetch_add(p, v, __ATOMIC_RELAXED, __HIP_MEMORY_SCOPE_AGENT); }
__device__ __forceinline__ unsigned xb_xcc_id() { return (unsigned)__builtin_amdgcn_s_getreg((3 << 11) | 20) & 0xFu; }
#define XB_SPIN(cond, bar) do { unsigned _sp = 0; while (cond) { __builtin_amdgcn_s_sleep(1); \
    if ((++_sp & 255u) == 0u) { if (xb_ld(&(bar)[XB_TMO])) break; if (_sp > XB_SPIN_CAP) { atomicAdd(&(bar)[XB_TMO], 1u); break; } } } } while (0)
struct XcdBarrier { unsigned* bar; unsigned x; volatile LAS unsigned* st; };
__device__ __forceinline__ XcdBarrier xcd_barrier_post(unsigned* bar, volatile LAS unsigned* st) {
    XcdBarrier b; b.bar = bar; b.x = xb_xcc_id(); b.st = st;
    if (threadIdx.x == 0) (void)xb_add(&bar[XB_XCNT(b.x)], 1u);
    return b;
}
__device__ __forceinline__ void xcd_barrier_complete(unsigned* bar, unsigned x, unsigned& nloc, unsigned& nx) {
    const unsigned G = gridDim.x * gridDim.y * gridDim.z;
    unsigned sum, cnt, mine, sp = 0u;
    for (;;) {
        sum = 0u; cnt = 0u; mine = 0u;
#pragma unroll
        for (unsigned j = 0; j < 16; ++j) { const unsigned c = xb_ld(&bar[XB_XCNT(j)]); sum += c; cnt += (c > 0u) ? 1u : 0u; mine = (j == x) ? c : mine; }
        if (sum == G) break;
        __builtin_amdgcn_s_sleep(1);
        if ((++sp & 255u) == 0u) { if (xb_ld(&bar[XB_TMO])) break; if (sp > XB_SPIN_CAP) { atomicAdd(&bar[XB_TMO], 1u); break; } }
    }
    nloc = mine > 0u ? mine : 1u; nx = cnt > 0u ? cnt : 1u;
}
__device__ __forceinline__ void xcd_barrier(const XcdBarrier& b) {
    asm volatile("s_waitcnt vmcnt(0)" ::: "memory");
    __syncthreads();
    if (threadIdx.x == 0) {
        unsigned* bar = b.bar;
        __builtin_amdgcn_s_waitcnt(0);
        unsigned nloc = b.st[0], nx = b.st[1];
        if (nloc == 0u) { xcd_barrier_complete(bar, b.x, nloc, nx); b.st[0] = nloc; b.st[1] = nx; }
        const unsigned old = xb_add(&bar[XB_XSUB(b.x)], 1u);
        const unsigned gen = old / nloc;
        if (old + 1u == (gen + 1u) * nloc) {
            __builtin_amdgcn_fence(__ATOMIC_RELEASE, "agent");
            asm volatile("s_waitcnt vmcnt(0)" ::: "memory");
            const unsigned og = xb_add(&bar[XB_TOP], 1u);
            const unsigned tg = og / nx;
            if (og + 1u == (tg + 1u) * nx) xb_add(&bar[XB_TOPGEN], 1u);
            else XB_SPIN(xb_ld(&bar[XB_TOPGEN]) == tg, bar);
            __builtin_amdgcn_fence(__ATOMIC_ACQUIRE, "agent");
            xb_add(&bar[XB_XGEN(b.x)], 1u);
            asm volatile("s_waitcnt vmcnt(0)" ::: "memory");
        } else {
            XB_SPIN(xb_ld(&bar[XB_XGEN(b.x)]) == gen, bar);
            __builtin_amdgcn_fence(__ATOMIC_ACQUIRE, "agent");
            asm volatile("s_waitcnt vmcnt(0)" ::: "memory");
        }
    }
    __syncthreads();
}

struct Args { const void* in[30]; float* out; unsigned char* ws; int ph_lo, ph_hi, qlo, qhi; };
struct Frame {
    int tid, lane, wave, G, bid;
    const float *x_p, *x_s, *c_cmp, *c_slc, *c_win, *st_h, *st_conv, *st_ffn; const int* pt;
    const float *norm_mix, *w_in, *rconv_w, *rconv_b, *rwa, *rba, *rwx, *rbx, *rlam, *cmp_w, *cmp_pos, *w_pr, *w_pa, *w_out, *norm_ffn, *w_gate, *w_up, *fconv_w, *fconv_b, *w_down, *norm_final;
    float* out; unsigned char* ws;
};
#define WSP(T, off) ((T*)(F.ws + (off)))

struct TrDesc { const float* src; const float* ks; bf16_t* dst; int ldw, ldk; };
__device__ __forceinline__ TrDesc tr_mk(const float* W, int ldw, int k0, int c0, const float* kscale, bf16_t* WT, int ldk, int dst_row0, int dst_k0) {
    TrDesc d; d.src = W + (size_t)k0 * ldw + c0; d.ks = kscale ? kscale + k0 : nullptr; d.dst = WT + (size_t)dst_row0 * ldk + dst_k0; d.ldw = ldw; d.ldk = ldk; return d; }
constexpr int TR_IN = 32 * (N1 / 32), TR_PR = 16 * 64, TR_O = 32 * 64, TR_G = 32 * 192, TR_D = 96 * 64, TR_C = 2 * 64 * 4;
constexpr int TR_A1 = TR_IN, TR_A2 = TR_A1 + 2 * TR_PR + TR_O, TR_A3 = TR_A2 + 2 * TR_G, TR_A4 = TR_A3 + TR_D, TR_A5 = TR_A4 + TR_C;
constexpr int TR_GDEF = 2048;
__device__ __forceinline__ TrDesc tr_desc(const Frame& F, int r) {
    if (r < TR_IN) { const int nblk = N1 / 32, kb = r / nblk, nb = r % nblk, n0 = nb * 32; const int src = n0 < 4608 ? n0 : n0 + 24;
        return tr_mk(F.w_in, 8728, kb * 64, src, F.norm_mix, WSP(bf16_t, WS_W1T), 2048, n0, kb * 64); } r -= TR_IN;
    if (r < TR_PR) { const int kb = r / 64, nb = r % 64; return tr_mk(F.w_pr, 2048, kb * 64, nb * 32, nullptr, WSP(bf16_t, WS_WPR), 1024, nb * 32, kb * 64); } r -= TR_PR;
    if (r < TR_PR) { const int kb = r / 64, nb = r % 64; return tr_mk(F.w_pa, 2048, kb * 64, nb * 32, nullptr, WSP(bf16_t, WS_WPA), 1024, nb * 32, kb * 64); } r -= TR_PR;
    if (r < TR_O) { const int kb = r / 64, nb = r % 64; return tr_mk(F.w_out, 2048, kb * 64, nb * 32, nullptr, WSP(bf16_t, WS_WO), 2048, nb * 32, kb * 64); } r -= TR_O;
    if (r < TR_G) { const int kb = r / 192, nb = r % 192; return tr_mk(F.w_gate, DFF, kb * 64, nb * 32, F.norm_ffn, WSP(bf16_t, WS_WG), 2048, (nb >> 2) * 256 + (nb & 3) * 32, kb * 64); } r -= TR_G;
    if (r < TR_G) { const int kb = r / 192, nb = r % 192; return tr_mk(F.w_up, DFF, kb * 64, nb * 32, F.norm_ffn, WSP(bf16_t, WS_WG), 2048, (nb >> 2) * 256 + 128 + (nb & 3) * 32, kb * 64); } r -= TR_G;
    if (r < TR_D) { const int kb = r / 64, nb = r % 64; return tr_mk(F.w_down, 2048, kb * 64, nb * 32, nullptr, WSP(bf16_t, WS_WD), DFF, nb * 32, kb * 64); } r -= TR_D;
    { const int c = r / 256, rr = r % 256, kb = rr / 4, nb = rr % 4, k0 = kb * 64, lw = k0 >> 7;
      return tr_mk(F.cmp_w + (size_t)c * 4096 * 128, 128, k0, nb * 32, nullptr, WSP(bf16_t, WS_WC), 2048, c * 256 + (lw >> 4) * 128 + nb * 32, (lw & 15) * 128 + (k0 & 127)); }
}
__device__ __forceinline__ void tr_load(const TrDesc& d, float (&tv)[32], f32x4 (&ks)[2], int lane) {
    const float* p = d.src + (size_t)(lane >> 5) * d.ldw + (lane & 31);
#pragma unroll
    for (int i = 0; i < 32; ++i) tv[i] = p[(size_t)(2 * i) * d.ldw];
    if (d.ks) { ks[0] = *(const f32x4*)(d.ks + 8 * (lane & 7)); ks[1] = *(const f32x4*)(d.ks + 8 * (lane & 7) + 4); } else { ks[0] = (f32x4){1.f, 1.f, 1.f, 1.f}; ks[1] = ks[0]; }
}
__device__ __forceinline__ void tr_store(const TrDesc& d, const float (&tv)[32], const f32x4 (&ks)[2], LAS float* scr, int lane) {
#pragma unroll
    for (int i = 0; i < 32; ++i) scr[(2 * i + (lane >> 5)) * 33 + (lane & 31)] = tv[i];
    asm volatile("s_waitcnt lgkmcnt(0)" ::: "memory");
    const int c = lane & 7;
#pragma unroll
    for (int j4 = 0; j4 < 4; ++j4) { const int n = (lane >> 3) + 8 * j4; const LAS float* s = scr + (8 * c) * 33 + n;
        u32x4 o; o.x = pk2(s[0 * 33] * ks[0].x, s[1 * 33] * ks[0].y); o.y = pk2(s[2 * 33] * ks[0].z, s[3 * 33] * ks[0].w); o.z = pk2(s[4 * 33] * ks[1].x, s[5 * 33] * ks[1].y); o.w = pk2(s[6 * 33] * ks[1].z, s[7 * 33] * ks[1].w);
        *(u32x4*)(d.dst + (size_t)n * d.ldk + 8 * c) = o; }
    asm volatile("s_waitcnt lgkmcnt(0)" ::: "memory");
}
__device__ __forceinline__ int tr_map(int v, int mode) { return mode == 0 ? v : v < TR_IN ? v : v < TR_IN + (2 * TR_G - TR_GDEF) ? v - TR_IN + TR_A2 + TR_GDEF : v - (TR_IN + 2 * TR_G - TR_GDEF) + TR_A4; }
__device__ __forceinline__ void tr_run(const Frame& F, LAS float* scr, int lane, int first, int step, int end, int mode) {
    int v = first; if (v >= end) return;
    TrDesc d = tr_desc(F, tr_map(v, mode)); float tv[32]; f32x4 ks[2]; tr_load(d, tv, ks, lane);
#pragma unroll 1
    for (;;) { const int vn = v + step; const bool more = vn < end;
        const TrDesc dn = tr_desc(F, tr_map(more ? vn : v, mode)); float tn[32]; f32x4 kn[2]; tr_load(dn, tn, kn, lane);
        tr_store(d, tv, ks, scr, lane);
        if (!more) break;
        d = dn; v = vn; ks[0] = kn[0]; ks[1] = kn[1];
#pragma unroll
        for (int i = 0; i < 32; ++i) tv[i] = tn[i]; }
}
__device__ __forceinline__ void tr_deferred(const Frame& F, unsigned char* ldsg, int lo, int hi, int wg_lo, int wg_hi) {
    if (wg_lo >= wg_hi) { wg_lo = 0; wg_hi = F.G; }
    if (F.bid < wg_lo || F.bid >= wg_hi) return;
    LAS float* scr = (LAS float*)((LAS unsigned char*)ldsg + F.wave * 16384);
    tr_run(F, scr, F.lane, lo + (F.bid - wg_lo) * 8 + F.wave, (wg_hi - wg_lo) * 8, hi, 0);
}
constexpr int CC_EARLY = 24;
__device__ __forceinline__ void cc_item(const Frame& F, int it, int lane) { bf16_t* CC = WSP(bf16_t, WS_CC);
    const int db = it >> 7, n = it & 127; const int phys = F.pt[db * 16 + (n >> 3)];
    const float* src = F.c_cmp + ((size_t)phys * 128 + (n & 7) * 16) * 512 + lane * 4; const int g = lane >> 5, d = (lane & 31) * 4;
#pragma unroll 1
    for (int l0 = 0; l0 < 16; l0 += 8) { f32x4 t[16];
#pragma unroll
        for (int u = 0; u < 16; ++u) t[u] = *(const f32x4*)(src + (l0 + (u >> 1)) * 512 + (u & 1) * 256);
#pragma unroll
        for (int u = 0; u < 16; ++u) { u32x2 w; w.x = pk2(t[u].x, t[u].y); w.y = pk2(t[u].z, t[u].w);
            *(u32x2*)(CC + ((size_t)((db * 2 + (u & 1)) * 256 + g * 128 + n)) * 2048 + (l0 + (u >> 1)) * 128 + d) = w; } }
}
__device__ __forceinline__ void p0_prologue(const Frame& F, unsigned char* ldsg, const int skipmask) {
    LAS float* scr = (LAS float*)((LAS unsigned char*)ldsg + F.wave * 16384);
    const int gw = F.bid * 8 + F.wave, NGW = F.G * 8, lane = F.lane;
    if (!(skipmask & 1)) { LAS bf16_t* WL = (LAS bf16_t*)ldsg; constexpr int WLS = 2056;
      { f32x4 wv[4][6];
#pragma unroll
        for (int r = 0; r < 4; ++r)
#pragma unroll
            for (int q = 0; q < 6; ++q) wv[r][q] = *(const f32x4*)(F.w_in + (size_t)(F.tid + 512 * r) * 8728 + 4608 + 4 * q);
#pragma unroll
        for (int r = 0; r < 4; ++r) { const int k = F.tid + 512 * r; const float nm = F.norm_mix[k];
#pragma unroll
            for (int q = 0; q < 6; ++q)
#pragma unroll
                for (int e = 0; e < 4; ++e) WL[(4 * q + e) * WLS + k] = (bf16_t)(pk2(wv[r][q][e] * nm, 0.f) & 0xffffu);
#pragma unroll
            for (int c = 24; c < 32; ++c) WL[c * WLS + k] = (bf16_t)0; } }
      __syncthreads();
      bf16_t* XB = WSP(bf16_t, WS_XB); float* RS = WSP(float, WS_RSTD1); float* GN = WSP(float, WS_GNSA);
      const int fr = lane & 15, fq = lane >> 4;
      if (F.wave >= 5 && !(skipmask & 4)) { const int ipw = (DBATCH * 128 + F.G - 1) / F.G, lo = F.bid * ipw, hi0 = (lo + ipw) < DBATCH * 128 ? (lo + ipw) : DBATCH * 128, hi = (lo + CC_EARLY) < hi0 ? (lo + CC_EARLY) : hi0;
          for (int it = lo + (F.wave - 5); it < hi; it += 3) cc_item(F, it, lane); }
      for (int grp = F.wave * F.G + F.bid; grp < M / 16; grp += NGW) { const int m0 = grp * 16, m = m0 + fr;
          const float* xrow = ((m < MP) ? F.x_p + (size_t)m * DM : F.x_s + (size_t)(m - MP) * DM) + 8 * fq;
          bf16_t* xb = XB + (size_t)m * DM + 8 * fq; const LAS bf16_t* w0 = WL + fr * WLS + 8 * fq; const LAS bf16_t* w1 = w0 + 16 * WLS;
          f32x4 a0 = {0.f, 0.f, 0.f, 0.f}, a1 = {0.f, 0.f, 0.f, 0.f}; float ss = 0.f;
          f32x4 cur[16], nxt[16];
#pragma unroll
          for (int j = 0; j < 8; ++j) { cur[2 * j] = *(const f32x4*)(xrow + 32 * j); cur[2 * j + 1] = *(const f32x4*)(xrow + 32 * j + 4); }
#pragma unroll 1
          for (int b = 0; b < 8; ++b) { const int bn = b < 7 ? b + 1 : 7;
#pragma unroll
              for (int j = 0; j < 8; ++j) { nxt[2 * j] = *(const f32x4*)(xrow + 256 * bn + 32 * j); nxt[2 * j + 1] = *(const f32x4*)(xrow + 256 * bn + 32 * j + 4); }
#pragma unroll
              for (int j = 0; j < 8; ++j) { const f32x4 p = cur[2 * j], q = cur[2 * j + 1];
                  ss += (p.x * p.x + p.y * p.y) + (p.z * p.z + p.w * p.w) + (q.x * q.x + q.y * q.y) + (q.z * q.z + q.w * q.w);
                  const u32x4 pk = pack8u(p, q); *(u32x4*)(xb + 256 * b + 32 * j) = pk; const bf16x8 af = __builtin_bit_cast(bf16x8, pk);
                  const bf16x8 b0 = *(const LAS bf16x8*)(w0 + 256 * b + 32 * j), b1 = *(const LAS bf16x8*)(w1 + 256 * b + 32 * j);
                  a0 = __builtin_amdgcn_mfma_f32_16x16x32_bf16(af, b0, a0, 0, 0, 0); a1 = __builtin_amdgcn_mfma_f32_16x16x32_bf16(af, b1, a1, 0, 0, 0); }
#pragma unroll
              for (int j = 0; j < 16; ++j) cur[j] = nxt[j]; }
          ss += __shfl_xor(ss, 16); ss += __shfl_xor(ss, 32);
          const float rstd = 1.0f / sqrtf(ss * (1.0f / DM) + EPS);
          if (fq == 0) RS[m] = rstd;
#pragma unroll
          for (int i = 0; i < 4; ++i) { const float rsr = __shfl(rstd, 4 * fq + i);
              GN[(size_t)(m0 + 4 * fq + i) * 32 + fr] = sigmoidf_(a0[i] * rsr); GN[(size_t)(m0 + 4 * fq + i) * 32 + 16 + fr] = sigmoidf_(fr < 8 ? a1[i] * rsr : 0.f); } }
      __syncthreads(); }
    if (!(skipmask & 2)) { constexpr int NV = TR_IN + (2 * TR_G - TR_GDEF) + TR_C; tr_run(F, scr, lane, gw, NGW, NV, 1); }
    if (!(skipmask & 4)) { const int ipw = (DBATCH * 128 + F.G - 1) / F.G, lo = F.bid * ipw, hi = (lo + ipw) < DBATCH * 128 ? (lo + ipw) : DBATCH * 128;
      for (int it = lo + CC_EARLY + F.wave; it < hi; it += 8) cc_item(F, it, lane); }
    if (F.tid < 256) { const int c = F.tid >> 7, e2 = F.tid & 127, kb = F.bid * (4096 / F.G), ke = kb + 4096 / F.G; float s = 0.f;
        const float* pw = F.cmp_w + (size_t)c * 4096 * 128 + e2; const float* pp = F.cmp_pos + c * 4096;
#pragma unroll 8
        for (int k = kb; k < ke; ++k) s += pp[k] * pw[(size_t)k * 128];
        WSP(float, WS_POSP)[F.bid * 256 + F.tid] = s; }
}

#define EPI_ROWS(r_) _Pragma("unroll") for (int ai = 0; ai < 2; ++ai) _Pragma("unroll") for (int m = 0; m < 4; ++m) { const int r_ = row0 + ai * 128 + m * 16;
#define EPI_COLS(c_) _Pragma("unroll") for (int bj = 0; bj < 2; ++bj) { const int c_ = col0 + bj * 128; f32x4 v0 = acc[ai][bj][m][0], v1 = acc[ai][bj][m][1];
#define EPI_END } }
#define EPI_PIN(x) asm volatile("" : "+v"(x))
__device__ __forceinline__ void st_bf8(bf16_t* p, f32x4 a, f32x4 b) { *(u32x4*)p = pack8u(a, b); }
__device__ __forceinline__ void st_f8(float* p, f32x4 a, f32x4 b) { *(f32x4*)p = a; *(f32x4*)(p + 4) = b; }

struct EpiIn {
    static constexpr bool PERM = true, AFTER_DRAIN = false, MIDK = false, PRE = true;
    const float* rstd; bf16_t *XR, *GG, *Q, *KVS, *KVW, *CC, *SGM; float* GNSA; float* out; int skip; LAS float* RSL;
    __device__ __forceinline__ void pre(const Unit& u, int wid, int lane) const {
        if (wid < 4) { unsigned lo = (unsigned)lane * 4u; asm volatile("" : "+v"(lo)); __builtin_amdgcn_global_load_lds((const unsigned*)((const char*)(rstd + u.pm * 256 + wid * 64) + lo), (LAS unsigned*)(RSL + wid * 64), 4, 0, 0); } }
    __device__ __forceinline__ void operator()(const f32x4 (&acc)[2][2][4][2], const Unit& u, int wr, int wc, int fr, int fq) const {
        if (skip) { if (acc[0][0][0][0].x == 123456.789f) out[0] = 1.f; return; }
        const int row0 = u.pm * 256 + wr * 64 + fr, col0 = u.pn * 256 + wc * 32 + 8 * fq, pn = u.pn; const bool samp = u.pm >= 64;
        float rsv[2][4];
#pragma unroll
        for (int ai = 0; ai < 2; ++ai)
#pragma unroll
            for (int m = 0; m < 4; ++m) rsv[ai][m] = RSL[wr * 64 + fr + ai * 128 + m * 16];
#pragma unroll
        for (int ai = 0; ai < 2; ++ai)
#pragma unroll
            for (int m = 0; m < 4; ++m) EPI_PIN(rsv[ai][m]);
        EPI_ROWS(r) const float rs = rsv[ai][m];
            EPI_COLS(c) v0 *= rs; v1 *= rs;
                if (pn < 4) { st_bf8(XR + (size_t)r * 1024 + c, v0, v1);
                    if (!samp) { const int t = r & 2047; if (t >= 2045) st_f8(out + O_PRC + (size_t)((r >> 11) * 3 + (t - 2045)) * 1024 + c, v0, v1); }
                    else { const int tq = r & 3; if (tq >= 1) st_f8(out + O_SRC + (size_t)(((r - MP) >> 2) * 3 + tq - 1) * 1024 + c, v0, v1); } }
                else if (pn < 8) { f32x4 a, b;
#pragma unroll
                    for (int j = 0; j < 4; ++j) { a[j] = gelu_tanh(v0[j]); b[j] = gelu_tanh(v1[j]); }
                    st_bf8(GG + (size_t)r * 1024 + (c - 1024), a, b); }
                else if (pn < 12) { st_bf8(Q + (size_t)r * 1024 + (c - 2048), v0, v1); }
                else if (pn < 14) { const int cc = c - 3072;
                    if (!samp) { st_f8(out + O_PKC + (size_t)r * 512 + cc, v0, v1); const int t = r & 2047, b = r >> 11;
                        st_bf8(CC + ((size_t)((256 + b * 2 + (cc >> 8)) * 256 + ((cc >> 7) & 1) * 128 + (t >> 4))) * 2048 + (t & 15) * 128 + (cc & 127), v0, v1); }
                    else st_f8(out + O_SKC + (size_t)(r - MP) * 512 + cc, v0, v1); }
                else if (pn < 16) { const int cc = c - 3584; st_bf8(KVS + (size_t)r * 512 + cc, v0, v1);
                    if (!samp) st_f8(out + O_PKS + (size_t)r * 512 + cc, v0, v1); else st_f8(out + O_SKS + (size_t)(r - MP) * 512 + cc, v0, v1); }
                else if (pn < 18) { const int cc = c - 4096; st_bf8(KVW + (size_t)r * 512 + cc, v0, v1);
                    if (!samp) { const int t = r & 2047; if (t >= 1536) st_f8(out + O_PKW + (size_t)((r >> 11) * 512 + t - 1536) * 512 + cc, v0, v1); }
                    else { const int q = r - MP; st_f8(out + O_SKW + (size_t)((q >> 2) * 512 + 508 + (q & 3)) * 512 + cc, v0, v1); } }
                else { f32x4 a, b;
#pragma unroll
                    for (int j = 0; j < 4; ++j) { a[j] = sigmoidf_(v0[j]); b[j] = sigmoidf_(v1[j]); }
                    st_bf8(SGM + (size_t)r * 4096 + (c - 4608), a, b); }
            EPI_END
    }
};
struct EpiFS {
    static constexpr bool PERM = false, AFTER_DRAIN = false, MIDK = false, PRE = false;
    float* FS;
    __device__ __forceinline__ void operator()(const f32x4 (&acc)[2][2][4][2], const Unit& u, int wr, int wc, int fr, int fq) const {
        float* base = FS + (size_t)u.pm * 65536 + (size_t)(wr * 64 + fr) * 256 + wc * 32 + 4 * fq;
#pragma unroll
        for (int ai = 0; ai < 2; ++ai)
#pragma unroll
            for (int m = 0; m < 4; ++m)
#pragma unroll
                for (int bj = 0; bj < 2; ++bj)
#pragma unroll
                    for (int n = 0; n < 2; ++n) *(f32x4*)(base + (size_t)(ai * 128 + m * 16) * 256 + bj * 128 + n * 16) = acc[ai][bj][m][n];
    }
};
template <int PASS> struct EpiProj {
    static constexpr bool PERM = true, AFTER_DRAIN = false, MIDK = false, PRE = false;
    const bf16_t* SGM; bf16_t* T1; bf16_t* MB;
    __device__ __forceinline__ void operator()(const f32x4 (&acc)[2][2][4][2], const Unit& u, int wr, int wc, int fr, int fq) const {
        const int row0 = u.pm * 256 + wr * 64 + fr, col0 = u.pn * 256 + wc * 32 + 8 * fq;
#pragma unroll
        for (int ai = 0; ai < 2; ++ai) { u32x4 gw[4][2], tw[4][2];
#pragma unroll
            for (int m = 0; m < 4; ++m)
#pragma unroll
                for (int bj = 0; bj < 2; ++bj) { const size_t r = (size_t)(row0 + ai * 128 + m * 16); const int c = col0 + bj * 128; gw[m][bj] = *(const u32x4*)(SGM + r * 4096 + PASS * 2048 + c);
                    if (PASS == 1) tw[m][bj] = *(const u32x4*)(T1 + r * 2048 + c); }
#pragma unroll
            for (int m = 0; m < 4; ++m)
#pragma unroll
                for (int bj = 0; bj < 2; ++bj) { EPI_PIN(gw[m][bj]); if (PASS == 1) EPI_PIN(tw[m][bj]); }
#pragma unroll
            for (int m = 0; m < 4; ++m)
#pragma unroll
                for (int bj = 0; bj < 2; ++bj) { const size_t r = (size_t)(row0 + ai * 128 + m * 16); const int c = col0 + bj * 128; const u32x4 g_ = gw[m][bj];
                    const f32x4 g0 = {bflo(g_.x), bfhi(g_.x), bflo(g_.y), bfhi(g_.y)}, g1 = {bflo(g_.z), bfhi(g_.z), bflo(g_.w), bfhi(g_.w)};
                    f32x4 v0 = acc[ai][bj][m][0] * g0, v1 = acc[ai][bj][m][1] * g1;
                    if (PASS == 0) st_bf8(T1 + r * 2048 + c, v0, v1);
                    else { const u32x4 t_ = tw[m][bj]; v0 += (f32x4){bflo(t_.x), bfhi(t_.x), bflo(t_.y), bfhi(t_.y)}; v1 += (f32x4){bflo(t_.z), bfhi(t_.z), bflo(t_.w), bfhi(t_.w)};
                        st_bf8(MB + r * 2048 + c, v0, v1); } } }
    }
};
struct EpiProjM {
    static constexpr bool PERM = true, AFTER_DRAIN = false, MIDK = true, PRE = false;
    const bf16_t* SGM; bf16_t* MB;
    __device__ __forceinline__ void mid(f32x4 (&acc)[2][2][4][2], const Unit& u, int wr, int wc, int fr, int fq) const {
        asm volatile("" : "+v"(fr), "+v"(fq));
        const int row0 = u.pm * 256 + wr * 64 + fr, col0 = u.pn * 256 + wc * 32 + 8 * fq;
#pragma unroll
        for (int ai = 0; ai < 2; ++ai) { u32x4 gr[4][2], ga[4][2];
#pragma unroll
            for (int m = 0; m < 4; ++m)
#pragma unroll
                for (int bj = 0; bj < 2; ++bj) { const bf16_t* p = SGM + (size_t)(row0 + ai * 128 + m * 16) * 4096 + col0 + bj * 128; gr[m][bj] = *(const u32x4*)p; ga[m][bj] = *(const u32x4*)(p + 2048); }
#pragma unroll
            for (int m = 0; m < 4; ++m)
#pragma unroll
                for (int bj = 0; bj < 2; ++bj) { EPI_PIN(gr[m][bj]); EPI_PIN(ga[m][bj]); }
#pragma unroll
            for (int m = 0; m < 4; ++m)
#pragma unroll
                for (int bj = 0; bj < 2; ++bj) { const u32x4 r_ = gr[m][bj], a_ = ga[m][bj];
                    const f32x4 r0 = {bflo(r_.x), bfhi(r_.x), bflo(r_.y), bfhi(r_.y)}, r1 = {bflo(r_.z), bfhi(r_.z), bflo(r_.w), bfhi(r_.w)};
                    f32x4 a0 = {bflo(a_.x), bfhi(a_.x), bflo(a_.y), bfhi(a_.y)}, a1 = {bflo(a_.z), bfhi(a_.z), bflo(a_.w), bfhi(a_.w)};
#pragma unroll
                    for (int j = 0; j < 4; ++j) { a0[j] = __builtin_amdgcn_rcpf(fmaxf(a0[j], 1e-20f)); a1[j] = __builtin_amdgcn_rcpf(fmaxf(a1[j], 1e-20f)); }
                    acc[ai][bj][m][0] *= r0 * a0; acc[ai][bj][m][1] *= r1 * a1; } }
    }
    __device__ __forceinline__ void operator()(const f32x4 (&acc)[2][2][4][2], const Unit& u, int wr, int wc, int fr, int fq) const {
        const int row0 = u.pm * 256 + wr * 64 + fr, col0 = u.pn * 256 + wc * 32 + 8 * fq;
#pragma unroll
        for (int ai = 0; ai < 2; ++ai) { u32x4 ga[4][2];
#pragma unroll
            for (int m = 0; m < 4; ++m)
#pragma unroll
                for (int bj = 0; bj < 2; ++bj) ga[m][bj] = *(const u32x4*)(SGM + (size_t)(row0 + ai * 128 + m * 16) * 4096 + 2048 + col0 + bj * 128);
#pragma unroll
            for (int m = 0; m < 4; ++m)
#pragma unroll
                for (int bj = 0; bj < 2; ++bj) EPI_PIN(ga[m][bj]);
#pragma unroll
            for (int m = 0; m < 4; ++m)
#pragma unroll
                for (int bj = 0; bj < 2; ++bj) { const u32x4 a_ = ga[m][bj]; f32x4 a0 = {bflo(a_.x), bfhi(a_.x), bflo(a_.y), bfhi(a_.y)}, a1 = {bflo(a_.z), bfhi(a_.z), bflo(a_.w), bfhi(a_.w)};
#pragma unroll
                    for (int j = 0; j < 4; ++j) { a0[j] = fmaxf(a0[j], 1e-20f); a1[j] = fmaxf(a1[j], 1e-20f); }
                    st_bf8(MB + (size_t)(row0 + ai * 128 + m * 16) * 2048 + col0 + bj * 128, acc[ai][bj][m][0] * a0, acc[ai][bj][m][1] * a1); } }
    }
};
struct EpiOut {
    static constexpr bool PERM = true, AFTER_DRAIN = false, MIDK = false, PRE = false;
    const bf16_t* XB; bf16_t* XB2; float* SS;
    __device__ __forceinline__ void operator()(const f32x4 (&acc)[2][2][4][2], const Unit& u, int wr, int wc, int fr, int fq) const {
        const int row0 = u.pm * 256 + wr * 64 + fr, col0 = u.pn * 256 + wc * 32 + 8 * fq;
#pragma unroll
        for (int ai = 0; ai < 2; ++ai) { u32x4 xw[4][2];
#pragma unroll
            for (int m = 0; m < 4; ++m)
#pragma unroll
                for (int bj = 0; bj < 2; ++bj) xw[m][bj] = *(const u32x4*)(XB + (size_t)(row0 + ai * 128 + m * 16) * DM + col0 + bj * 128);
#pragma unroll
            for (int m = 0; m < 4; ++m)
#pragma unroll
                for (int bj = 0; bj < 2; ++bj) EPI_PIN(xw[m][bj]);
#pragma unroll
            for (int m = 0; m < 4; ++m) { const int r = row0 + ai * 128 + m * 16; float ss = 0.f;
#pragma unroll
                for (int bj = 0; bj < 2; ++bj) { const int c = col0 + bj * 128; const u32x4 w = xw[m][bj];
                    const f32x4 v0 = acc[ai][bj][m][0] + (f32x4){bflo(w.x), bfhi(w.x), bflo(w.y), bfhi(w.y)}, v1 = acc[ai][bj][m][1] + (f32x4){bflo(w.z), bfhi(w.z), bflo(w.w), bfhi(w.w)};
                    st_bf8(XB2 + (size_t)r * DM + c, v0, v1);
                    ss += (v0.x * v0.x + v0.y * v0.y) + (v0.z * v0.z + v0.w * v0.w) + (v1.x * v1.x + v1.y * v1.y) + (v1.z * v1.z + v1.w * v1.w); }
                ss += __shfl_xor(ss, 16); ss += __shfl_xor(ss, 32);
                if (fq == 0) SS[(size_t)r * 32 + u.pn * 4 + wc] = ss; } }
    }
};
__device__ __forceinline__ float dppf(float x, int ctrl_sel) {
    const int v = __float_as_int(x);
    const int r = ctrl_sel == 0 ? __builtin_amdgcn_update_dpp(0, v, 0x111, 0xf, 0xf, true) : ctrl_sel == 1 ? __builtin_amdgcn_update_dpp(0, v, 0x112, 0xf, 0xf, true)
                : ctrl_sel == 2 ? __builtin_amdgcn_update_dpp(0, v, 0x121, 0xf, 0xf, true) : __builtin_amdgcn_update_dpp(0, v, 0x122, 0xf, 0xf, true);
    return __int_as_float(r);
}
struct EpiFFN {
    static constexpr bool PERM = true, AFTER_DRAIN = false, MIDK = false, PRE = true;
    const float* RS2; const float* cw; const float* cbias; const float* st_ffn; bf16_t* ACT; float* out; float* GE; float* G0; float* U0; LAS float* XL; int skip;
    __device__ __forceinline__ void pre(const Unit& u, int wid, int lane) const {
        if (wid < 4) { LAS float* RSL = XL + 1024; LAS float* CWL = XL + 1280;
            unsigned lo = (unsigned)lane * 4u; asm volatile("" : "+v"(lo));
            __builtin_amdgcn_global_load_lds((const unsigned*)((const char*)(RS2 + u.pm * 256 + wid * 64) + lo), (LAS unsigned*)(RSL + wid * 64), 4, 0, 0);
            const float* src = (wid < 3 ? cw + (size_t)wid * DFF : cbias) + u.pn * 128;
            __builtin_amdgcn_global_load_lds((const unsigned*)((const char*)src + lo), (LAS unsigned*)(CWL + wid * 128), 4, 0, 0);
            __builtin_amdgcn_global_load_lds((const unsigned*)((const char*)(src + 64) + lo), (LAS unsigned*)(CWL + wid * 128 + 64), 4, 0, 0); } }
    __device__ __forceinline__ void operator()(const f32x4 (&acc)[2][2][4][2], const Unit& u, int wr, int wc, int fr, int fq) const {
        if (skip) { if (acc[0][0][0][0].x == 123456.789f) out[0] = 1.f; return; }
        const int row0 = u.pm * 256 + wr * 64 + fr, f0 = u.pn * 128 + wc * 32 + 8 * fq; const bool samp = u.pm >= 64;
        LAS float* RSL = XL + 1024;
        const LAS float* CWL = XL + 1280;
        float w0[8], w1[8], w2[8], bb[8];
#pragma unroll
        for (int e = 0; e < 8; e += 4) { const int fl = wc * 32 + 8 * fq + e; const f32x4 a = *(const LAS f32x4*)(CWL + fl), b4 = *(const LAS f32x4*)(CWL + 128 + fl), c4 = *(const LAS f32x4*)(CWL + 256 + fl), d4 = *(const LAS f32x4*)(CWL + 384 + fl);
#pragma unroll
            for (int j = 0; j < 4; ++j) { w0[e + j] = a[j]; w1[e + j] = b4[j]; w2[e + j] = c4[j]; bb[e + j] = d4[j]; } }
        LAS float* xw = XL + ((wr * 4 + wc) * 2) * 32 + 8 * fq;
#pragma unroll
        for (int ai = 0; ai < 2; ++ai) if (fr >= 14) { LAS float* p = xw + ai * (2 * 4 * 2 * 32) + (fr - 14) * 32; *(LAS f32x4*)p = acc[ai][0][3][0]; *(LAS f32x4*)(p + 4) = acc[ai][0][3][1]; }
        asm volatile("s_waitcnt lgkmcnt(0)\n\ts_barrier" ::: "memory");
        float rs[2][4];
#pragma unroll
        for (int ai = 0; ai < 2; ++ai)
#pragma unroll
            for (int m = 0; m < 4; ++m) rs[ai][m] = RSL[ai * 128 + wr * 64 + m * 16 + fr];
#pragma unroll
        for (int ai = 0; ai < 2; ++ai) {
            float x0[8], x1[8]; const int pb = ai * 2 + wr;
            if (pb > 0) { const LAS float* p = XL + (((pb - 1) * 4 + wc) * 2) * 32 + 8 * fq; const f32x4 a = *(const LAS f32x4*)p, b4 = *(const LAS f32x4*)(p + 4), c4 = *(const LAS f32x4*)(p + 32), d4 = *(const LAS f32x4*)(p + 36);
                const float sa = RSL[(pb - 1) * 64 + 62], sb = RSL[(pb - 1) * 64 + 63];
#pragma unroll
                for (int j = 0; j < 4; ++j) { x0[j] = a[j] * sa; x0[4 + j] = b4[j] * sa; x1[j] = c4[j] * sb; x1[4 + j] = d4[j] * sb; } }
            else {
#pragma unroll
                for (int j = 0; j < 8; ++j) { x0[j] = 0.f; x1[j] = 0.f; } }
            float gp[8];
#pragma unroll
            for (int j = 0; j < 8; ++j) gp[j] = 0.f;
#pragma unroll
            for (int m = 0; m < 4; ++m) { const int r = row0 + ai * 128 + m * 16; const float s = rs[ai][m];
                float g[8], uu[8], q1[8], q2[8];
#pragma unroll
                for (int j = 0; j < 4; ++j) { g[j] = acc[ai][0][m][0][j] * s; g[4 + j] = acc[ai][0][m][1][j] * s; uu[j] = acc[ai][1][m][0][j] * s; uu[4 + j] = acc[ai][1][m][1][j] * s; }
#pragma unroll
                for (int j = 0; j < 8; ++j) {
                    if (m == 0) { const float s1 = dppf(g[j], 0), s2 = dppf(g[j], 1); q1[j] = (fr == 0) ? x1[j] : s1; q2[j] = (fr == 0) ? x0[j] : (fr == 1) ? x1[j] : s2; }
                    else { const float r1 = dppf(gp[j], 2), r2 = dppf(gp[j], 3);
                        q1[j] = __int_as_float(__builtin_amdgcn_update_dpp(__float_as_int(r1), __float_as_int(g[j]), 0x111, 0xf, 0xf, false));
                        q2[j] = __int_as_float(__builtin_amdgcn_update_dpp(__float_as_int(r2), __float_as_int(g[j]), 0x112, 0xf, 0xf, false)); } }
                if (samp) { const int qq = r - MP, tq = qq & 3;
                    if (tq < 2) { const float* sp = st_ffn + (size_t)(qq >> 2) * 2 * DFF + f0; const f32x4 a = *(const f32x4*)(sp + DFF), b4 = *(const f32x4*)(sp + DFF + 4);
                        if (tq == 0) { const f32x4 c4 = *(const f32x4*)sp, d4 = *(const f32x4*)(sp + 4);
#pragma unroll
                            for (int j = 0; j < 4; ++j) { q1[j] = a[j]; q1[4 + j] = b4[j]; q2[j] = c4[j]; q2[4 + j] = d4[j]; } }
                        else {
#pragma unroll
                            for (int j = 0; j < 4; ++j) { q2[j] = a[j]; q2[4 + j] = b4[j]; } } }
                    if (tq >= 2) { float* op = out + O_SFC + (size_t)((qq >> 2) * 2 + tq - 2) * DFF + f0; *(f32x4*)op = (f32x4){g[0] * SC_SFC, g[1] * SC_SFC, g[2] * SC_SFC, g[3] * SC_SFC}; *(f32x4*)(op + 4) = (f32x4){g[4] * SC_SFC, g[5] * SC_SFC, g[6] * SC_SFC, g[7] * SC_SFC}; } }
                else { const int t = r & 2047; if (t >= 2046) { float* op = out + O_PFC + (size_t)((r >> 11) * 2 + t - 2046) * DFF + f0; *(f32x4*)op = (f32x4){g[0] * SC_PFC, g[1] * SC_PFC, g[2] * SC_PFC, g[3] * SC_PFC}; *(f32x4*)(op + 4) = (f32x4){g[4] * SC_PFC, g[5] * SC_PFC, g[6] * SC_PFC, g[7] * SC_PFC}; } }
                float ov[8];
#pragma unroll
                for (int j = 0; j < 8; j += 2) {
                    typedef float f32x2 __attribute__((ext_vector_type(2)));
                    const f32x2 W0 = {w0[j], w0[j + 1]}, W1 = {w1[j], w1[j + 1]}, W2 = {w2[j], w2[j + 1]}, BB = {bb[j], bb[j + 1]}, Q2 = {q2[j], q2[j + 1]}, Q1 = {q1[j], q1[j + 1]}, GG2 = {g[j], g[j + 1]}, UU = {uu[j], uu[j + 1]};
                    const f32x2 x = W2 * GG2 + (W1 * Q1 + (W0 * Q2 + BB));
                    const f32x2 t = (x * x) * 0.044715f + 1.0f, a2 = (x * t) * (-2.302208198f);
                    f32x2 ex; ex.x = __builtin_amdgcn_exp2f(a2.x); ex.y = __builtin_amdgcn_exp2f(a2.y);
                    const f32x2 dn = ex + 1.0f; f32x2 rc; rc.x = __builtin_amdgcn_rcpf(dn.x); rc.y = __builtin_amdgcn_rcpf(dn.y);
                    const f32x2 r2 = (x * rc) * UU; ov[j] = r2.x; ov[j + 1] = r2.y; }
                u32x4 o; o.x = pk2(ov[0], ov[1]); o.y = pk2(ov[2], ov[3]); o.z = pk2(ov[4], ov[5]); o.w = pk2(ov[6], ov[7]);
                *(u32x4*)(ACT + (size_t)r * DFF + f0) = o;
                if (ai == 1 && m == 3 && wr == 1 && fr >= 14) { float* p = GE + ((size_t)u.pm * 2 + (fr - 14)) * DFF + f0; *(f32x4*)p = (f32x4){g[0], g[1], g[2], g[3]}; *(f32x4*)(p + 4) = (f32x4){g[4], g[5], g[6], g[7]}; }
                if (ai == 0 && m == 0 && wr == 0 && fr < 2) { float* p = G0 + ((size_t)u.pm * 2 + fr) * DFF + f0; *(f32x4*)p = (f32x4){g[0], g[1], g[2], g[3]}; *(f32x4*)(p + 4) = (f32x4){g[4], g[5], g[6], g[7]};
                    float* p2 = U0 + ((size_t)u.pm * 2 + fr) * DFF + f0; *(f32x4*)p2 = (f32x4){uu[0], uu[1], uu[2], uu[3]}; *(f32x4*)(p2 + 4) = (f32x4){uu[4], uu[5], uu[6], uu[7]}; }
#pragma unroll
                for (int j = 0; j < 8; ++j) gp[j] = g[j];
            }
        }
    }
};
struct EpiDown {
    static constexpr bool PERM = false, AFTER_DRAIN = false, MIDK = false, PRE = false;
    const bf16_t* XB2; float* out; float* SS; int skip;
    __device__ __forceinline__ void operator()(const f32x4 (&acc)[2][2][4][2], const Unit& u, int wr, int wc, int fr, int fq) const {
        if (skip) { if (acc[0][0][0][0].x == 123456.789f) out[0] = 1.f; return; }
        const int row0 = u.pm * 256 + wr * 64 + fr, col0 = u.pn * 256 + wc * 32 + 4 * fq;
#pragma unroll
        for (int ai = 0; ai < 2; ++ai) { u32x2 xw[4][2][2];
#pragma unroll
            for (int m = 0; m < 4; ++m)
#pragma unroll
                for (int bj = 0; bj < 2; ++bj)
#pragma unroll
                    for (int n = 0; n < 2; ++n) xw[m][bj][n] = *(const u32x2*)(XB2 + (size_t)(row0 + ai * 128 + m * 16) * DM + col0 + bj * 128 + n * 16);
#pragma unroll
            for (int m = 0; m < 4; ++m)
#pragma unroll
                for (int bj = 0; bj < 2; ++bj)
#pragma unroll
                    for (int n = 0; n < 2; ++n) EPI_PIN(xw[m][bj][n]);
#pragma unroll
            for (int m = 0; m < 4; ++m) { const int r = row0 + ai * 128 + m * 16; float ss = 0.f;
#pragma unroll
                for (int bj = 0; bj < 2; ++bj)
#pragma unroll
                    for (int n = 0; n < 2; ++n) { const size_t o = (size_t)r * DM + col0 + bj * 128 + n * 16; const u32x2 w = xw[m][bj][n]; const f32x4 v = acc[ai][bj][m][n] + (f32x4){bflo(w.x), bfhi(w.x), bflo(w.y), bfhi(w.y)};
                        *(f32x4*)(out + o) = v; ss += (v.x * v.x + v.y * v.y) + (v.z * v.z + v.w * v.w); }
                ss += __shfl_xor(ss, 16); ss += __shfl_xor(ss, 32);
                if (fq == 0) SS[(size_t)r * 32 + u.pn * 4 + wc] = ss; } }
    }
};
template <int MODE  > struct EpiSlab {
    static constexpr bool PERM = false, AFTER_DRAIN = false, MIDK = false, PRE = false;
    float* SLAB; int kslice; const bf16_t* SGM;
    __device__ __forceinline__ void operator()(const f32x4 (&acc)[2][2][4][2], const Unit& u, int wr, int wc, int fr, int fq) const {
        int pm = u.pm, pn = u.pn, s = u.ko / kslice, pass = 0;
        if (MODE == 1 && pm >= 130) { pass = 1; pm -= 66; pn -= 8; s += 4; }
        float* base = SLAB + ((size_t)s * MS + (size_t)(pm - 64) * 256 + wr * 64 + fr) * DM + pn * 256 + wc * 32 + 4 * fq;
        const bf16_t* gb = SGM + (size_t)(pm * 256 + wr * 64 + fr) * 4096 + pass * 2048 + pn * 256 + wc * 32 + 4 * fq;
#pragma unroll
        for (int ai = 0; ai < 2; ++ai)
#pragma unroll
            for (int m = 0; m < 4; ++m)
#pragma unroll
                for (int bj = 0; bj < 2; ++bj)
#pragma unroll
                    for (int n = 0; n < 2; ++n) { f32x4 v = acc[ai][bj][m][n];
                        if (MODE == 1) { const u32x2 gw = *(const u32x2*)(gb + (size_t)(ai * 128 + m * 16) * 4096 + bj * 128 + n * 16); v *= (f32x4){bflo(gw.x), bfhi(gw.x), bflo(gw.y), bfhi(gw.y)}; }
                        *(f32x4*)(base + (size_t)(ai * 128 + m * 16) * DM + bj * 128 + n * 16) = v; }
    }
};
struct SplitOrder {
    int G, c, NS, kslice, mode;
    __device__ __forceinline__ bool next(int i, Unit& u) const { const int L = i * G + c; if (L >= 16 * NS) return false; const int un = L / NS; int s = L - un * NS; u.pm = 64 + (un >> 3); u.pn = un & 7;
        if (mode == 1 && s >= NS / 2) { s -= NS / 2; u.pm += 66; u.pn += 8; } u.ko = s * kslice; return true; }
    __device__ __forceinline__ void a_ready(const Unit&) const {}
    __device__ __forceinline__ void done(const Unit&) const {}
};
struct CmpOrder {
    int G, c, base, count;
    __device__ __forceinline__ bool next(int i, Unit& u) const { const int L = i * G + c; if (L >= count) return false; u.pm = base + L; u.pn = (base + L) & 1; u.ko = 0; return true; }
    __device__ __forceinline__ void a_ready(const Unit&) const {}
    __device__ __forceinline__ void done(const Unit&) const {}
};

constexpr int RG_XC = 0, RG_WA = 34816, RG_WX = 43520, RG_A = 52224, RG_B = 68608, RG_U = 84992, RG_SA = 101376, RG_SH = 103424, RG_HC = 105472;
__device__ __forceinline__ void rglru_unit(const Frame& F, int unit, unsigned char* ldsg) {
    LAS unsigned char* lds = (LAS unsigned char*)ldsg;
    int tid = F.tid; asm volatile("" : "+v"(tid));
    const int lane = tid & 63, wid = F.wave, r32 = lane & 31, hi = lane >> 5;
    const bool samp = unit >= 256; int b = 0, n, q, grp = 0;
    if (!samp) { b = unit >> 5; n = (unit >> 2) & 7; q = unit & 3; } else { const int u2 = unit - 256; n = u2 >> 4; q = (u2 >> 2) & 3; grp = u2 & 3; }
    const int rowbase = samp ? MP + grp * 128 : b * SEQ, nchunks = samp ? 1 : 16;
    const bf16_t* XR = WSP(bf16_t, WS_XR); const bf16_t* GG = WSP(bf16_t, WS_GG); bf16_t* Y = WSP(bf16_t, WS_Y);
    LAS bf16_t* XC = (LAS bf16_t*)(lds + RG_XC); LAS bf16_t* WAT = (LAS bf16_t*)(lds + RG_WA); LAS bf16_t* WXT = (LAS bf16_t*)(lds + RG_WX);
    LAS float* As = (LAS float*)(lds + RG_A); LAS float* Bs = (LAS float*)(lds + RG_B); LAS float* Us = (LAS float*)(lds + RG_U);
    LAS float* SA = (LAS float*)(lds + RG_SA); LAS float* SH = (LAS float*)(lds + RG_SH); LAS float* HC = (LAS float*)(lds + RG_HC);
    __syncthreads();
    for (int idx = tid; idx < 4096; idx += 512) { const int c = idx >> 5, d = idx & 31; const size_t o = ((size_t)n * 128 + c) * 128 + q * 32 + d;
        WAT[d * 136 + c] = (bf16_t)(pk2(F.rwa[o], 0.f) & 0xffffu); WXT[d * 136 + c] = (bf16_t)(pk2(F.rwx[o], 0.f) & 0xffffu); }
    if (tid < 32) HC[tid] = 0.f;
    const int cg = tid & 15; float cw[4][8], cb[8];
#pragma unroll
    for (int e = 0; e < 8; ++e) { const int ch = n * 128 + cg * 8 + e; cb[e] = F.rconv_b[ch];
#pragma unroll
        for (int j = 0; j < 4; ++j) cw[j][e] = F.rconv_w[j * 1024 + ch]; }
    const int which = wid >> 2, rt = wid & 3, chd = n * 128 + q * 32 + r32;
    const float gbias = which ? F.rbx[chd] : F.rba[chd];
    const float sp8 = -8.0f * log1pf(expf(-F.rlam[chd]));
    const int sd = tid & 31, seg = tid >> 5, sch = n * 128 + q * 32 + sd;
    for (int ck = 0; ck < nchunks; ++ck) {
        const int r0 = rowbase + ck * 128;
        __syncthreads();
#pragma unroll
        for (int k = 0; k < 4; ++k) { const int item = tid + 512 * k, row = item >> 4; const int gr = r0 + row; float acc8[8];
#pragma unroll
            for (int e = 0; e < 8; ++e) acc8[e] = cb[e];
#pragma unroll
            for (int j = 0; j < 4; ++j) { float xv[8]; bool have = true;
                if (!samp) { const int t = ck * 128 + row - 3 + j; have = t >= 0;
                    if (have) { const u32x4 w = *(const u32x4*)(XR + (size_t)(gr - 3 + j) * 1024 + n * 128 + cg * 8);
                        xv[0] = bflo(w.x); xv[1] = bfhi(w.x); xv[2] = bflo(w.y); xv[3] = bfhi(w.y); xv[4] = bflo(w.z); xv[5] = bfhi(w.z); xv[6] = bflo(w.w); xv[7] = bfhi(w.w); } }
                else { const int qq = gr - MP, db = qq >> 2, tq = qq & 3, tt = tq - 3 + j;
                    if (tt >= 0) { const u32x4 w = *(const u32x4*)(XR + (size_t)(gr - 3 + j) * 1024 + n * 128 + cg * 8);
                        xv[0] = bflo(w.x); xv[1] = bfhi(w.x); xv[2] = bflo(w.y); xv[3] = bfhi(w.y); xv[4] = bflo(w.z); xv[5] = bfhi(w.z); xv[6] = bflo(w.w); xv[7] = bfhi(w.w); }
                    else { const float* sp = F.st_conv + ((size_t)db * 3 + (tq + j)) * 1024 + n * 128 + cg * 8; const f32x4 a = *(const f32x4*)sp, c4 = *(const f32x4*)(sp + 4);
                        xv[0] = a.x; xv[1] = a.y; xv[2] = a.z; xv[3] = a.w; xv[4] = c4.x; xv[5] = c4.y; xv[6] = c4.z; xv[7] = c4.w; } }
                if (have) {
#pragma unroll
                    for (int e = 0; e < 8; ++e) acc8[e] += cw[j][e] * xv[e]; } }
            u32x4 o; o.x = pk2(acc8[0], acc8[1]); o.y = pk2(acc8[2], acc8[3]); o.z = pk2(acc8[4], acc8[5]); o.w = pk2(acc8[6], acc8[7]);
            *(LAS u32x4*)(XC + row * 136 + cg * 8) = o; }
        __syncthreads();
        { f32x16 acc;
#pragma unroll
          for (int r = 0; r < 16; ++r) acc[r] = gbias;
          const LAS bf16_t* wt = which ? WXT : WAT;
#pragma unroll
          for (int ks = 0; ks < 8; ++ks) { const bf16x8 af = *(const LAS bf16x8*)(XC + (rt * 32 + r32) * 136 + ks * 16 + hi * 8); const bf16x8 bfr = *(const LAS bf16x8*)(wt + r32 * 136 + ks * 16 + hi * 8);
              acc = __builtin_amdgcn_mfma_f32_32x32x16_bf16(af, bfr, acc, 0, 0, 0); }
#pragma unroll
          for (int r = 0; r < 16; ++r) { const int row = rt * 32 + (r & 3) + 8 * (r >> 2) + 4 * hi; const float sg = sigmoidf_(acc[r]);
              if (which == 0) { const float la = sp8 * sg; As[row * 32 + r32] = expf(la); Bs[row * 32 + r32] = sqrtf(-expm1f(2.0f * la)); }
              else { Us[row * 32 + r32] = sg * bf2f(XC[row * 136 + q * 32 + r32]); } } }
        __syncthreads();
        if (!samp) { float hl[8], cl[8]; float h = 0.f, ca = 1.f;
#pragma unroll
            for (int i = 0; i < 8; ++i) { const int row = seg * 8 + i; const float a = As[row * 32 + sd], uu = Bs[row * 32 + sd] * Us[row * 32 + sd]; h = a * h + uu; ca *= a; hl[i] = h; cl[i] = ca; }
            SA[seg * 32 + sd] = ca; SH[seg * 32 + sd] = h;
            __syncthreads();
            float hin = HC[sd];
            for (int s = 0; s < seg; ++s) hin = SA[s * 32 + sd] * hin + SH[s * 32 + sd];
            float hh = 0.f;
#pragma unroll
            for (int i = 0; i < 8; ++i) { const int gr = r0 + seg * 8 + i; hh = hl[i] + cl[i] * hin; const float gg = bf2f(GG[(size_t)gr * 1024 + sch]);
                Y[(size_t)gr * 1024 + sch] = (bf16_t)(pk2(hh * gg, 0.f) & 0xffffu); }
            __syncthreads();
            if (seg == 15) { HC[sd] = hh; if (ck == nchunks - 1) F.out[O_PRH + (size_t)b * 1024 + sch] = hh * SC_PRH; }
        } else { float h = 0.f;
#pragma unroll
            for (int i = 0; i < 8; ++i) { const int row = seg * 8 + i, gr = r0 + row, qq = gr - MP, db = qq >> 2, tq = qq & 3;
                if (tq == 0) h = F.st_h[(size_t)db * 1024 + sch];
                const float a = As[row * 32 + sd], uu = Bs[row * 32 + sd] * Us[row * 32 + sd]; h = a * h + uu;
                const float gg = bf2f(GG[(size_t)gr * 1024 + sch]); Y[(size_t)gr * 1024 + sch] = (bf16_t)(pk2(h * gg, 0.f) & 0xffffu);
                if (tq == 3) F.out[O_SRH + (size_t)db * 1024 + sch] = h * SC_SRH; } }
    }
}

constexpr int RP_XRAW = 0, RP_XC = 33792, RP_WA = 68608, RP_WX = 77312, RP_A = 86016, RP_U = 102400, RP_SA = 118784, RP_SH = 120832, RP_HC = 122880;
__device__ __forceinline__ void rglru_prompt_unit(const Frame& F, int unit, unsigned char* ldsg) {
    LAS unsigned char* lds = (LAS unsigned char*)ldsg;
    int tid = F.tid; asm volatile("" : "+v"(tid));
    const int lane = tid & 63, wid = F.wave;
    const int b = unit >> 5, n = (unit >> 2) & 7, q = unit & 3, rowbase = b * SEQ;
    const bf16_t* XR = WSP(bf16_t, WS_XR); const bf16_t* GG = WSP(bf16_t, WS_GG); bf16_t* Y = WSP(bf16_t, WS_Y);
    LAS bf16_t* XRAW = (LAS bf16_t*)(lds + RP_XRAW); LAS bf16_t* XC = (LAS bf16_t*)(lds + RP_XC); LAS bf16_t* WAT = (LAS bf16_t*)(lds + RP_WA); LAS bf16_t* WXT = (LAS bf16_t*)(lds + RP_WX);
    LAS float* As = (LAS float*)(lds + RP_A); LAS float* Us = (LAS float*)(lds + RP_U);
    LAS float* SA = (LAS float*)(lds + RP_SA); LAS float* SH = (LAS float*)(lds + RP_SH); LAS float* HC = (LAS float*)(lds + RP_HC);
    __syncthreads();
    for (int idx = tid; idx < 4096; idx += 512) { const int c = idx >> 5, d = idx & 31; const size_t o = ((size_t)n * 128 + c) * 128 + q * 32 + d;
        WAT[d * 136 + c] = (bf16_t)(pk2(F.rwa[o], 0.f) & 0xffffu); WXT[d * 136 + c] = (bf16_t)(pk2(F.rwx[o], 0.f) & 0xffffu); }
    if (tid < 32) HC[tid] = 0.f;
    const int cg = tid & 15; float cw[4][8], cb[8];
#pragma unroll
    for (int e = 0; e < 8; ++e) { const int ch = n * 128 + cg * 8 + e; cb[e] = F.rconv_b[ch];
#pragma unroll
        for (int j = 0; j < 4; ++j) cw[j][e] = F.rconv_w[j * 1024 + ch]; }
    const int fr = lane & 15, fq = lane >> 4; float gba[2], gbx[2], sp8[2];
#pragma unroll
    for (int ct = 0; ct < 2; ++ct) { const int chd = n * 128 + q * 32 + ct * 16 + fr; gba[ct] = F.rba[chd]; gbx[ct] = F.rbx[chd]; sp8[ct] = -8.0f * 1.4426950409f * log1pf(expf(-F.rlam[chd])); }
    const int sd = tid & 31, seg = tid >> 5;
    const int orow = tid >> 2, ocg = tid & 3;
    u32x4 raw[5], ggp;
#pragma unroll
    for (int k = 0; k < 5; ++k) { const int p = tid + 512 * k, rr = (p >> 4) - 4; raw[k] = (u32x4){0u, 0u, 0u, 0u};
        if (p < 2112 && rr >= 0) raw[k] = *(const u32x4*)(XR + (size_t)(rowbase + rr) * 1024 + n * 128 + (p & 15) * 8); }
    ggp = *(const u32x4*)(GG + (size_t)(rowbase + orow) * 1024 + n * 128 + q * 32 + ocg * 8);
    for (int ck = 0; ck < 16; ++ck) {
        const int r0 = rowbase + ck * 128;
        __syncthreads();
#pragma unroll
        for (int k = 0; k < 5; ++k) { const int p = tid + 512 * k; if (p < 2112) *(LAS u32x4*)(XRAW + (p >> 4) * 128 + (p & 15) * 8) = raw[k]; }
        const u32x4 ggc = ggp;
        if (ck < 15) {
#pragma unroll
            for (int k = 0; k < 5; ++k) { const int p = tid + 512 * k; if (p < 2112) raw[k] = *(const u32x4*)(XR + (size_t)(r0 + 124 + (p >> 4)) * 1024 + n * 128 + (p & 15) * 8); }
            ggp = *(const u32x4*)(GG + (size_t)(r0 + 128 + orow) * 1024 + n * 128 + q * 32 + ocg * 8); }
        __syncthreads();
#pragma unroll
        for (int k = 0; k < 4; ++k) { const int row = (tid >> 4) + 32 * k; float acc8[8];
#pragma unroll
            for (int e = 0; e < 8; ++e) acc8[e] = cb[e];
#pragma unroll
            for (int j = 0; j < 4; ++j) { const u32x4 w = *(const LAS u32x4*)(XRAW + (row + 1 + j) * 128 + cg * 8);
                acc8[0] += cw[j][0] * bflo(w.x); acc8[1] += cw[j][1] * bfhi(w.x); acc8[2] += cw[j][2] * bflo(w.y); acc8[3] += cw[j][3] * bfhi(w.y);
                acc8[4] += cw[j][4] * bflo(w.z); acc8[5] += cw[j][5] * bfhi(w.z); acc8[6] += cw[j][6] * bflo(w.w); acc8[7] += cw[j][7] * bfhi(w.w); }
            u32x4 o; o.x = pk2(acc8[0], acc8[1]); o.y = pk2(acc8[2], acc8[3]); o.z = pk2(acc8[4], acc8[5]); o.w = pk2(acc8[6], acc8[7]);
            *(LAS u32x4*)(XC + row * 136 + cg * 8) = o; }
        __syncthreads();
        { f32x4 ar[2], ai[2];
#pragma unroll
          for (int ct = 0; ct < 2; ++ct) { ar[ct] = (f32x4){gba[ct], gba[ct], gba[ct], gba[ct]}; ai[ct] = (f32x4){gbx[ct], gbx[ct], gbx[ct], gbx[ct]}; }
#pragma unroll
          for (int ks = 0; ks < 4; ++ks) { const bf16x8 af = *(const LAS bf16x8*)(XC + (wid * 16 + fr) * 136 + ks * 32 + fq * 8);
#pragma unroll
              for (int ct = 0; ct < 2; ++ct) { const bf16x8 ba = *(const LAS bf16x8*)(WAT + (ct * 16 + fr) * 136 + ks * 32 + fq * 8), bx = *(const LAS bf16x8*)(WXT + (ct * 16 + fr) * 136 + ks * 32 + fq * 8);
                  ar[ct] = __builtin_amdgcn_mfma_f32_16x16x32_bf16(af, ba, ar[ct], 0, 0, 0); ai[ct] = __builtin_amdgcn_mfma_f32_16x16x32_bf16(af, bx, ai[ct], 0, 0, 0); } }
#pragma unroll
          for (int ct = 0; ct < 2; ++ct)
#pragma unroll
              for (int j = 0; j < 4; ++j) { const int row = wid * 16 + fq * 4 + j, d = ct * 16 + fr;
                  const float rg = sigmoidf_(ar[ct][j]), ig = sigmoidf_(ai[ct][j]); const float l2 = sp8[ct] * rg;
                  const float a = __builtin_amdgcn_exp2f(l2); const float x = 1.3862943611f * l2;
                  const float om = (x > -0.05f) ? -x * (1.0f + x * (0.5f + x * (0.16666667f + x * 0.041666668f))) : 1.0f - a * a;
                  As[row * 32 + d] = a; Us[row * 32 + d] = __builtin_amdgcn_sqrtf(om) * ig * bf2f(XC[row * 136 + q * 32 + d]); } }
        __syncthreads();
        float hl[8], cl[8]; float h = 0.f, ca = 1.f;
#pragma unroll
        for (int i = 0; i < 8; ++i) { const int row = seg * 8 + i; const float a = As[row * 32 + sd]; h = a * h + Us[row * 32 + sd]; ca *= a; hl[i] = h; cl[i] = ca; }
        SA[seg * 32 + sd] = ca; SH[seg * 32 + sd] = h;
        __syncthreads();
        float hin = HC[sd];
        for (int s = 0; s < seg; ++s) hin = SA[s * 32 + sd] * hin + SH[s * 32 + sd];
        float hh = 0.f;
#pragma unroll
        for (int i = 0; i < 8; ++i) { hh = hl[i] + cl[i] * hin; As[(seg * 8 + i) * 32 + sd] = hh; }
        __syncthreads();
        if (seg == 15) { HC[sd] = hh; if (ck == 15) F.out[O_PRH + (size_t)b * 1024 + n * 128 + q * 32 + sd] = hh * SC_PRH; }
        { const LAS f32x4* hp = (const LAS f32x4*)(As + orow * 32 + ocg * 8); const f32x4 h0 = hp[0], h1 = hp[1];
          u32x4 o; o.x = pk2(h0.x * bflo(ggc.x), h0.y * bfhi(ggc.x)); o.y = pk2(h0.z * bflo(ggc.y), h0.w * bfhi(ggc.y)); o.z = pk2(h1.x * bflo(ggc.z), h1.y * bfhi(ggc.z)); o.w = pk2(h1.z * bflo(ggc.w), h1.w * bfhi(ggc.w));
          *(u32x4*)(Y + (size_t)(r0 + orow) * 1024 + n * 128 + q * 32 + ocg * 8) = o; }
    }
}

#ifndef QB_OF
#define QB_OF(x) (31 - (x))
#endif
namespace att {
#ifndef ATT_THR
#define ATT_THR 8.f
#endif
constexpr float SCALE = 0.08838834764831845f, THR = ATT_THR;
constexpr int A_V = 0, A_K = 16384, A_WS = 32768, A_IMPA = 36864, A_IMPB = 70656, A_IMP = 104448, A_SEL = 112896, A_UNI = 113152, A_SC = 113408, A_Q = 115712;
#define KSWZ(row, colB) ((row) * 256 + ((colB) ^ (((row) & 7) << 4)))
#define SBAR() __builtin_amdgcn_sched_barrier(0)
__device__ __forceinline__ int v_st(int k, int c) { const int kk = (k & ~0xC) | ((k & 4) << 1) | ((k & 8) >> 1); return ((kk >> 3) * 4 + (c >> 5)) * 512 + ((kk & 7) * 32 + (c & 31)) * 2; }
__device__ __forceinline__ int v_rd_base(int lane) { return ((lane & 3) << 3) | (((lane >> 2) & 3) << 6) | (((lane >> 4) & 1) << 5) | (((lane >> 5) & 1) << 8); }
constexpr int v_rd_off(int d0, int ks, int half) { return d0 * 512 + ks * 4096 + half * 2048; }
__device__ __forceinline__ int crow(int r, int hi) { return (r & 3) + 8 * (r >> 2) + 4 * hi; }
__device__ __forceinline__ unsigned cvtpk(float lo, float hi) { return pg8::cvt_pk_bf16(lo, hi); }

__device__ __forceinline__ void mask_tile(f32x16& p0, f32x16& p1, int dq, int kstep, unsigned W, bool rowsel) {
    const float NEG = -__builtin_inff();
#pragma unroll
    for (int r = 0; r < 16; ++r) { const int c = (r & 3) + 8 * (r >> 2);
        const bool bad0 = (!rowsel) | ((unsigned)(dq - kstep * c) > W), bad1 = (!rowsel) | ((unsigned)(dq - kstep * (c + 32)) > W);
        p0[r] = bad0 ? NEG : p0[r]; p1[r] = bad1 ? NEG : p1[r]; }
}
__device__ __forceinline__ void partialSM(f32x16& p0, f32x16& p1, float& m_reg, float& mn, float& alpha) {
    float pmax = p0[0];
#pragma unroll
    for (int r = 1; r < 16; ++r) pmax = fmaxf(pmax, p0[r]);
#pragma unroll
    for (int r = 0; r < 16; ++r) pmax = fmaxf(pmax, p1[r]);
    { auto rr = __builtin_amdgcn_permlane32_swap(__float_as_uint(pmax), __float_as_uint(pmax), false, false);
      pmax = fmaxf(__uint_as_float(rr[0]), __uint_as_float(rr[1])); }
    constexpr float C2 = 1.4426950408889634f * SCALE;
    if (__builtin_expect(__all((pmax - m_reg) * SCALE <= THR), 1)) { mn = m_reg; alpha = 1.f; }
    else { mn = fmaxf(m_reg, pmax); alpha = __builtin_amdgcn_exp2f((m_reg - mn) * C2); m_reg = mn; }
    const float mnL = -mn * C2;
#pragma unroll
    for (int r = 0; r < 16; ++r) { p0[r] = __builtin_amdgcn_exp2f(fmaf(p0[r], C2, mnL)); p1[r] = __builtin_amdgcn_exp2f(fmaf(p1[r], C2, mnL)); }
}
__device__ __forceinline__ void finishSM(f32x16& p0, f32x16& p1, float alpha, float& l_reg, bf16x8& pa0, bf16x8& pa1, bf16x8& pa2, bf16x8& pa3) {
    float ps = 0;
#pragma unroll
    for (int r = 0; r < 16; ++r) ps += p0[r];
#pragma unroll
    for (int r = 0; r < 16; ++r) ps += p1[r];
    { auto rr = __builtin_amdgcn_permlane32_swap(__float_as_uint(ps), __float_as_uint(ps), false, false);
      ps = __uint_as_float(rr[0]) + __uint_as_float(rr[1]); }
    l_reg = l_reg * alpha + ps;
#define PK4(P, B_, OUT) do { unsigned a0 = cvtpk(P[B_+0], P[B_+1]), a1 = cvtpk(P[B_+2], P[B_+3]);                          \
        unsigned b0 = cvtpk(P[B_+4], P[B_+5]), b1 = cvtpk(P[B_+6], P[B_+7]);                                             \
        auto r0 = __builtin_amdgcn_permlane32_swap(a0, b0, false, false); auto r1 = __builtin_amdgcn_permlane32_swap(a1, b1, false, false); \
        u32x4 w = {r0[0], r1[0], r0[1], r1[1]}; OUT = *reinterpret_cast<bf16x8*>(&w); } while (0)
    PK4(p0, 0, pa0); PK4(p0, 8, pa1); PK4(p1, 0, pa2); PK4(p1, 8, pa3);
#undef PK4
}
template <bool QLDS>
__device__ __forceinline__ void qkt(f32x16& p0, f32x16& p1, const LAS char* K_lds, int r32, int hi, const bf16x8* qr, const LAS char* Q_lds, float bbase, float bstep) {
#pragma unroll
    for (int r = 0; r < 16; ++r) { const int c = (r & 3) + 8 * (r >> 2); p0[r] = fmaf(bstep, (float)c, bbase); p1[r] = fmaf(bstep, (float)(c + 32), bbase); }
    const LAS char* kb[4];
#pragma unroll
    for (int dd = 0; dd < 4; ++dd) kb[dd] = K_lds + KSWZ(r32, (dd * 16 + hi * 8) * 2);
#pragma unroll
    for (int d0 = 0; d0 < 8; ++d0) { const LAS char* a = kb[d0 & 3] + (d0 >> 2) * 128;
        const bf16x8 b0 = *reinterpret_cast<const LAS bf16x8*>(a);
        const bf16x8 b1 = *reinterpret_cast<const LAS bf16x8*>(a + 32 * 256);
        const bf16x8 qf = QLDS ? *reinterpret_cast<const LAS bf16x8*>(Q_lds + d0 * 1024) : qr[d0];
        p0 = __builtin_amdgcn_mfma_f32_32x32x16_bf16(b0, qf, p0, 0, 0, 0);
        p1 = __builtin_amdgcn_mfma_f32_32x32x16_bf16(b1, qf, p1, 0, 0, 0); }
}
__device__ __forceinline__ void pv_tile(f32x16* o, int vb0, bf16x8 pa0, bf16x8 pa1, bf16x8 pa2, bf16x8 pa3) {
#define TRRD(dst, off) asm volatile("ds_read_b64_tr_b16 %0, %1 offset:%2" : "=&v"(dst) : "v"(vb0), "i"(off) : "memory")
#define PV_D0(d0) do { s16x4 l0, l1, l2, l3, h0, h1, h2, h3; constexpr int b_ = v_rd_off(d0, 0, 0); \
        TRRD(l0, b_); TRRD(h0, b_ + 2048); TRRD(l1, b_ + 4096); TRRD(h1, b_ + 6144); TRRD(l2, b_ + 8192); TRRD(h2, b_ + 10240); TRRD(l3, b_ + 12288); TRRD(h3, b_ + 14336); \
        asm volatile("s_waitcnt lgkmcnt(0)" ::: "memory"); SBAR();   \
        o[d0] = __builtin_amdgcn_mfma_f32_32x32x16_bf16(pa0, (bf16x8){l0[0], l0[1], l0[2], l0[3], h0[0], h0[1], h0[2], h0[3]}, o[d0], 0, 0, 0);   \
        o[d0] = __builtin_amdgcn_mfma_f32_32x32x16_bf16(pa1, (bf16x8){l1[0], l1[1], l1[2], l1[3], h1[0], h1[1], h1[2], h1[3]}, o[d0], 0, 0, 0);   \
        o[d0] = __builtin_amdgcn_mfma_f32_32x32x16_bf16(pa2, (bf16x8){l2[0], l2[1], l2[2], l2[3], h2[0], h2[1], h2[2], h2[3]}, o[d0], 0, 0, 0);   \
        o[d0] = __builtin_amdgcn_mfma_f32_32x32x16_bf16(pa3, (bf16x8){l3[0], l3[1], l3[2], l3[3], h3[0], h3[1], h3[2], h3[3]}, o[d0], 0, 0, 0); } while (0)
    PV_D0(0); PV_D0(1); PV_D0(2); PV_D0(3);
#undef PV_D0
#undef TRRD
}
struct Tile { const void* K; const void* V; int stride; int mode  ; int nvalid; int kp0, kstep; unsigned W; int selbit; int n0; int wrow  ; };

template <bool SAMPLE>
__device__ __forceinline__ void attn_unit(const Frame& F, int uidx, unsigned char* ldsg) {
    LAS char* lds = (LAS char*)ldsg;
    int tid = F.tid; asm volatile("" : "+v"(tid));
    const int wid = F.wave, lane = tid & 63, r32 = lane & 31, hi = lane >> 5;
    int b = 0, g, qb = 32, db = 0;
    if (SAMPLE) { db = uidx >> 1; g = uidx & 1; } else { qb = QB_OF(uidx >> 4); b = (uidx & 15) >> 1; g = uidx & 1; }
    const bool active = SAMPLE ? (wid == 0) : true;
    const int hl = SAMPLE ? ((r32 & 15) >> 2) : (wid >> 1), tok = SAMPLE ? (r32 & 3) : ((wid & 1) * 32 + r32);
    const bool rowvalid = SAMPLE ? (r32 < 16) : true;
    const int t = SAMPLE ? SEQ + tok : qb * 64 + tok;
    const size_t grow = SAMPLE ? (size_t)MP + db * 4 + tok : (size_t)b * SEQ + t;
    const int head = g * 4 + hl;
    const float sl_raw = __builtin_amdgcn_exp2f(-(float)(head + 1)) * (1.0f / SCALE);
    const bf16_t* Qg = WSP(bf16_t, WS_Q); const bf16_t* KVS = WSP(bf16_t, WS_KVS); const bf16_t* KVWb = WSP(bf16_t, WS_KVW);
    const float* FS = WSP(float, WS_FS); const float* POSB = WSP(float, WS_POSB); const float* GNSA = WSP(float, WS_GNSA);
    float* OMIX = WSP(float, WS_OMIX); bf16_t* OB = WSP(bf16_t, WS_OB);
    bf16x8 qr[8]; const LAS char* Q_lds = lds + A_Q + lane * 16;
    if (SAMPLE) { __syncthreads();
        if (wid == 0) {
#pragma unroll
            for (int d0 = 0; d0 < 8; ++d0) { bf16x8 qv = *(const bf16x8*)(Qg + grow * 1024 + head * 128 + d0 * 16 + hi * 8);
#ifdef QDEGRADE
                for (int e = 0; e < 8; ++e) qv[e] &= (short)0xFFFC;
#endif
                *(LAS bf16x8*)(lds + A_Q + d0 * 1024 + lane * 16) = qv; } }
    } else {
#pragma unroll
        for (int d0 = 0; d0 < 8; ++d0) { qr[d0] = *(const bf16x8*)(Qg + grow * 1024 + head * 128 + d0 * 16 + hi * 8);
#ifdef QDEGRADE
            for (int e = 0; e < 8; ++e) qr[d0][e] &= (short)0xFFFC;
#endif
        } }
    LAS char* V_lds = lds + A_V; LAS char* K_lds = lds + A_K;
    LAS float* li_l = (LAS float*)(lds + A_WS) + wid * 64; LAS float* al_l = li_l + 32;
    LAS float* IMPA = (LAS float*)(lds + A_IMPA); LAS float* IMPB = (LAS float*)(lds + A_IMPB); LAS float* IMP = (LAS float*)(lds + A_IMP);
    LAS unsigned* SEL = (LAS unsigned*)(lds + A_SEL); LAS unsigned* UNI = (LAS unsigned*)(lds + A_UNI); LAS float* SC = (LAS float*)(lds + A_SC);
    const int vb0 = (int)(unsigned)(size_t)V_lds + v_rd_base(lane);
    const int sr = tid >> 4, sc = (tid & 15) * 8, vst0 = v_st(sr, sc), vst1 = v_st(32 + sr, sc), kws = KSWZ(sr, sc * 2);
    const int fsunit = SAMPLE ? db * 2 : 256 + b * 2;
#ifdef ATT_EQUIV
    const int ncmp = 2; const int wlo = 0;
#else
    const int ncmp = SAMPLE ? 2 : (qb >= 16 ? 2 : 1);
    const int wlo = SAMPLE ? 0 : (qb >= 8 ? qb - 8 : 0);
#endif

    float m_reg = -1e30f, l_reg = 0.f; f32x16 o[4];
#pragma unroll
    for (int d = 0; d < 4; ++d)
#pragma unroll
        for (int r = 0; r < 16; ++r) o[d][r] = 0.f;
    float sc0 = 1.f;
    unsigned sel = 0u, rem = 0u; bool own_done = false;
    int br = 0, step = 0;
    auto gen = [&](Tile& T) -> bool {
        bool have = false; T.K = nullptr; T.V = nullptr; T.stride = 0; T.mode = 0; T.nvalid = 64; T.kp0 = 0; T.kstep = 1; T.W = 0x7fffffffu; T.selbit = -1; T.n0 = 0; T.wrow = -1;
        if (br == 0) { if (step < ncmp) { have = true; T.mode = 2; T.n0 = step * 64; T.kp0 = 31 + 1024 * step; T.kstep = 16; } }
        else if (br == 1) {
            if (rem != 0u) { const int kb = __builtin_ctz(rem); rem &= rem - 1u; have = true; T.selbit = kb; T.kp0 = kb * 64;
                if (SAMPLE) { const int page = F.pt[db * 16 + (kb >> 1)]; const float* base = F.c_slc + ((size_t)page * 128 + (kb & 1) * 64) * 512 + g * 128;
                    T.K = base; T.V = base + 256; T.stride = 512; T.mode = 1; }
                else { const bf16_t* base = KVS + ((size_t)b * SEQ + kb * 64) * 512 + g * 128; T.K = base; T.V = base + 256; T.stride = 512; T.mode = 0; } }
            else if (!own_done) { own_done = true; have = true;
                if (SAMPLE) { const bf16_t* base = KVS + ((size_t)MP + db * 4) * 512 + g * 128; T.K = base; T.V = base + 256; T.stride = 512; T.nvalid = 4; T.kp0 = SEQ; }
                else { const bf16_t* base = KVS + ((size_t)b * SEQ + qb * 64) * 512 + g * 128; T.K = base; T.V = base + 256; T.stride = 512; T.kp0 = qb * 64; } } }
        else {
            if (SAMPLE) { if (step < 8) { have = true; const float* base = F.c_win + ((size_t)db * 512 + step * 64) * 512 + g * 128; T.K = base; T.V = base + 256; T.stride = 512; T.mode = 1; T.kp0 = SEQ - 512 + step * 64; T.W = 512u; T.wrow = step * 64; }
                else if (step == 8) { have = true; const bf16_t* base = KVWb + ((size_t)MP + db * 4) * 512 + g * 128; T.K = base; T.V = base + 256; T.stride = 512; T.nvalid = 4; T.kp0 = SEQ; T.W = 512u; } }
            else { const int kb = wlo + step; if (kb <= qb) { have = true; const bf16_t* base = KVWb + ((size_t)b * SEQ + kb * 64) * 512 + g * 128; T.K = base; T.V = base + 256; T.stride = 512; T.kp0 = kb * 64; T.W = 512u; } } }
        if (have) ++step;
        return have; };
    u32x4 pk0 = {0u, 0u, 0u, 0u}, pk1 = pk0, pv0 = pk0, pv1 = pk0; f32x4 fk[4], fv[4];
    auto issue = [&](const Tile& T) {
        if (T.mode == 0) { const bf16_t* Kp = (const bf16_t*)T.K; const bf16_t* Vp = (const bf16_t*)T.V; pk0 = (u32x4){0u, 0u, 0u, 0u}; pk1 = pk0; pv0 = pk0; pv1 = pk0;
            if (sr < T.nvalid) { pk0 = *(const u32x4*)(Kp + (size_t)sr * T.stride + sc); pv0 = *(const u32x4*)(Vp + (size_t)sr * T.stride + sc); }
            if (sr + 32 < T.nvalid) { pk1 = *(const u32x4*)(Kp + (size_t)(sr + 32) * T.stride + sc); pv1 = *(const u32x4*)(Vp + (size_t)(sr + 32) * T.stride + sc); } }
        else if (SAMPLE && T.mode == 1) { const float* Kp = (const float*)T.K + (size_t)sr * T.stride + sc; const float* Vp = (const float*)T.V + (size_t)sr * T.stride + sc;
            fk[0] = *(const f32x4*)Kp; fk[1] = *(const f32x4*)(Kp + 4); fk[2] = *(const f32x4*)(Kp + 32 * 512); fk[3] = *(const f32x4*)(Kp + 32 * 512 + 4);
            fv[0] = *(const f32x4*)Vp; fv[1] = *(const f32x4*)(Vp + 4); fv[2] = *(const f32x4*)(Vp + 32 * 512); fv[3] = *(const f32x4*)(Vp + 32 * 512 + 4); } };
    auto commit = [&](const Tile& T) {
        if (T.mode == 0) { *(LAS u32x4*)(K_lds + kws) = pk0; *(LAS u32x4*)(K_lds + kws + 32 * 256) = pk1; *(LAS u32x4*)(V_lds + vst0) = pv0; *(LAS u32x4*)(V_lds + vst1) = pv1; }
        else if (SAMPLE && T.mode == 1) { *(LAS u32x4*)(K_lds + kws) = pack8u(fk[0], fk[1]); *(LAS u32x4*)(K_lds + kws + 32 * 256) = pack8u(fk[2], fk[3]);
            *(LAS u32x4*)(V_lds + vst0) = pack8u(fv[0], fv[1]); *(LAS u32x4*)(V_lds + vst1) = pack8u(fv[2], fv[3]);
            if (T.wrow >= 0) {
                float* dst = F.out + O_SKW + ((size_t)db * 512) * 512 + g * 128 + sc; const int i0 = T.wrow + sr - 4;
                if (i0 >= 0) { float* p = dst + (size_t)i0 * 512; *(f32x4*)p = fk[0]; *(f32x4*)(p + 4) = fk[1]; *(f32x4*)(p + 256) = fv[0]; *(f32x4*)(p + 260) = fv[1]; }
                { float* p = dst + (size_t)(i0 + 32) * 512; *(f32x4*)p = fk[2]; *(f32x4*)(p + 4) = fk[3]; *(f32x4*)(p + 256) = fv[2]; *(f32x4*)(p + 260) = fv[3]; } } }
        else if (T.mode == 2) { const float* Fk = FS + (size_t)fsunit * 65536; const float* Fv = Fk + 65536;
#pragma unroll 1
            for (int hh = 0; hh < 2; ++hh) { const int n = T.n0 + sr + 32 * hh; u32x4 kk = {0u, 0u, 0u, 0u}, vv = kk;
                if (n <= 126) { const size_t o1 = (size_t)(g * 128 + n) * 256 + sc, o2 = (size_t)(g * 128 + n + 1) * 256 + 128 + sc;
                    { const f32x4 a0 = *(const f32x4*)(Fk + o1) + *(const f32x4*)(Fk + o2) + *(const f32x4*)(POSB + sc), a1 = *(const f32x4*)(Fk + o1 + 4) + *(const f32x4*)(Fk + o2 + 4) + *(const f32x4*)(POSB + sc + 4); kk = pack8u(a0, a1); }
                    { const f32x4 c0 = *(const f32x4*)(Fv + o1) + *(const f32x4*)(Fv + o2) + *(const f32x4*)(POSB + 128 + sc), c1 = *(const f32x4*)(Fv + o1 + 4) + *(const f32x4*)(Fv + o2 + 4) + *(const f32x4*)(POSB + 128 + sc + 4); vv = pack8u(c0, c1); } }
                *(LAS u32x4*)(K_lds + kws + hh * 32 * 256) = kk; *(LAS u32x4*)(V_lds + (hh ? vst1 : vst0)) = vv; } } };
    Tile T; bool have = gen(T);
    if (have) issue(T);
    for (;;) {
        if (!have) {
            if (active) {
                const float inv = 1.0f / fmaxf(l_reg, 1e-30f);
                if (hi == 0) li_l[r32] = rowvalid ? GNSA[grow * 32 + br * 8 + head] * inv : 0.f;
                asm volatile("s_waitcnt lgkmcnt(0)" ::: "memory");
                int r32e = r32, hie = hi; asm volatile("" : "+v"(r32e), "+v"(hie));
#pragma unroll
                for (int r = 0; r < (SAMPLE ? 8 : 16); ++r) { const int rr = crow(r, hie); const float fac = li_l[rr];
                    size_t orow; int ohead; bool ok = true;
                    if (SAMPLE) { ok = rr < 16; orow = (size_t)MP + db * 4 + (rr & 3); ohead = g * 4 + ((rr & 15) >> 2); } else { orow = (size_t)b * SEQ + qb * 64 + (wid & 1) * 32 + rr; ohead = head; }
                    if (ok) { float* pm = OMIX + orow * 1024 + ohead * 128 + r32e; bf16_t* pb = OB + orow * 1024 + ohead * 128 + r32e;
                        float v0 = o[0][r] * fac, v1 = o[1][r] * fac, v2 = o[2][r] * fac, v3 = o[3][r] * fac;
                        if (br > 0) { v0 += pm[0]; v1 += pm[32]; v2 += pm[64]; v3 += pm[96]; }
                        if (br < 2) { pm[0] = v0; pm[32] = v1; pm[64] = v2; pm[96] = v3; }
                        else { pb[0] = (bf16_t)(cvtpk(v0, 0.f) & 0xffffu); pb[32] = (bf16_t)(cvtpk(v1, 0.f) & 0xffffu); pb[64] = (bf16_t)(cvtpk(v2, 0.f) & 0xffffu); pb[96] = (bf16_t)(cvtpk(v3, 0.f) & 0xffffu); } }
                    if ((r & 7) == 7) asm volatile("" ::: "memory"); }
                if (br == 0 && rowvalid && hi == 0) { SC[(hl * 64 + tok) * 2] = sc0 * inv; SC[(hl * 64 + tok) * 2 + 1] = inv; }
            }
            if (br == 0) {
                __syncthreads();
                constexpr int NTOK = SAMPLE ? 4 : 64; const int cur = SAMPLE ? 32 : qb;
                if (tid < NTOK) {
#pragma unroll 1
                    for (int k = 0; k < 32; ++k) { float s = 0.f;
#pragma unroll
                        for (int h = 0; h < 4; ++h) { s += IMPA[(h * 64 + tid) * 33 + k] * SC[(h * 64 + tid) * 2 + (k >> 4)]; if (k > 0) s += IMPB[(h * 64 + tid) * 33 + k - 1] * SC[(h * 64 + tid) * 2 + ((k - 1) >> 4)]; }
                        IMP[tid * 33 + k] = s; }
                    unsigned mask = 0u;
                    if (cur >= 1) { if (cur <= 7) mask = (1u << (cur & 31)) - 1u;
                        else { mask = 1u;
#pragma unroll 1
                            for (int it = 0; it < 6; ++it) { float best = -1.f; int bi = 0;
#pragma unroll 1
                                for (int k = 1; k < cur; ++k) { const float v = IMP[tid * 33 + k]; if (!((mask >> k) & 1u) && v > best) { best = v; bi = k; } }
                                mask |= 1u << bi; } } }
                    SEL[tid] = mask;
#ifdef ATT_CHECK
                    if (!SAMPLE) ((unsigned*)(F.ws + (size_t)1272 * MiB))[(b * 2 + g) * 2048 + qb * 64 + tid] = mask;
#endif
                }
                __syncthreads();
                if (wid == 0) { unsigned v = (lane < NTOK) ? SEL[lane] : 0u;
#pragma unroll
                    for (int off = 1; off < 64; off <<= 1) v |= __shfl_xor(v, off);
                    if (lane == 0) UNI[0] = v; }
                __syncthreads();
                rem = UNI[0]; sel = SEL[tok];
            }
            ++br; step = 0; if (br == 3) break;
            m_reg = -1e30f; l_reg = 0.f;
#pragma unroll
            for (int d = 0; d < 4; ++d)
#pragma unroll
                for (int r = 0; r < 16; ++r) o[d][r] = 0.f;
            have = gen(T); if (have) issue(T);
            continue;
        }
        asm volatile("s_waitcnt lgkmcnt(0)\n\ts_barrier" ::: "memory");
        commit(T);
        Tile TN; const bool have_n = gen(TN);
        if (have_n) issue(TN);
        asm volatile("s_waitcnt lgkmcnt(0)\n\ts_barrier" ::: "memory");
        if (active) {
            f32x16 p0, p1; float mn, al; bf16x8 pa0, pa1, pa2, pa3;
            const bool rowsel = rowvalid && (T.selbit < 0 || ((sel >> T.selbit) & 1u));
            const float bstep = sl_raw * (float)T.kstep, bbase = rowsel ? sl_raw * (float)(T.kp0 + T.kstep * 4 * hi) : -__builtin_inff();
            qkt<SAMPLE>(p0, p1, K_lds, r32, hi, qr, Q_lds, bbase, bstep);
            { const int kpl = T.kp0 + 63 * T.kstep, tlo = SAMPLE ? SEQ : t - r32, thi = tlo + (SAMPLE ? 3 : 31);
              if (kpl > tlo || (T.W < 0x7fffffffu && thi - T.kp0 > (int)T.W)) mask_tile(p0, p1, t - T.kp0 - T.kstep * 4 * hi, T.kstep, T.W, true); }
            partialSM(p0, p1, m_reg, mn, al);
            if (__any(al < 1.f)) { if (hi == 0) al_l[r32] = al; asm volatile("s_waitcnt lgkmcnt(0)" ::: "memory");
#pragma unroll
                for (int d_ = 0; d_ < 4; ++d_)
#pragma unroll
                    for (int r = 0; r < 16; ++r) o[d_][r] *= al_l[crow(r, hi)];
                if (br == 0 && T.n0 > 0) sc0 *= al; }
            if (br == 0 && rowvalid) { const int rowi = (hl * 64 + tok) * 33 + (T.n0 >> 2) + hi;
#pragma unroll
                for (int j = 0; j < 4; ++j) { IMPA[rowi + 2 * j] = (p0[4 * j] + p0[4 * j + 1]) + (p0[4 * j + 2] + p0[4 * j + 3]); IMPB[rowi + 2 * j] = p0[4 * j + 3];
                    IMPA[rowi + 8 + 2 * j] = (p1[4 * j] + p1[4 * j + 1]) + (p1[4 * j + 2] + p1[4 * j + 3]); IMPB[rowi + 8 + 2 * j] = p1[4 * j + 3]; } }
            finishSM(p0, p1, al, l_reg, pa0, pa1, pa2, pa3);
            pv_tile(o, vb0, pa0, pa1, pa2, pa3);
        }
        T = TN; have = have_n;
    }
}
}

#ifdef ATT_CHECK
__device__ __forceinline__ float bfr(float x) { return __uint_as_float(pk2(x, 0.f) << 16); }
__device__ __forceinline__ void att_check(const Frame& F, unsigned char* ldsg) {
    LAS float* L = (LAS float*)ldsg;
    LAS float* Qs = L;
    LAS float* Ss = L + 512;
    LAS float* Oc = L + 512 + 2560;
    LAS float* IMPs = Oc + 1536;
    LAS int* KP = (LAS int*)(IMPs + 32);
    LAS float* RED = (LAS float*)(KP + 640);
    LAS unsigned* MSK = (LAS unsigned*)(RED + 1024);
    const int tid = F.tid, bid = F.bid;
    const int b = bid & 7, g = (bid >> 3) & 1, t = (bid * CHK_MUL + CHK_ADD) & 2047;
    const size_t row = (size_t)b * SEQ + t;
    const bf16_t* Qg = WSP(bf16_t, WS_Q); const bf16_t* KVS = WSP(bf16_t, WS_KVS); const bf16_t* KVWb = WSP(bf16_t, WS_KVW);
    const float* FS = WSP(float, WS_FS); const float* POSB = WSP(float, WS_POSB); const float* GNSA = WSP(float, WS_GNSA); const bf16_t* OB = WSP(bf16_t, WS_OB);
    const float SCL = 0.08838834764831845f;
    __syncthreads();
    { const int h = tid >> 7, d = tid & 127; float qv = bf2f(Qg[row * 1024 + (g * 4 + h) * 128 + d]);
#ifdef CHK_QNOISE
      { unsigned hsh = (unsigned)(row * 1024 + (g * 4 + h) * 128 + d) * 2654435761u; hsh ^= hsh >> 15; hsh *= 2246822519u; hsh ^= hsh >> 13; qv *= 1.0f + CHK_QNOISE * ((float)(hsh & 0xffff) * (1.0f / 32768.0f) - 1.0f); }
#endif
      Qs[h * 128 + d] = qv; }
    __syncthreads();
    const int hh = tid >> 7, dd = tid & 127; const float slope = exp2f(-(float)(g * 4 + hh + 1));
    const float* Fk = FS + (size_t)(256 + b * 2) * 65536; const float* Fv = Fk + 65536;
    const int ncv = t >= 31 ? (t - 31) / 16 + 1 : 0;
    { const int n = dd; float s = -INFINITY;
      if (n < ncv && n <= 126) { float acc = 0.f; for (int d = 0; d < 128; ++d) { const float kc = bfr(Fk[(size_t)(g * 128 + n) * 256 + d] + Fk[(size_t)(g * 128 + n + 1) * 256 + 128 + d] + POSB[d]); acc += Qs[hh * 128 + d] * kc; }
          s = acc * SCL + slope * (float)(16 * n + 31); }
      Ss[hh * 640 + n] = s; }
    __syncthreads();
    if (tid < 4) { float mx = -INFINITY; for (int n = 0; n < 128; ++n) mx = fmaxf(mx, Ss[tid * 640 + n]); float sum = 0.f;
        for (int n = 0; n < 128; ++n) { const float e = (Ss[tid * 640 + n] == -INFINITY) ? 0.f : expf(Ss[tid * 640 + n] - mx); Ss[tid * 640 + n] = e; sum += e; }
        const float inv = 1.0f / fmaxf(sum, 1e-30f); for (int n = 0; n < 128; ++n) Ss[tid * 640 + n] *= inv; }
    __syncthreads();
    { float acc = 0.f; for (int n = 0; n < ncv && n <= 126; ++n) { const float kv = bfr(Fv[(size_t)(g * 128 + n) * 256 + dd] + Fv[(size_t)(g * 128 + n + 1) * 256 + 128 + dd] + POSB[128 + dd]); acc += Ss[hh * 640 + n] * kv; }
      Oc[(0 * 4 + hh) * 128 + dd] = acc; }
    if (tid < 32) { float s = 0.f; for (int h = 0; h < 4; ++h) for (int n = 4 * tid - 1; n <= 4 * tid + 3; ++n) if (n >= 0 && n < 127) s += Ss[h * 640 + n]; IMPs[tid] = s; }
    __syncthreads();
    const int cur = t >> 6;
    if (tid == 0) { unsigned mask = 0u;
        if (cur >= 1) { if (cur <= 7) mask = (1u << cur) - 1u; else { mask = 1u;
            for (int it = 0; it < 6; ++it) { float best = -1.f; int bi = 0; for (int k = 1; k < cur; ++k) { const float v = IMPs[k]; if (!((mask >> k) & 1u) && v > best) { best = v; bi = k; } } mask |= 1u << bi; } } }
        const unsigned kmask = ((const unsigned*)(F.ws + (size_t)1272 * MiB))[(b * 2 + g) * 2048 + t];
        MSK[2] = (kmask != mask) ? 1u : 0u;
#if CHK_USE_KMASK
        mask = kmask;
#endif
        int nk = 0; for (int k = 0; k < 32; ++k) if ((mask >> k) & 1u) for (int i = 0; i < 64; ++i) KP[nk++] = k * 64 + i;
        for (int s = cur * 64; s <= t; ++s) KP[nk++] = s;
        MSK[0] = mask; MSK[1] = (unsigned)nk; }
    __syncthreads();
    for (int br = 1; br <= 2; ++br) {
        const bf16_t* KV = (br == 1) ? KVS : KVWb; const int wl = t - 512 > 0 ? t - 512 : 0; const int nk = (br == 1) ? (int)MSK[1] : t - wl + 1;
        __syncthreads();
        for (int j = dd; j < 640; j += 128) { float s = -INFINITY;
            if (j < nk) { const int kp = (br == 1) ? KP[j] : wl + j; const bf16_t* kr = KV + ((size_t)b * SEQ + kp) * 512 + g * 128; float acc = 0.f; for (int d = 0; d < 128; ++d) acc += Qs[hh * 128 + d] * bf2f(kr[d]);
                s = acc * SCL + slope * (float)kp; }
            Ss[hh * 640 + j] = s; }
        __syncthreads();
        if (tid < 4) { float mx = -INFINITY; for (int n = 0; n < 640; ++n) mx = fmaxf(mx, Ss[tid * 640 + n]); float sum = 0.f;
            for (int n = 0; n < 640; ++n) { const float e = (Ss[tid * 640 + n] == -INFINITY) ? 0.f : expf(Ss[tid * 640 + n] - mx); Ss[tid * 640 + n] = e; sum += e; }
            const float inv = 1.0f / fmaxf(sum, 1e-30f); for (int n = 0; n < 640; ++n) Ss[tid * 640 + n] *= inv; }
        __syncthreads();
        { float acc = 0.f; for (int j = 0; j < nk; ++j) { const int kp = (br == 1) ? KP[j] : wl + j; acc += Ss[hh * 640 + j] * bf2f(KV[((size_t)b * SEQ + kp) * 512 + 256 + g * 128 + dd]); }
          Oc[(br * 4 + hh) * 128 + dd] = acc; }
    }
    __syncthreads();
    { const int head = g * 4 + hh; float ref = 0.f; for (int br = 0; br < 3; ++br) ref += GNSA[row * 32 + br * 8 + head] * Oc[(br * 4 + hh) * 128 + dd];
      const float mine = bf2f(OB[row * 1024 + head * 128 + dd]); RED[tid] = (mine - ref) * (mine - ref); RED[512 + tid] = ref * ref; }
    __syncthreads();
    if (tid == 0) { float e2 = 0.f, r2 = 0.f; for (int i = 0; i < 512; ++i) { e2 += RED[i]; r2 += RED[512 + i]; }
#if CHK_SELONLY
        if (MSK[2]) {
#else
        if (e2 > CHK_TOL * r2) {
#endif
          const float v = CHK_VEXPR;
            F.out[O_PRH + bid] = v; } }
}
#endif

#ifndef P7_ROWS
#define P7_ROWS 16
#endif
__device__ __forceinline__ void p7_act(const Frame& F) {
    const bf16_t* GB = WSP(bf16_t, WS_GB); const bf16_t* UB = WSP(bf16_t, WS_UB); bf16_t* ACT = WSP(bf16_t, WS_ACT);
    const int gt = F.bid * 512 + F.tid, NT = F.G * 512;
    for (int idx = gt; idx < (M / P7_ROWS) * 768; idx += NT) { const int cgp = idx % 768, r0 = (idx / 768) * P7_ROWS, c = cgp * 8; const bool samp = r0 >= MP;
        float w0[8], w1[8], w2[8], bb[8], g2[8], g1[8];
#pragma unroll
        for (int e = 0; e < 8; e += 4) { const f32x4 a = *(const f32x4*)(F.fconv_w + c + e), b4 = *(const f32x4*)(F.fconv_w + DFF + c + e), c4 = *(const f32x4*)(F.fconv_w + 2 * DFF + c + e), d4 = *(const f32x4*)(F.fconv_b + c + e);
#pragma unroll
            for (int j = 0; j < 4; ++j) { w0[e + j] = a[j]; w1[e + j] = b4[j]; w2[e + j] = c4[j]; bb[e + j] = d4[j]; } }
        if (!samp && (r0 & 2047) != 0) { const u32x4 a = *(const u32x4*)(GB + (size_t)(r0 - 2) * DFF + c), b4 = *(const u32x4*)(GB + (size_t)(r0 - 1) * DFF + c);
            g2[0] = bflo(a.x); g2[1] = bfhi(a.x); g2[2] = bflo(a.y); g2[3] = bfhi(a.y); g2[4] = bflo(a.z); g2[5] = bfhi(a.z); g2[6] = bflo(a.w); g2[7] = bfhi(a.w);
            g1[0] = bflo(b4.x); g1[1] = bfhi(b4.x); g1[2] = bflo(b4.y); g1[3] = bfhi(b4.y); g1[4] = bflo(b4.z); g1[5] = bfhi(b4.z); g1[6] = bflo(b4.w); g1[7] = bfhi(b4.w); }
        else {
#pragma unroll
            for (int e = 0; e < 8; ++e) { g2[e] = 0.f; g1[e] = 0.f; } }
#pragma unroll 4
        for (int i = 0; i < P7_ROWS; ++i) { const int r = r0 + i;
            if (samp && (i & 3) == 0) { const int db = (r - MP) >> 2; const float* sp = F.st_ffn + (size_t)db * 2 * DFF + c;
                const f32x4 a = *(const f32x4*)sp, a2 = *(const f32x4*)(sp + 4), b4 = *(const f32x4*)(sp + DFF), b5 = *(const f32x4*)(sp + DFF + 4);
#pragma unroll
                for (int j = 0; j < 4; ++j) { g2[j] = a[j]; g2[4 + j] = a2[j]; g1[j] = b4[j]; g1[4 + j] = b5[j]; } }
            const u32x4 gw = *(const u32x4*)(GB + (size_t)r * DFF + c), uw = *(const u32x4*)(UB + (size_t)r * DFF + c);
            float g0[8], uu[8], ov[8];
            g0[0] = bflo(gw.x); g0[1] = bfhi(gw.x); g0[2] = bflo(gw.y); g0[3] = bfhi(gw.y); g0[4] = bflo(gw.z); g0[5] = bfhi(gw.z); g0[6] = bflo(gw.w); g0[7] = bfhi(gw.w);
            uu[0] = bflo(uw.x); uu[1] = bfhi(uw.x); uu[2] = bflo(uw.y); uu[3] = bfhi(uw.y); uu[4] = bflo(uw.z); uu[5] = bfhi(uw.z); uu[6] = bflo(uw.w); uu[7] = bfhi(uw.w);
#pragma unroll
            for (int e = 0; e < 8; ++e) { const float pre = bb[e] + w0[e] * g2[e] + w1[e] * g1[e] + w2[e] * g0[e]; ov[e] = gelu_tanh(pre) * uu[e]; g2[e] = g1[e]; g1[e] = g0[e]; }
            u32x4 o; o.x = pk2(ov[0], ov[1]); o.y = pk2(ov[2], ov[3]); o.z = pk2(ov[4], ov[5]); o.w = pk2(ov[6], ov[7]);
            *(u32x4*)(ACT + (size_t)r * DFF + c) = o; } }
}
#ifndef ROWSC
#define ROWSC(m) 1.0f
#endif
__device__ __forceinline__ void p9_final(const Frame& F) {
    const int gw = F.bid * 8 + F.wave, NGW = F.G * 8, lane = F.lane; const float* SS = WSP(float, WS_SS3);
    f32x4 gv[8];
#pragma unroll
    for (int j = 0; j < 8; ++j) gv[j] = ((const f32x4*)F.norm_final)[lane + 64 * j];
    if (F.wave < 2) for (int s = F.wave * F.G + F.bid; s < MS; s += 2 * F.G) { const int m = MP + s; f32x4* row = (f32x4*)(F.out + (size_t)m * DM);
            const bf16_t* xb = WSP(bf16_t, WS_XB2) + (size_t)m * DM; const float* sl = WSP(float, WS_SLAB) + (size_t)(m - MP) * DM; f32x4 v[8]; float ss = 0.f;
#pragma unroll
            for (int j = 0; j < 8; ++j) { const u32x2 xw = *((const u32x2*)xb + lane + 64 * j); f32x4 a = {bflo(xw.x), bfhi(xw.x), bflo(xw.y), bfhi(xw.y)};
#pragma unroll 4
                for (int ks = 0; ks < 16; ++ks) a += *((const f32x4*)(sl + (size_t)ks * MS * DM) + lane + 64 * j);
                v[j] = a; ss += (a.x * a.x + a.y * a.y) + (a.z * a.z + a.w * a.w); }
            const float rs = 1.0f / sqrtf(wave_sum(ss) * (1.0f / DM) + EPS);
#pragma unroll
            for (int j = 0; j < 8; ++j) row[lane + 64 * j] = v[j] * (rs * SC_YS) * gv[j]; }
    { int m = gw; f32x4 cur[8]; float cs = 0.f;
      if (m < MP) { const f32x4* row = (const f32x4*)(F.out + (size_t)m * DM);
#pragma unroll
          for (int j = 0; j < 8; ++j) cur[j] = row[lane + 64 * j];
          cs = lane < 32 ? SS[(size_t)m * 32 + lane] : 0.f; }
#pragma unroll 1
      for (; m < MP; m += NGW) { const int mn = (m + NGW) < MP ? (m + NGW) : m; const f32x4* rown = (const f32x4*)(F.out + (size_t)mn * DM); f32x4 nx[8];
#pragma unroll
          for (int j = 0; j < 8; ++j) nx[j] = rown[lane + 64 * j];
          const float ns = lane < 32 ? SS[(size_t)mn * 32 + lane] : 0.f;
          const float rs = 1.0f / sqrtf(wave_sum(cs) * (1.0f / DM) + EPS); f32x4* row = (f32x4*)(F.out + (size_t)m * DM);
#pragma unroll
          for (int j = 0; j < 8; ++j) row[lane + 64 * j] = cur[j] * (rs * SC_YP * ROWSC(m)) * gv[j];
#pragma unroll
          for (int j = 0; j < 8; ++j) cur[j] = nx[j];
          cs = ns; } }
}

#ifndef PG_SP2
#define PG_SP2 true
#endif
#ifndef PG_ALIGN
#define PG_ALIGN true
#endif
__global__ void __launch_bounds__(512, 2) fwd(Args args) {
    extern __shared__ __attribute__((aligned(16))) unsigned char lds[];
    Frame F;
    F.tid = threadIdx.x; F.lane = F.tid & 63; F.wave = __builtin_amdgcn_readfirstlane(F.tid >> 6); F.G = gridDim.x; F.bid = blockIdx.x;
    F.x_p = (const float*)args.in[0]; F.x_s = (const float*)args.in[1]; F.c_cmp = (const float*)args.in[2]; F.c_slc = (const float*)args.in[3]; F.c_win = (const float*)args.in[4];
    F.st_h = (const float*)args.in[5]; F.st_conv = (const float*)args.in[6]; F.st_ffn = (const float*)args.in[7]; F.pt = (const int*)args.in[8];
    F.norm_mix = (const float*)args.in[9]; F.w_in = (const float*)args.in[10]; F.rconv_w = (const float*)args.in[11]; F.rconv_b = (const float*)args.in[12];
    F.rwa = (const float*)args.in[13]; F.rba = (const float*)args.in[14]; F.rwx = (const float*)args.in[15]; F.rbx = (const float*)args.in[16]; F.rlam = (const float*)args.in[17];
    F.cmp_w = (const float*)args.in[18]; F.cmp_pos = (const float*)args.in[19]; F.w_pr = (const float*)args.in[20]; F.w_pa = (const float*)args.in[21]; F.w_out = (const float*)args.in[22];
    F.norm_ffn = (const float*)args.in[23]; F.w_gate = (const float*)args.in[24]; F.w_up = (const float*)args.in[25]; F.fconv_w = (const float*)args.in[26]; F.fconv_b = (const float*)args.in[27];
    F.w_down = (const float*)args.in[28]; F.norm_final = (const float*)args.in[29];
    F.out = args.out; F.ws = args.ws;
    LAS unsigned char* ldsl = (LAS unsigned char*)lds;
    volatile LAS unsigned* MISC = (volatile LAS unsigned*)(ldsl + MISC_OFF);
    if (F.tid < 32) MISC[F.tid] = 0u;
    __syncthreads();
    const int lo = args.ph_lo, hi = args.ph_hi;
    const bool multi = (hi - lo) > 1;
    XcdBarrier bar; bar.bar = (unsigned*)(F.ws + WS_CTL) + CW_BAR; bar.x = 0; bar.st = nullptr;
    if (multi) bar = xcd_barrier_post((unsigned*)(F.ws + WS_CTL) + CW_BAR, MISC + 8);
#ifndef PH_MASK
#define PH_MASK 0xfff
#endif
#define IN(k) (((PH_MASK >> (k)) & 1) && lo <= (k) && (k) < hi)
#ifndef SEAM_REP
#define SEAM_REP 1
#endif
#define SEAM(k) do { if (IN(k) && IN((k) + 1)) { for (int rep_ = 0; rep_ < SEAM_REP; ++rep_) xcd_barrier(bar); } } while (0)

    #ifdef REPEAT_P0SKIP
    if (IN(0)) { p0_prologue(F, lds, args.qhi < 0 ? args.qlo : 0); } SEAM(0);
#else
    if (IN(0)) { p0_prologue(F, lds, 0); } SEAM(0);
#endif
        const int P1_BUSY = ((M / 256) * (N1 / 256)) % F.G;
    const int NEARLY = P1_BUSY > 0 ? ((F.G - P1_BUSY) < 256 ? (F.G - P1_BUSY) : 256) : 0;
    const int NCMP2 = NCU_UNITS - NEARLY;
#ifdef REPEAT_LD
    const int ld1 = (args.qhi < 0 && args.qlo > 0) ? args.qlo : DM;
#else
    constexpr int ld1 = DM;
#endif
    if (IN(1)) { pg8::Gemm g{WSP(bf16_t, WS_XB), WSP(bf16_t, WS_W1T), M, N1, DM, ld1, ld1};
#ifdef REPEAT_SWAPBUF
        if (args.qhi < 0) { g.A = WSP(bf16_t, WS_XB2); g.Bt = WSP(bf16_t, WS_WG); }
#endif
 pg8::StaticOrder S; S.init(M, N1, F.G, F.bid);
#ifdef REPEAT_WGM
        if (args.qhi < 0) S.wgm = REPEAT_WGM;
#endif

        EpiIn E{WSP(float, WS_RSTD1), WSP(bf16_t, WS_XR), WSP(bf16_t, WS_GG), WSP(bf16_t, WS_Q), WSP(bf16_t, WS_KVS), WSP(bf16_t, WS_KVW), WSP(bf16_t, WS_CC), WSP(bf16_t, WS_SGM), WSP(float, WS_GNSA), F.out, args.qhi < 0, (LAS float*)(ldsl + XL_OFF) + 1024};
        pg8::gemm_phase<EpiIn, pg8::StaticOrder, PG_ALIGN, PG_SP2>(ldsl, g, S, E);
        if (F.bid >= P1_BUSY && NEARLY > 0) {
            pg8::Gemm gc{WSP(bf16_t, WS_CC), WSP(bf16_t, WS_WC), NCU_UNITS * 256, 512, 2048, 2048, 2048}; CmpOrder Sc{NEARLY, F.bid - P1_BUSY, 0, NEARLY}; EpiFS Ec{WSP(float, WS_FS)};
            pg8::gemm_phase<EpiFS, CmpOrder, PG_ALIGN, PG_SP2>(ldsl, gc, Sc, Ec); } } SEAM(1);

#ifdef REPEAT_P2SKIP
    const int p2skip = args.qhi < 0 ? args.qlo : 0;
#else
    constexpr int p2skip = 0;
#endif
    if (IN(2)) {
        { LAS float* red = (LAS float*)(ldsl + XL_OFF);
          for (int e = F.bid; e < 256; e += F.G) { float s = 0.f; for (int w = F.tid; w < F.G; w += 512) s += WSP(float, WS_POSP)[w * 256 + e];
              s = wave_sum(s); if (F.lane == 0) red[F.wave] = s; __syncthreads();
              if (F.tid == 0) WSP(float, WS_POSB)[e] = ((red[0] + red[1]) + (red[2] + red[3])) + ((red[4] + red[5]) + (red[6] + red[7])); __syncthreads(); } }
        if (!(p2skip & 1)) { pg8::Gemm g{WSP(bf16_t, WS_CC), WSP(bf16_t, WS_WC), NCU_UNITS * 256, 512, 2048, 2048, 2048}; CmpOrder S{F.G, F.bid, NEARLY, NCMP2}; EpiFS E{WSP(float, WS_FS)};
          pg8::gemm_phase<EpiFS, CmpOrder, PG_ALIGN, PG_SP2>(ldsl, g, S, E); }
        if (!(p2skip & 2)) for (int u = F.bid; u < 256; u += F.G) rglru_prompt_unit(F, u, lds);
        if (!(p2skip & 4)) for (int u = 256 + (F.G - 1 - F.bid); u < 384; u += F.G) rglru_unit(F, u, lds);
        __syncthreads(); if (!(p2skip & 8)) tr_deferred(F, lds, TR_A1, TR_A2 + TR_GDEF, NCMP2, F.G); } SEAM(2);
    if (IN(3)) {
        unsigned* qhead = (unsigned*)(F.ws + WS_CTL) + CW_QUEUE;
        for (;;) {
            if (F.tid == 0) MISC[16] = __hip_atomic_fetch_add(qhead, 1u, __ATOMIC_RELAXED, __HIP_MEMORY_SCOPE_AGENT);
            __syncthreads(); const int u = args.qlo + (int)MISC[16]; __syncthreads();
            if (u >= args.qhi) break;
            if (u < 512 && (u & 1)) att::attn_unit<true>(F, u >> 1, lds);
            else { const int gg = u < 512 ? 1 : 0, pp = u < 512 ? (u >> 1) : u - 512, qb = 31 - (pp >> 3), bb = pp & 7; att::attn_unit<false>(F, (31 - qb) * 16 + bb * 2 + gg, lds); } } } SEAM(3);
    if (IN(4)) { pg8::StaticOrder S; S.init(MP, DM, F.G, F.bid);
#ifdef PROJ_MERGED
        { pg8::Gemm g{WSP(bf16_t, WS_Y), WSP(bf16_t, WS_WPR), MP, DM, 2048, 1024, 1024, WSP(bf16_t, WS_OB), WSP(bf16_t, WS_WPA)}; EpiProjM E{WSP(bf16_t, WS_SGM), WSP(bf16_t, WS_MB)}; pg8::gemm_phase<EpiProjM, pg8::StaticOrder, PG_ALIGN, PG_SP2>(ldsl, g, S, E); }
#else
        { pg8::Gemm g{WSP(bf16_t, WS_Y), WSP(bf16_t, WS_WPR), MP, DM, 1024, 1024, 1024}; EpiProj<0> E{WSP(bf16_t, WS_SGM), WSP(bf16_t, WS_T1), WSP(bf16_t, WS_MB)}; pg8::gemm_phase<EpiProj<0>, pg8::StaticOrder, PG_ALIGN, PG_SP2>(ldsl, g, S, E); }
        { pg8::Gemm g{WSP(bf16_t, WS_OB), WSP(bf16_t, WS_WPA), MP, DM, 1024, 1024, 1024}; EpiProj<1> E{WSP(bf16_t, WS_SGM), WSP(bf16_t, WS_T1), WSP(bf16_t, WS_MB)}; pg8::gemm_phase<EpiProj<1>, pg8::StaticOrder, PG_ALIGN, PG_SP2>(ldsl, g, S, E); }
#endif
        { pg8::Gemm g{WSP(bf16_t, WS_Y), WSP(bf16_t, WS_WPR), 2 * M, DM, 256, 1024, 1024}; SplitOrder T{F.G, F.bid, 8, 256, 1}; EpiSlab<1> E{WSP(float, WS_SLAB2), 256, WSP(bf16_t, WS_SGM)};
          pg8::gemm_phase<EpiSlab<1>, SplitOrder, PG_ALIGN, PG_SP2>(ldsl, g, T, E); } } SEAM(4);
    if (IN(5)) {
        const int gt = F.bid * 512 + F.tid, NT = F.G * 512; const float* sl = WSP(float, WS_SLAB2); bf16_t* MB = WSP(bf16_t, WS_MB);
        for (int i = gt; i < MS * 256; i += NT) { const size_t o = (size_t)i * 8; f32x4 a = *(const f32x4*)(sl + o), b4 = *(const f32x4*)(sl + o + 4);
#pragma unroll
            for (int s = 1; s < 8; ++s) { a += *(const f32x4*)(sl + (size_t)s * MS * DM + o); b4 += *(const f32x4*)(sl + (size_t)s * MS * DM + o + 4); }
            *(u32x4*)(MB + (size_t)MP * DM + o) = pack8u(a, b4); } } SEAM(5);
    if (IN(6)) { { pg8::Gemm g{WSP(bf16_t, WS_MB), WSP(bf16_t, WS_WO), MP, DM, DM, DM, DM}; pg8::StaticOrder S; S.init(MP, DM, F.G, F.bid);
          EpiOut E{WSP(bf16_t, WS_XB), WSP(bf16_t, WS_XB2), WSP(float, WS_SS2)}; pg8::gemm_phase<EpiOut, pg8::StaticOrder, PG_ALIGN, PG_SP2>(ldsl, g, S, E); }
        { pg8::Gemm g{WSP(bf16_t, WS_MB), WSP(bf16_t, WS_WO), M, DM, 256, DM, DM}; SplitOrder T{F.G, F.bid, 8, 256, 0}; EpiSlab<0> E{WSP(float, WS_SLAB2), 256, nullptr};
          pg8::gemm_phase<EpiSlab<0>, SplitOrder, PG_ALIGN, PG_SP2>(ldsl, g, T, E); } } SEAM(6);
    if (IN(7)) {
        const int NGW = F.G * 8, lane = F.lane; const float* sl = WSP(float, WS_SLAB2); const bf16_t* XB = WSP(bf16_t, WS_XB); bf16_t* XB2 = WSP(bf16_t, WS_XB2); float* SS = WSP(float, WS_SS2); float* RS2 = WSP(float, WS_RSTD2);
        LAS float* red = (LAS float*)(ldsl + XL_OFF);
        for (int it0 = F.bid * 8; it0 < MS * 4; it0 += NGW) { const int it = it0 + F.wave, r = it >> 2, q = it & 3; const size_t o = (size_t)r * DM + q * 512 + lane * 8; const u32x4 xw = *(const u32x4*)(XB + (size_t)MP * DM + o);
            f32x4 a = {bflo(xw.x), bfhi(xw.x), bflo(xw.y), bfhi(xw.y)}, b4 = {bflo(xw.z), bfhi(xw.z), bflo(xw.w), bfhi(xw.w)};
#pragma unroll
            for (int s = 0; s < 8; ++s) { a += *(const f32x4*)(sl + (size_t)s * MS * DM + o); b4 += *(const f32x4*)(sl + (size_t)s * MS * DM + o + 4); }
            *(u32x4*)(XB2 + (size_t)MP * DM + o) = pack8u(a, b4);
            float ss = (a.x * a.x + a.y * a.y) + (a.z * a.z + a.w * a.w) + (b4.x * b4.x + b4.y * b4.y) + (b4.z * b4.z + b4.w * b4.w); ss = wave_sum(ss);
            if (lane == 0) red[F.wave] = ss; __syncthreads();
            if ((F.wave & 3) == 0 && lane == 0) RS2[MP + r] = 1.0f / sqrtf(((red[F.wave] + red[F.wave + 1]) + (red[F.wave + 2] + red[F.wave + 3])) * (1.0f / DM) + EPS);
            __syncthreads(); }
        if (F.tid < 64) for (int row = F.tid * F.G + F.bid; row < MP; row += 64 * F.G) { const f32x4* sp = (const f32x4*)(SS + (size_t)row * 32); f32x4 t = sp[0];
#pragma unroll
            for (int j = 1; j < 8; ++j) t += sp[j];
            RS2[row] = 1.0f / sqrtf(((t.x + t.y) + (t.z + t.w)) * (1.0f / DM) + EPS); } } SEAM(7);
    if (IN(8)) { pg8::Gemm g{WSP(bf16_t, WS_XB2), WSP(bf16_t, WS_WG), M, 2 * DFF, DM, DM, DM}; pg8::StaticOrder S; S.init(M, 2 * DFF, F.G, F.bid);
        if (F.G == 256) S.light = 14;

        EpiFFN E{WSP(float, WS_RSTD2), F.fconv_w, F.fconv_b, F.st_ffn, WSP(bf16_t, WS_ACT), F.out, WSP(float, WS_GE), WSP(float, WS_G0), WSP(float, WS_U0), (LAS float*)(ldsl + XL_OFF), args.qhi < 0};
        pg8::gemm_phase<EpiFFN, pg8::StaticOrder, PG_ALIGN, PG_SP2>(ldsl, g, S, E);
        tr_deferred(F, lds, TR_A3, TR_A4, F.G == 256 ? 112 : S.nwg % F.G, F.G); } SEAM(8);

    if (IN(9)) { const int gt = F.bid * 512 + F.tid, NT = F.G * 512; const float* GE = WSP(float, WS_GE); const float* G0 = WSP(float, WS_G0); const float* U0 = WSP(float, WS_U0); bf16_t* ACT = WSP(bf16_t, WS_ACT);
        for (int i = gt; i < 64 * 2 * 768; i += NT) { const int f = (i % 768) * 8, rr = (i / 768) & 1, pm = i / (2 * 768); if ((pm & 7) == 0) continue;
            const float* a0 = GE + ((size_t)(pm - 1) * 2 + 0) * DFF + f; const float* a1 = a0 + DFF; const float* b0 = G0 + ((size_t)pm * 2 + 0) * DFF + f; const float* b1 = b0 + DFF; const float* up = U0 + ((size_t)pm * 2 + rr) * DFF + f;
            float ov[8];
#pragma unroll
            for (int h = 0; h < 2; ++h) { const f32x4 gm2 = *(const f32x4*)(a0 + 4 * h), gm1 = *(const f32x4*)(a1 + 4 * h), g0 = *(const f32x4*)(b0 + 4 * h), g1 = *(const f32x4*)(b1 + 4 * h), uv = *(const f32x4*)(up + 4 * h);
                const f32x4 w0 = *(const f32x4*)(F.fconv_w + f + 4 * h), w1 = *(const f32x4*)(F.fconv_w + DFF + f + 4 * h), w2 = *(const f32x4*)(F.fconv_w + 2 * DFF + f + 4 * h), bb = *(const f32x4*)(F.fconv_b + f + 4 * h);
                const f32x4 pre = rr == 0 ? bb + w0 * gm2 + w1 * gm1 + w2 * g0 : bb + w0 * gm1 + w1 * g0 + w2 * g1;
#pragma unroll
                for (int j = 0; j < 4; ++j) ov[4 * h + j] = gelu_tanh(pre[j]) * uv[j]; }
            u32x4 o; o.x = pk2(ov[0], ov[1]); o.y = pk2(ov[2], ov[3]); o.z = pk2(ov[4], ov[5]); o.w = pk2(ov[6], ov[7]);
            *(u32x4*)(ACT + (size_t)(pm * 256 + rr) * DFF + f) = o; } } SEAM(9);
    if (IN(10)) { { pg8::Gemm g{WSP(bf16_t, WS_ACT), WSP(bf16_t, WS_WD), MP, DM, DFF, DFF, DFF}; pg8::StaticOrder S; S.init(MP, DM, F.G, F.bid);
          EpiDown E{WSP(bf16_t, WS_XB2), F.out, WSP(float, WS_SS3), args.qhi < 0}; pg8::gemm_phase<EpiDown, pg8::StaticOrder, PG_ALIGN, PG_SP2>(ldsl, g, S, E); }
        { pg8::Gemm g{WSP(bf16_t, WS_ACT), WSP(bf16_t, WS_WD), M, DM, 384, DFF, DFF}; SplitOrder S{F.G, F.bid, 16, 384, 0}; EpiSlab<0> E{WSP(float, WS_SLAB), 384, nullptr};
          pg8::gemm_phase<EpiSlab<0>, SplitOrder, PG_ALIGN, PG_SP2>(ldsl, g, S, E); } } SEAM(10);
    if (IN(11)) { p9_final(F); }
#ifdef ATT_CHECK
    if (lo <= 12 && 12 < hi) att_check(F, lds);
#endif
#ifdef PROBE
    if (lo <= 12 && 12 < hi) {
        const int gt = F.bid * 512 + F.tid, NT = F.G * 512;
        const bf16_t* P1 = WSP(bf16_t, PROBE_A); const bf16_t* P2 = WSP(bf16_t, PROBE_B);
        for (size_t i = gt; i < (size_t)M * 1024; i += NT) { const size_t r = i >> 10, c = i & 1023; F.out[r * DM + c] = bf2f(P1[(size_t)r * PROBE_LDA + c]); F.out[r * DM + 1024 + c] = bf2f(P2[(size_t)r * PROBE_LDB + c]); }
        for (size_t i = gt; i < (size_t)NBATCH * 2 * DFF; i += NT) F.out[O_PFC + i] = 0.f;
        for (size_t i = gt; i < (size_t)DBATCH * 2 * DFF; i += NT) F.out[O_SFC + i] = 0.f;
    }
#endif
#undef IN
#undef SEAM
}

extern "C" void kernel_launch(void* const* d_in, const int* in_sizes, int n_in, void* d_out, int out_size, void* d_ws, size_t ws_size, hipStream_t stream) {
    static int grid = 0;
    if (grid == 0) {
        if (n_in != 30 || (size_t)out_size != O_END || ws_size < WS_END) { fprintf(stderr, "kernel_launch: unexpected shapes: n_in %d out %d (want %zu) ws %zu (want %zu)\n", n_in, out_size, (size_t)O_END, ws_size, (size_t)WS_END); grid = -1; return; }
        int dev = 0, cus = 0, per_cu = 0;
        if (hipGetDevice(&dev) != hipSuccess || hipDeviceGetAttribute(&cus, hipDeviceAttributeMultiprocessorCount, dev) != hipSuccess) { grid = -1; return; }
        if (hipFuncSetAttribute((const void*)fwd, hipFuncAttributeMaxDynamicSharedMemorySize, LDS_BYTES) != hipSuccess) { fprintf(stderr, "kernel_launch: hipFuncSetAttribute failed\n"); grid = -1; return; }
        if (hipOccupancyMaxActiveBlocksPerMultiprocessor(&per_cu, (const void*)fwd, 512, LDS_BYTES) != hipSuccess || per_cu < 1) fprintf(stderr, "kernel_launch: occupancy query reports %d\n", per_cu);
        (void)hipGetLastError();
        grid = cus;
    }
    if (grid < 0) return;
    if (hipMemsetAsync((char*)d_ws + WS_CTL, 0, CTL_ZERO_BYTES, stream) != hipSuccess) return;
    Args a{};
    for (int i = 0; i < 30; ++i) a.in[i] = d_in[i];
    a.out = (float*)d_out; a.ws = (unsigned char*)d_ws; a.qlo = 0; a.qhi = 768;
#if MK_ONE_LAUNCH
    a.ph_lo = 0; a.ph_hi = NPHASE;
    hipLaunchKernelGGL(fwd, dim3(grid), dim3(512), LDS_BYTES, stream, a);
#else
#if defined(ATT_CHECK)
    for (int q = 0; q < NPHASE + 1; ++q) { const int p = q < 4 ? q : (q == 4 ? 12 : q - 1); a.ph_lo = p; a.ph_hi = p + 1; hipLaunchKernelGGL(fwd, dim3(grid), dim3(512), LDS_BYTES, stream, a); }
#elif defined(PROBE)
    for (int p = 0; p < NPHASE + 1; ++p) { a.ph_lo = p; a.ph_hi = p + 1; hipLaunchKernelGGL(fwd, dim3(grid), dim3(512), LDS_BYTES, stream, a); }
#else
    for (int p = 0; p < NPHASE; ++p) { a.ph_lo = p; a.ph_hi = p + 1; hipLaunchKernelGGL(fwd, dim3(grid), dim3(512), LDS_BYTES, stream, a);
#ifdef REPEAT_PH
#ifndef REPEAT_SKIP
#define REPEAT_SKIP 0
#endif
#ifndef REPEAT_QLO
#define REPEAT_QLO 0
#define REPEAT_QHI 768
#endif
        if (p == REPEAT_PH) { if (p == 1 || p == 8 || p == 10) a.qhi = REPEAT_SKIP ? -1 : 768;
#ifdef REPEAT_LD
            if (p == 1) a.qlo = REPEAT_LD;
#endif
#ifdef REPEAT_P0SKIP
            if (p == 0) { a.qhi = -1; a.qlo = REPEAT_P0SKIP; }
#endif
#ifdef REPEAT_P2SKIP
            if (p == 2) { a.qhi = -1; a.qlo = REPEAT_P2SKIP; }
#endif
 if (p == 3) { (void)hipMemsetAsync((char*)d_ws + WS_CTL + CW_QUEUE * 4, 0, 4, stream); a.qlo = REPEAT_QLO; a.qhi = REPEAT_QHI; } hipLaunchKernelGGL(fwd, dim3(grid), dim3(512), LDS_BYTES, stream, a); a.qlo = 0; a.qhi = 768; }
#endif
    }
#endif
#endif
}
```
